# Optimizing an MI355X kernel written in HIP

```python
import math
import jax, jax.numpy as jnp
from jax import lax
import numpy as np

D_MODEL = 1024
BATCH = 4
SEQ = 4096
DEPTH = 1
DEC_BATCH = 32
DEC_SEQ = 4
PAST_LEN = 16384
PAGE_SIZE = 128

MIX_W = D_MODEL
ATT_W = MIX_W // 2
HG_W = MIX_W - ATT_W
ATT_DH = 64
ATT_H = ATT_W // ATT_DH
DIL_PATTERNS = ((128, 1), (512, 4), (2048, 16))
MAX_WINDOW = 2048
Q_BLOCK = 128
HG_DK = 128
HG_H = HG_W // HG_DK
HG_DV = HG_W // HG_H
HG_CHUNK = 64
N_MEM = 256
X_H = 4
X_DH = 128
X_W = X_H * X_DH
D_FF = 2816
CONV_W = 3
EPS = 1e-6
IN_COLS = 3 * ATT_W + 4 * HG_W
IN_SPLITS = (ATT_W, 2 * ATT_W, 3 * ATT_W, 3 * ATT_W + HG_W, 3 * ATT_W + 2 * HG_W, 3 * ATT_W + 3 * HG_W)

kernel_name = 'hymba_hgrn2_dilated_decoder_step'


def rmsnorm(x, g):
    x32 = x.astype(jnp.float32)
    y = x32 * lax.rsqrt(jnp.mean(x32 * x32, axis=-1, keepdims=True) + EPS)
    return (y * g.astype(jnp.float32)).astype(x.dtype)


def head_rmsnorm(a, g):
    B, T, H, Dh = a.shape
    a32 = a.astype(jnp.float32)
    y = a32 * lax.rsqrt(jnp.mean(a32 * a32, axis=-1, keepdims=True) + EPS)
    return y.reshape(B, T, H * Dh) * g.astype(jnp.float32)


def alibi_slopes():
    return jnp.exp2(-8.0 * jnp.arange(1, ATT_H + 1, dtype=jnp.float32) / ATT_H)


def dilated_block(q, k_all, v_all, q_idx):
    slopes = alibi_slopes()
    lses, outs = [], []
    for win, dil in DIL_PATTERNS:
        dist = jnp.arange(win // dil + 1, dtype=jnp.int32) * dil
        idx = q_idx[:, None] - dist[None, :]
        valid = idx >= 0
        idx = jnp.maximum(idx, 0)
        kg = k_all[:, idx]
        vg = v_all[:, idx]
        s = jnp.einsum('bqhd,bqjhd->bhqj', q, kg).astype(jnp.float32) * (ATT_DH ** -0.5)
        s = s - slopes[:, None, None] * dist.astype(jnp.float32)
        s = jnp.where(valid[None, None], s, -jnp.inf)
        m = jnp.max(s, axis=-1, keepdims=True)
        p = jnp.exp(s - m)
        den = jnp.sum(p, axis=-1, keepdims=True)
        o = jnp.einsum('bhqj,bqjhd->bhqd', p.astype(vg.dtype), vg).astype(jnp.float32) / den
        lses.append(m + jnp.log(den))
        outs.append(o)
    w = jax.nn.softmax(jnp.stack(lses), axis=0)
    out = jnp.sum(w * jnp.stack(outs), axis=0)
    return out.transpose(0, 2, 1, 3).astype(q.dtype)


def dilated_attention(q, k_all, v_all, q_idx):
    B, T, H, Dh = q.shape
    if T % Q_BLOCK == 0 and T > Q_BLOCK:
        nb = T // Q_BLOCK
        qb = q.reshape(B, nb, Q_BLOCK, H, Dh).transpose(1, 0, 2, 3, 4)
        ib = q_idx.reshape(nb, Q_BLOCK)
        ob = lax.map(lambda a: dilated_block(a[0], k_all, v_all, a[1]), (qb, ib))
        return ob.transpose(1, 0, 2, 3, 4).reshape(B, T, H, Dh)
    return dilated_block(q, k_all, v_all, q_idx)


def hgrn2_recurrence(q, k, v, logf, s0):
    B, T, H, DK = q.shape
    DV = v.shape[-1]
    C = math.gcd(T, HG_CHUNK)
    n = T // C

    def to_chunks(a):
        return a.reshape(B, n, C, H, a.shape[-1]).transpose(1, 0, 3, 2, 4)

    causal = jnp.tril(jnp.ones((C, C), dtype=bool))[None, None, :, :, None]

    def step(S, inp):
        qc, kc, vc, gc = inp
        b = jnp.cumsum(gc, axis=2)
        decay = jnp.exp(jnp.where(causal, b[:, :, :, None, :] - b[:, :, None, :, :], -jnp.inf))
        a = jnp.einsum('bhtk,bhsk,bhtsk->bhts', qc, kc, decay)
        o = jnp.einsum('bhts,bhsv->bhtv', a, vc) + jnp.einsum('bhtk,bhkv->bhtv', qc * jnp.exp(b), S)
        b_last = b[:, :, -1, :]
        S = jnp.exp(b_last)[..., None] * S + jnp.einsum('bhsk,bhsv->bhkv', kc * jnp.exp(b_last[:, :, None, :] - b), vc)
        return S, o

    s_fin, o = lax.scan(step, s0.astype(jnp.float32), (to_chunks(q), to_chunks(k), to_chunks(v), to_chunks(logf)))
    o = o.transpose(1, 0, 3, 2, 4).reshape(B, T, H, DV)
    return o, s_fin


def hgrn_lower_bound(lb_logits, layer):
    probs = jax.nn.softmax(lb_logits.astype(jnp.float32), axis=0)
    return jnp.cumsum(probs, axis=0)[layer]


def memory_kv(mem, norm_mem, w_ck, w_cv):
    B = mem.shape[0]
    m = rmsnorm(mem, norm_mem)
    return ((m @ w_ck).reshape(B, N_MEM, X_H, X_DH), (m @ w_cv).reshape(B, N_MEM, X_H, X_DH))


def decoder_layer(x, k_past, v_past, hg_s0, conv_buf, mem_k, mem_v, lb,
                  norm_mix, w_in, att_out_norm, hg_out_norm, w_out,
                  norm_cross, w_cq, w_co, norm_ffn, w_gate, w_up, conv_w, conv_b, w_down):
    B, T, _ = x.shape
    P = k_past.shape[1]
    f32 = jnp.float32
    h = rmsnorm(x, norm_mix)
    z = h @ w_in
    aq, ak, av, hq, hf, hi, hg = jnp.split(z, IN_SPLITS, axis=-1)
    aq = aq.reshape(B, T, ATT_H, ATT_DH)
    ak = ak.reshape(B, T, ATT_H, ATT_DH)
    av = av.reshape(B, T, ATT_H, ATT_DH)
    k_all = jnp.concatenate([k_past.astype(ak.dtype), ak], axis=1)
    v_all = jnp.concatenate([v_past.astype(av.dtype), av], axis=1)
    q_idx = P + jnp.arange(T, dtype=jnp.int32)
    att = dilated_attention(aq, k_all, v_all, q_idx)
    att = head_rmsnorm(att, att_out_norm).astype(x.dtype)
    f = lb + (1.0 - lb) * jax.nn.sigmoid(hf.astype(f32))
    qh = jax.nn.silu(hq.astype(f32)) * (HG_DK ** -0.5)
    o, s_new = hgrn2_recurrence(qh.reshape(B, T, HG_H, HG_DK), (1.0 - f).reshape(B, T, HG_H, HG_DK),
                                hi.astype(f32).reshape(B, T, HG_H, HG_DV), jnp.log(f).reshape(B, T, HG_H, HG_DK), hg_s0)
    o = (head_rmsnorm(o, hg_out_norm) * jax.nn.silu(hg.astype(f32))).astype(x.dtype)
    x = x + jnp.concatenate([att, o], axis=-1) @ w_out
    c = rmsnorm(x, norm_cross)
    cq = (c @ w_cq).reshape(B, T, X_H, X_DH)
    s = jnp.einsum('bthd,bmhd->bhtm', cq, mem_k.astype(cq.dtype)).astype(f32) * (X_DH ** -0.5)
    pr = jax.nn.softmax(s, axis=-1)
    co = jnp.einsum('bhtm,bmhd->bthd', pr.astype(x.dtype), mem_v.astype(x.dtype)).reshape(B, T, X_W)
    x = x + co @ w_co
    u = rmsnorm(x, norm_ffn)
    ug = u @ w_gate
    up = jnp.concatenate([conv_buf.astype(ug.dtype), ug], axis=1)
    conv = conv_b + sum(conv_w[j] * up[:, j:j + T] for j in range(CONV_W))
    x = x + (jax.nn.silu(conv) * (u @ w_up)) @ w_down
    return x, ak, av, s_new, up[:, -(CONV_W - 1):]


def setup_inputs(seed: int = 0) -> dict:
    key = jax.random.key(seed)
    ks = iter(jax.random.split(key, 40))
    nrm = lambda shape, scale=1.0: jax.random.normal(next(ks), shape, jnp.float32) * scale
    gain = lambda shape: 1.0 + 0.02 * jax.random.normal(next(ks), shape, jnp.float32)
    win_buf = min(MAX_WINDOW, PAST_LEN)
    return {
        'x_prompt': nrm((BATCH, SEQ, D_MODEL)),
        'x_sample': nrm((DEC_BATCH, DEC_SEQ, D_MODEL)),
        'cache_win_k': nrm((DEPTH, DEC_BATCH, win_buf, ATT_H, ATT_DH)),
        'cache_win_v': nrm((DEPTH, DEC_BATCH, win_buf, ATT_H, ATT_DH)),
        'state_hgrn': nrm((DEPTH, DEC_BATCH, HG_H, HG_DK, HG_DV), 0.1),
        'state_ffn_conv': nrm((DEPTH, DEC_BATCH, CONV_W - 1, D_FF)),
        'cache_mem_k': nrm((DEPTH, DEC_BATCH, N_MEM, X_H, X_DH)),
        'cache_mem_v': nrm((DEPTH, DEC_BATCH, N_MEM, X_H, X_DH)),
        'mem_prompt': nrm((BATCH, N_MEM, D_MODEL)),
        'hg_lb_logits': nrm((DEPTH + 1, HG_W)),
        'norm_mix': gain((DEPTH, D_MODEL)),
        'w_in': nrm((DEPTH, D_MODEL, IN_COLS), D_MODEL ** -0.5),
        'att_out_norm': gain((DEPTH, ATT_W)),
        'hg_out_norm': gain((DEPTH, HG_W)),
        'w_out': nrm((DEPTH, MIX_W, D_MODEL), MIX_W ** -0.5),
        'norm_cross': gain((DEPTH, D_MODEL)),
        'norm_mem': gain((DEPTH, D_MODEL)),
        'w_cq': nrm((DEPTH, D_MODEL, X_W), D_MODEL ** -0.5),
        'w_ck': nrm((DEPTH, D_MODEL, X_W), D_MODEL ** -0.5),
        'w_cv': nrm((DEPTH, D_MODEL, X_W), D_MODEL ** -0.5),
        'w_co': nrm((DEPTH, X_W, D_MODEL), X_W ** -0.5),
        'norm_ffn': gain((DEPTH, D_MODEL)),
        'w_gate': nrm((DEPTH, D_MODEL, D_FF), D_MODEL ** -0.5),
        'w_up': nrm((DEPTH, D_MODEL, D_FF), D_MODEL ** -0.5),
        'conv_w': nrm((DEPTH, CONV_W, D_FF), CONV_W ** -0.5),
        'conv_b': nrm((DEPTH, D_FF), 0.01),
        'w_down': nrm((DEPTH, D_FF, D_MODEL), D_FF ** -0.5),
        'norm_final': gain((D_MODEL,)),
    }


def reference(x_prompt, x_sample, cache_win_k, cache_win_v, state_hgrn, state_ffn_conv, cache_mem_k, cache_mem_v,
              mem_prompt, hg_lb_logits, norm_mix, w_in, att_out_norm, hg_out_norm, w_out, norm_cross, norm_mem,
              w_cq, w_ck, w_cv, w_co, norm_ffn, w_gate, w_up, conv_w, conv_b, w_down, norm_final):
    Bp, T, _ = x_prompt.shape
    keep = min(MAX_WINDOW, T)
    yp, ys = x_prompt, x_sample
    pk, pv, ps, pc, pmk, pmv = [], [], [], [], [], []
    sk, sv, ss, sc = [], [], [], []
    for l in range(DEPTH):
        lb = hgrn_lower_bound(hg_lb_logits, l)
        weights = (norm_mix[l], w_in[l], att_out_norm[l], hg_out_norm[l], w_out[l], norm_cross[l], w_cq[l], w_co[l],
                   norm_ffn[l], w_gate[l], w_up[l], conv_w[l], conv_b[l], w_down[l])
        mk, mv = memory_kv(mem_prompt, norm_mem[l], w_ck[l], w_cv[l])
        empty = jnp.zeros((Bp, 0, ATT_H, ATT_DH), x_prompt.dtype)
        yp, k_new, v_new, s_new, c_new = decoder_layer(
            yp, empty, empty, jnp.zeros((Bp, HG_H, HG_DK, HG_DV), jnp.float32),
            jnp.zeros((Bp, CONV_W - 1, D_FF), x_prompt.dtype), mk, mv, lb, *weights)
        pk.append(k_new[:, T - keep:])
        pv.append(v_new[:, T - keep:])
        ps.append(s_new)
        pc.append(c_new)
        pmk.append(mk)
        pmv.append(mv)
        ys, k_new, v_new, s_new, c_new = decoder_layer(
            ys, cache_win_k[l], cache_win_v[l], state_hgrn[l], state_ffn_conv[l], cache_mem_k[l], cache_mem_v[l],
            lb, *weights)
        sk.append(k_new)
        sv.append(v_new)
        ss.append(s_new)
        sc.append(c_new)
    yp = rmsnorm(yp, norm_final)
    ys = rmsnorm(ys, norm_final)
    return (yp, ys, jnp.stack(pk), jnp.stack(pv), jnp.stack(ps), jnp.stack(pc), jnp.stack(pmk), jnp.stack(pmv),
            jnp.stack(sk), jnp.stack(sv), jnp.stack(ss), jnp.stack(sc))
```

```cpp
#include <hip/hip_runtime.h>
#include <hip/hip_cooperative_groups.h>
#include <cstdio>
#include <cstdint>
namespace cg = cooperative_groups;
#ifndef MK_N_LAUNCHES
#define MK_N_LAUNCHES 1
#endif
#ifndef REP_MASK
#define REP_MASK 0
#endif
#define REPS(k) for (int rep_ = 0; rep_ < 1 + ((REP_MASK >> (k)) & 1); ++rep_)
namespace pg8 {
#define PG8_LAS __attribute__((address_space(3)))
typedef unsigned short bf16_t;
typedef short bf16x8 __attribute__((ext_vector_type(8)));
typedef float f32x4 __attribute__((ext_vector_type(4)));
typedef unsigned u32x4 __attribute__((ext_vector_type(4)));
constexpr int BM = 256, BK = 64, HALF = 128, HTB = HALF * BK * 2  , STAGE_BYTES = 8 * HTB, NXCD = 8, WGM = 8;

__host__ __device__ __forceinline__ int lds_byte(int r, int c) { const int st = (r >> 4) * 2 + (c >> 5), rr = r & 15, cc = c & 31, ob = rr * 64 + cc * 2; return st * 1024 + (ob ^ (((ob >> 9) & 1) << 5)); }
__host__ __device__ __forceinline__ void stage_rc(int b, int& R, int& C) { const int st = b / 1024, sb = b % 1024, swz = sb ^ (((sb >> 9) & 1) << 5); R = (st >> 1) * 16 + swz / 64; C = (st & 1) * 32 + (swz % 64) / 2; }
__host__ __device__ __forceinline__ int perm32(int rho) { const int n = rho >> 4, i = rho & 15; return 8 * (i >> 2) + 4 * n + (i & 3); }

struct Unit { int pm, pn; };
struct Gemm { const bf16_t* A; const bf16_t* Bt; int M, N, K; };

struct StaticOrder {
    int nM, nN, nwg, G, c;
    __host__ __device__ void init(int M, int N, int G_, int c_) { nM = M / BM; nN = N / BM; nwg = nM * nN; G = G_; c = c_; }
    __host__ __device__ bool next(int i, Unit& u) const {
        const long L = (long)i * G + c; if (L >= nwg) return false;
        int wgid = (int)L; { const int q = nwg / NXCD, r = nwg % NXCD, xcd = wgid % NXCD, off = wgid / NXCD; wgid = (xcd < r ? xcd * (q + 1) : r * (q + 1) + (xcd - r) * q) + off; }
        const int nig = WGM * nN, gid = wgid / nig, fm = gid * WGM, gsz = (nM - fm) < WGM ? (nM - fm) : WGM;
        u.pm = fm + ((wgid % nig) % gsz); u.pn = (wgid % nig) / gsz; return true;
    }
    __device__ __forceinline__ void a_ready(const Unit&) const {}
    __device__ __forceinline__ void done(const Unit&) const {}
};


template <class Epi, class Sched, bool ALIGN_EPI = false, bool SP2 = false>
__device__ __forceinline__ void gemm_phase(PG8_LAS unsigned char* lds, const Gemm g, const Sched& S, const Epi& E) {
    const int tid = threadIdx.x, wid = __builtin_amdgcn_readfirstlane(tid >> 6), lane = tid & 63, wr = wid >> 2, wc = wid & 3, fr = lane & 15, fq = lane >> 4;
    const int K = g.K, nt = K / BK;
    unsigned voffA[2], voffB[2];
#pragma unroll
    for (int i = 0; i < 2; ++i) { int R, C; stage_rc(tid * 16 + i * 8192, R, C); const int Rb = Epi::PERM ? ((R & ~31) + perm32(R & 31)) : R;
        voffA[i] = (unsigned)(R * K + C) * 2u; voffB[i] = (unsigned)(Rb * K + C) * 2u; }
    const size_t kstep = (size_t)(BK * 2);
    const size_t hstep = (size_t)HALF * K * 2;
    const size_t tstep = 2 * hstep;
    const unsigned ldsw = (unsigned)wid * 1024u;
    const int aoff = lds_byte(wr * 64 + fr, fq * 8), boff = lds_byte(wc * 32 + fr, fq * 8);
#define PG8_SA(b, h) (((b) * 2 + (h)) * HTB)
#define PG8_SB(b, h) ((4 + (b) * 2 + (h)) * HTB)
#define PG8_STAGE(bufoff, gbase, voff) do { _Pragma("unroll") for (int _i = 0; _i < 2; ++_i) \
        __builtin_amdgcn_global_load_lds((const unsigned*)((const char*)(gbase) + (voff)[_i]), (PG8_LAS unsigned*)(lds + (bufoff) + ldsw + _i * 8192), 16, 0, 0); } while (0)
#define PG8_LDA(dst, b, h) do { _Pragma("unroll") for (int m = 0; m < 4; ++m) _Pragma("unroll") for (int k = 0; k < 2; ++k) dst[m][k] = *(const PG8_LAS bf16x8*)(lds + PG8_SA(b, h) + aoff + m * 2048 + k * 1024); } while (0)
#define PG8_LDB(dst, b, h) do { _Pragma("unroll") for (int n = 0; n < 2; ++n) _Pragma("unroll") for (int k = 0; k < 2; ++k) dst[n][k] = *(const PG8_LAS bf16x8*)(lds + PG8_SB(b, h) + boff + n * 2048 + k * 1024); } while (0)
#define PG8_MMA(ai, bj, At, Bt) do { __builtin_amdgcn_s_setprio(1); _Pragma("unroll") for (int m = 0; m < 4; ++m) _Pragma("unroll") for (int n = 0; n < 2; ++n) _Pragma("unroll") for (int k = 0; k < 2; ++k) \
        acc[ai][bj][m][n] = __builtin_amdgcn_mfma_f32_16x16x32_bf16(Bt[n][k], At[m][k], acc[ai][bj][m][n], 0, 0, 0); __builtin_amdgcn_s_setprio(0); } while (0)
#define PG8_WAIT_V(n) asm volatile("s_waitcnt vmcnt(" #n ")" ::: "memory")
#define PG8_WAIT_L(n) asm volatile("s_waitcnt lgkmcnt(" #n ")" ::: "memory")
#define PG8_BAR __builtin_amdgcn_s_barrier()
#define PG8_SCHED __builtin_amdgcn_sched_barrier(0)
    Unit cur, nxt; int ui = 0;
    if (!S.next(0, cur)) return;
    f32x4 acc[2][2][4][2];
#pragma unroll
    for (int a = 0; a < 2; ++a)
#pragma unroll
        for (int b = 0; b < 2; ++b)
#pragma unroll
            for (int m = 0; m < 4; ++m)
#pragma unroll
                for (int n = 0; n < 2; ++n) acc[a][b][m][n] = (f32x4){0.f, 0.f, 0.f, 0.f};
    bf16x8 At[4][2], B0[2][2], B1[2][2];
    const char* cA = (const char*)g.A + (size_t)cur.pm * tstep; const char* cB = (const char*)g.Bt + (size_t)cur.pn * tstep;
    S.a_ready(cur);
    if constexpr (SP2) {
        PG8_STAGE(PG8_SB(0, 0), cB, voffB); PG8_STAGE(PG8_SB(0, 1), cB + hstep, voffB); PG8_STAGE(PG8_SA(0, 0), cA, voffA); PG8_STAGE(PG8_SA(0, 1), cA + hstep, voffA);
        if (wr == 1) PG8_BAR;
        PG8_WAIT_V(2); PG8_BAR;
        PG8_STAGE(PG8_SB(1, 0), cB + kstep, voffB); PG8_STAGE(PG8_SA(1, 0), cA + kstep, voffA); PG8_STAGE(PG8_SB(1, 1), cB + hstep + kstep, voffB);
        PG8_WAIT_V(6); PG8_BAR;
    } else {
        PG8_STAGE(PG8_SB(0, 0), cB, voffB); PG8_STAGE(PG8_SA(0, 0), cA, voffA); PG8_STAGE(PG8_SB(0, 1), cB + hstep, voffB); PG8_STAGE(PG8_SA(0, 1), cA + hstep, voffA);
        if (wr == 1) PG8_BAR;
        PG8_WAIT_V(4); PG8_BAR;
        PG8_STAGE(PG8_SB(1, 0), cB + kstep, voffB); PG8_STAGE(PG8_SA(1, 0), cA + kstep, voffA); PG8_STAGE(PG8_SB(1, 1), cB + hstep + kstep, voffB);
        PG8_WAIT_V(6); PG8_BAR;
    }
    for (;;) {
        const bool has_next = S.next(ui + 1, nxt);
        const char* nA = has_next ? (const char*)g.A + (size_t)nxt.pm * tstep : cA; const char* nB = has_next ? (const char*)g.Bt + (size_t)nxt.pn * tstep : cB;
        for (int t = 0; t < nt; t += 2) {
            const bool last = (t == nt - 2);
            const char* a1 = cA + (size_t)(t + 1) * kstep;
            const char* a2 = last ? nA : cA + (size_t)(t + 2) * kstep; const char* b2 = last ? nB : cB + (size_t)(t + 2) * kstep;
            const char* a3 = a2 + kstep; const char* b3 = b2 + kstep;
            if (last && has_next) S.a_ready(nxt);
            if constexpr (SP2) {
            PG8_LDB(B0, 0, 0); PG8_LDB(B1, 0, 1); PG8_SCHED; PG8_LDA(At, 0, 0); PG8_STAGE(PG8_SA(1, 1), a1 + hstep, voffA);
            PG8_WAIT_V(8); PG8_WAIT_L(0); PG8_BAR; PG8_MMA(0, 0, At, B0); PG8_MMA(0, 1, At, B1); PG8_BAR; PG8_SCHED;
            PG8_LDA(At, 0, 1); PG8_STAGE(PG8_SB(0, 0), b2, voffB); PG8_STAGE(PG8_SB(0, 1), b2 + hstep, voffB); PG8_STAGE(PG8_SA(0, 0), a2, voffA);
            PG8_WAIT_V(8); PG8_WAIT_L(0); PG8_BAR; PG8_MMA(1, 0, At, B0); PG8_MMA(1, 1, At, B1); PG8_BAR; PG8_SCHED;
            PG8_LDB(B0, 1, 0); PG8_LDB(B1, 1, 1); PG8_SCHED; PG8_LDA(At, 1, 0); PG8_STAGE(PG8_SA(0, 1), a2 + hstep, voffA);
            PG8_WAIT_V(8); PG8_WAIT_L(0); PG8_BAR; PG8_MMA(0, 0, At, B0); PG8_MMA(0, 1, At, B1); PG8_BAR; PG8_SCHED;
            PG8_LDA(At, 1, 1); PG8_STAGE(PG8_SB(1, 0), b3, voffB); PG8_STAGE(PG8_SB(1, 1), b3 + hstep, voffB); PG8_STAGE(PG8_SA(1, 0), a3, voffA);
            PG8_WAIT_V(8); PG8_WAIT_L(0); PG8_BAR; PG8_MMA(1, 0, At, B0); PG8_MMA(1, 1, At, B1); PG8_BAR; PG8_SCHED;
            } else {
            PG8_LDB(B0, 0, 0); PG8_SCHED; PG8_LDA(At, 0, 0); PG8_STAGE(PG8_SA(1, 1), a1 + hstep, voffA);
            PG8_WAIT_L(8); PG8_BAR; PG8_WAIT_L(0); PG8_MMA(0, 0, At, B0); PG8_BAR; PG8_SCHED;
            PG8_LDB(B1, 0, 1); PG8_STAGE(PG8_SB(0, 0), b2, voffB);
            PG8_BAR; PG8_WAIT_L(0); PG8_MMA(0, 1, At, B1); PG8_BAR;
            PG8_LDA(At, 0, 1); PG8_STAGE(PG8_SA(0, 0), a2, voffA);
            PG8_BAR; PG8_WAIT_L(0); PG8_MMA(1, 0, At, B0); PG8_BAR; PG8_SCHED;
            PG8_STAGE(PG8_SB(0, 1), b2 + hstep, voffB);
            PG8_WAIT_V(6); PG8_BAR; PG8_MMA(1, 1, At, B1); PG8_BAR;
            PG8_LDB(B0, 1, 0); PG8_SCHED; PG8_LDA(At, 1, 0); PG8_STAGE(PG8_SA(0, 1), a2 + hstep, voffA);
            PG8_WAIT_L(8); PG8_BAR; PG8_WAIT_L(0); PG8_MMA(0, 0, At, B0); PG8_BAR; PG8_SCHED;
            PG8_LDB(B1, 1, 1); PG8_STAGE(PG8_SB(1, 0), b3, voffB);
            PG8_BAR; PG8_WAIT_L(0); PG8_MMA(0, 1, At, B1); PG8_BAR;
            PG8_LDA(At, 1, 1); PG8_STAGE(PG8_SA(1, 0), a3, voffA);
            PG8_BAR; PG8_WAIT_L(0); PG8_MMA(1, 0, At, B0); PG8_BAR; PG8_SCHED;
            PG8_STAGE(PG8_SB(1, 1), b3 + hstep, voffB);
            PG8_WAIT_V(6); PG8_BAR; PG8_MMA(1, 1, At, B1); PG8_BAR;
            }
        }
        if constexpr (ALIGN_EPI) { if (wr == 0) PG8_BAR; }
        if constexpr (!Epi::AFTER_DRAIN) { E(acc, cur, wr, wc, fr, fq); S.done(cur); }
        if (!has_next) break;
#pragma unroll
        for (int a = 0; a < 2; ++a)
#pragma unroll
            for (int b = 0; b < 2; ++b)
#pragma unroll
                for (int m = 0; m < 4; ++m)
#pragma unroll
                    for (int n = 0; n < 2; ++n) acc[a][b][m][n] = (f32x4){0.f, 0.f, 0.f, 0.f};
        cur = nxt; cA = nA; cB = nB; ++ui;
        if constexpr (ALIGN_EPI) { if (wr == 1) PG8_BAR; }
    }
    PG8_WAIT_V(0);
    if constexpr (!ALIGN_EPI) { if (wr == 0) PG8_BAR; }
    PG8_BAR;
    if constexpr (Epi::AFTER_DRAIN) { E.fused(acc, cur, wr, wc, fr, fq, lds, wid, lane); S.done(cur); }
#undef PG8_SA
#undef PG8_SB
#undef PG8_STAGE
#undef PG8_LDA
#undef PG8_LDB
#undef PG8_MMA
#undef PG8_WAIT_V
#undef PG8_WAIT_L
#undef PG8_BAR
#undef PG8_SCHED
}
}
using pg8::bf16_t; using pg8::bf16x8; using pg8::f32x4; using pg8::u32x4; using pg8::Unit;
typedef short s16x4 __attribute__((ext_vector_type(4)));
typedef unsigned u32x2 __attribute__((ext_vector_type(2)));
#define LAS __attribute__((address_space(3)))
constexpr int MP = 16384, MSAMP = 128, MT = MP + MSAMP, MPAD = 16640, DM = 1024, SEQ = 4096, DFF = 2816;
constexpr float EPS = 1e-6f, LOG2E = 1.4426950408889634f;
constexpr float QSCALE = 0.125f * LOG2E;
constexpr float CQSCALE = 0.08838834764831845f * LOG2E;
constexpr float HQSCALE = 0.08838834764831845f;
constexpr size_t O_Y = 0, O_WKP = 16908288, O_WVP = 21102592, O_HSP = 25296896, O_FCP = 25559040, O_MKP = 25581568, O_MVP = 26105856,
                 O_WKS = 26630144, O_WVS = 26695680, O_HSS = 26761216, O_FCS = 28858368;
constexpr size_t MiB = 1u << 20;
constexpr size_t WS_WIN = 0, WS_WOUT = 7 * MiB, WS_WCQ = 9 * MiB, WS_WCKV = 10 * MiB, WS_WCO = 12 * MiB, WS_WGU = 13 * MiB, WS_WD = 24 * MiB,
                 WS_LB = 30 * MiB, WS_SS1 = WS_LB + 4096, WS_SS2 = WS_SS1 + 256 * 1024, WS_XN = 32 * MiB, WS_CQ = 65 * MiB, WS_CO = 82 * MiB,
                 WS_MKB = 99 * MiB, WS_MVB = 100 * MiB, WS_MN = 101 * MiB,
                 WS_QB = 104 * MiB, WS_KB = 121 * MiB, WS_VB = 138 * MiB, WS_QH = 155 * MiB, WS_VH = 172 * MiB, WS_GH = 189 * MiB, WS_LF = 206 * MiB,
                 WS_VT = 239 * MiB, WS_KV = 255 * MiB, WS_SP = 319 * MiB, WS_MIX = 351 * MiB,
                 WS_UG = 104 * MiB, WS_UP = 194 * MiB, WS_ACT = 284 * MiB;
constexpr size_t WS_SS3 = 30 * MiB + 600 * 1024, WS_CNT = 30 * MiB + 800 * 1024, WS_BAR = 31 * MiB, WS_EDGE = 375 * MiB, WS_PART = 377 * MiB, WS_UPV = 379 * MiB, WS_UGS = 381 * MiB, WS_UPS = 382 * MiB;
constexpr int LDS_BYTES = 147456, LDS_BARST = 147456 - 64;

struct Args { const float* in[28]; float* out; unsigned char* ws; int ph_lo, ph_hi; };

typedef float f32x2_t __attribute__((ext_vector_type(2))); typedef __bf16 bf16x2_t __attribute__((ext_vector_type(2)));
__device__ __forceinline__ unsigned pk2(float lo, float hi) { unsigned r; asm volatile("v_cvt_pk_bf16_f32 %0, %1, %2" : "=v"(r) : "v"(lo), "v"(hi)); return r; }
__device__ __forceinline__ unsigned pk2m(float lo, float hi) { const f32x2_t v = {lo, hi}; const bf16x2_t b = __builtin_convertvector(v, bf16x2_t); return __builtin_bit_cast(unsigned, b); }
__device__ __forceinline__ float bflo(unsigned w) { return __uint_as_float(w << 16); }
__device__ __forceinline__ float bfhi(unsigned w) { return __uint_as_float(w & 0xffff0000u); }
__device__ __forceinline__ float bf1(bf16_t h) { return __uint_as_float((unsigned)h << 16); }
__device__ __forceinline__ void store_bf16x8(bf16_t* p, f32x4 a, f32x4 b) { u32x4 w; w.x = pk2(a[0], a[1]); w.y = pk2(a[2], a[3]); w.z = pk2(b[0], b[1]); w.w = pk2(b[2], b[3]); *(u32x4*)p = w; }
__device__ __forceinline__ float wave_sum(float v) {
#pragma unroll
    for (int o = 1; o < 64; o <<= 1) v += __shfl_xor(v, o);
    return v;
}
__device__ __forceinline__ float wave_max(float v) {
#pragma unroll
    for (int o = 1; o < 64; o <<= 1) v = fmaxf(v, __shfl_xor(v, o));
    return v;
}
__device__ __forceinline__ float xg_max(float x) {
    auto s = __builtin_amdgcn_permlane16_swap(__float_as_uint(x), __float_as_uint(x), false, false); x = fmaxf(__uint_as_float(s[0]), __uint_as_float(s[1]));
    auto u = __builtin_amdgcn_permlane32_swap(__float_as_uint(x), __float_as_uint(x), false, false); return fmaxf(__uint_as_float(u[0]), __uint_as_float(u[1]));
}
__device__ __forceinline__ float xg_sum(float x) {
    auto s = __builtin_amdgcn_permlane16_swap(__float_as_uint(x), __float_as_uint(x), false, false); x = __uint_as_float(s[0]) + __uint_as_float(s[1]);
    auto u = __builtin_amdgcn_permlane32_swap(__float_as_uint(x), __float_as_uint(x), false, false); return __uint_as_float(u[0]) + __uint_as_float(u[1]);
}
__device__ __forceinline__ float silu_f(float x) { return x * __builtin_amdgcn_rcpf(1.f + __expf(-x)); }
__device__ __forceinline__ float ex2(float x) { return __builtin_amdgcn_exp2f(x); }

#define EPI_ROWS_BEGIN  _Pragma("unroll") for (int ai = 0; ai < 2; ++ai) _Pragma("unroll") for (int m = 0; m < 4; ++m) { const int row = u.pm * 256 + ai * 128 + wr * 64 + m * 16 + fr;
#define EPI_ROWS_END }

struct EpiIn {
    static constexpr bool PERM = true, AFTER_DRAIN = false;
    bf16_t *Qb, *Kb, *Vb, *QH, *VH, *GH, *VT; float* LF; const float* LB; float* out;
    __device__ __forceinline__ void operator()(const f32x4 (&acc)[2][2][4][2], const Unit& u, int wr, int wc, int fr, int fq) const {
        const int grp = u.pn >> 1;
        EPI_ROWS_BEGIN
            if (row >= MT) continue;
#pragma unroll
            for (int bj = 0; bj < 2; ++bj) {
                const int cc = (u.pn & 1) * 256 + bj * 128 + wc * 32 + 8 * fq;
                f32x4 v0 = acc[ai][bj][m][0], v1 = acc[ai][bj][m][1];
                const size_t o = (size_t)row * 512 + cc;
                if (grp == 0) { store_bf16x8(Qb + o, v0 * QSCALE, v1 * QSCALE); }
                else if (grp == 1 || grp == 2) {
                    store_bf16x8((grp == 1 ? Kb : Vb) + o, v0, v1);
                    float* dst = nullptr;
                    if (row >= MP) dst = out + (grp == 1 ? O_WKS : O_WVS) + (size_t)(row - MP) * 512 + cc;
                    else { const int t = row & 4095, b = row >> 12; if (t >= 2048) dst = out + (grp == 1 ? O_WKP : O_WVP) + (size_t)(b * 2048 + t - 2048) * 512 + cc; }
                    if (dst) { *(f32x4*)dst = v0; *(f32x4*)(dst + 4) = v1; }
                } else if (grp == 3) {
#pragma unroll
                    for (int j = 0; j < 4; ++j) { v0[j] = silu_f(v0[j]) * HQSCALE; v1[j] = silu_f(v1[j]) * HQSCALE; }
                    store_bf16x8(QH + o, v0, v1);
                } else if (grp == 4) {
                    const f32x4 l0 = *(const f32x4*)(LB + cc), l1 = *(const f32x4*)(LB + cc + 4);
#pragma unroll
                    for (int j = 0; j < 4; ++j) { v0[j] = __logf(l0[j] + (1.f - l0[j]) * __builtin_amdgcn_rcpf(1.f + __expf(-v0[j]))); v1[j] = __logf(l1[j] + (1.f - l1[j]) * __builtin_amdgcn_rcpf(1.f + __expf(-v1[j]))); }
                    *(f32x4*)(LF + o) = v0; *(f32x4*)(LF + o + 4) = v1;
                } else if (grp == 5) {
                    store_bf16x8(VH + o, v0, v1);
                    if (row < MP) { const int t = row & 4095, b = row >> 12; bf16_t* vt = VT + (size_t)(b * 512 + cc) * 4096 + t;
#pragma unroll
                        for (int j = 0; j < 4; ++j) { vt[(size_t)j * 4096] = (bf16_t)(pk2(v0[j], 0.f) & 0xffffu); vt[(size_t)(j + 4) * 4096] = (bf16_t)(pk2(v1[j], 0.f) & 0xffffu); } }
                } else { store_bf16x8(GH + o, v0, v1); }
            }
        EPI_ROWS_END
    }
};

struct EpiMem {
    static constexpr bool PERM = true, AFTER_DRAIN = false;
    bf16_t *MKB, *MVB; float* out;
    __device__ __forceinline__ void operator()(const f32x4 (&acc)[2][2][4][2], const Unit& u, int wr, int wc, int fr, int fq) const {
        const bool isv = u.pn >= 2;
        EPI_ROWS_BEGIN
#pragma unroll
            for (int bj = 0; bj < 2; ++bj) {
                const int cc = (u.pn & 1) * 256 + bj * 128 + wc * 32 + 8 * fq;
                const f32x4 v0 = acc[ai][bj][m][0], v1 = acc[ai][bj][m][1];
                const size_t o = (size_t)row * 512 + cc;
                store_bf16x8((isv ? MVB : MKB) + o, v0, v1);
                float* dst = out + (isv ? O_MVP : O_MKP) + o; *(f32x4*)dst = v0; *(f32x4*)(dst + 4) = v1;
            }
        EPI_ROWS_END
    }
};

template <int MODE> struct EpiRes {
    static constexpr bool PERM = true, AFTER_DRAIN = false;
    const float* xin; float* out; bf16_t* XN; unsigned long long* ss;
    __device__ __forceinline__ void operator()(const f32x4 (&acc)[2][2][4][2], const Unit& u, int wr, int wc, int fr, int fq) const {
        EPI_ROWS_BEGIN
            float sq = 0.f;
#pragma unroll
            for (int bj = 0; bj < 2; ++bj) {
                const int col = u.pn * 256 + bj * 128 + wc * 32 + 8 * fq;
                f32x4 v0 = acc[ai][bj][m][0], v1 = acc[ai][bj][m][1];
                const size_t o = (size_t)row * DM + col;
                if (MODE == 0) { v0 += *(const f32x4*)(xin + o); v1 += *(const f32x4*)(xin + o + 4); }
                else { const u32x4 w = *(const u32x4*)(XN + o); v0 += (f32x4){bflo(w.x), bfhi(w.x), bflo(w.y), bfhi(w.y)}; v1 += (f32x4){bflo(w.z), bfhi(w.z), bflo(w.w), bfhi(w.w)}; }
                if (MODE == 2) { store_bf16x8(XN + o, v0, v1); }
                else { store_bf16x8(XN + o, v0, v1);
                    sq += (v0[0] * v0[0] + v0[1] * v0[1]) + (v0[2] * v0[2] + v0[3] * v0[3]) + (v1[0] * v1[0] + v1[1] * v1[1]) + (v1[2] * v1[2] + v1[3] * v1[3]); }
            }
            if (MODE != 2) { sq = xg_sum(sq); if (fq == 0) atomicAdd(ss + row, (unsigned long long)(sq * 16777216.f)); }
        EPI_ROWS_END
    }
};
struct EpiFinal {
    static constexpr bool PERM = true, AFTER_DRAIN = false;
    const bf16_t* XN; unsigned long long* ss3; unsigned* cnt; const float* g; float* out;
    __device__ __forceinline__ void operator()(const f32x4 (&acc_)[2][2][4][2], const Unit& u, int wr, int wc, int fr, int fq) const {
        f32x4 (&x)[2][2][4][2] = const_cast<f32x4 (&)[2][2][4][2]>(acc_);
        EPI_ROWS_BEGIN
            float sq = 0.f;
#pragma unroll
            for (int bj = 0; bj < 2; ++bj) {
                const int col = u.pn * 256 + bj * 128 + wc * 32 + 8 * fq;
                const u32x4 w = *(const u32x4*)(XN + ((unsigned)row * (unsigned)DM + (unsigned)col));
                f32x4 v0 = x[ai][bj][m][0] + (f32x4){bflo(w.x), bfhi(w.x), bflo(w.y), bfhi(w.y)}, v1 = x[ai][bj][m][1] + (f32x4){bflo(w.z), bfhi(w.z), bflo(w.w), bfhi(w.w)};
                x[ai][bj][m][0] = v0; x[ai][bj][m][1] = v1;
                sq += (v0[0] * v0[0] + v0[1] * v0[1]) + (v0[2] * v0[2] + v0[3] * v0[3]) + (v1[0] * v1[0] + v1[1] * v1[1]) + (v1[2] * v1[2] + v1[3] * v1[3]);
            }
            sq = xg_sum(sq);
            if (fq == 0) (void)__hip_atomic_fetch_add(ss3 + row, (unsigned long long)(sq * 16777216.f), __ATOMIC_RELAXED, __HIP_MEMORY_SCOPE_AGENT);
        EPI_ROWS_END
        asm volatile("s_waitcnt vmcnt(0) lgkmcnt(0)" ::: "memory"); __builtin_amdgcn_s_barrier(); asm volatile("" ::: "memory");
        if (threadIdx.x == 0) {
            unsigned* c = cnt + 64 * u.pm;
            (void)__hip_atomic_fetch_add(c, 1u, __ATOMIC_RELAXED, __HIP_MEMORY_SCOPE_AGENT);
            unsigned spins = 0;
            while (__hip_atomic_load(c, __ATOMIC_RELAXED, __HIP_MEMORY_SCOPE_AGENT) < 4u && ++spins < (1u << 22)) __builtin_amdgcn_s_sleep(2);
        }
        asm volatile("s_waitcnt vmcnt(0) lgkmcnt(0)" ::: "memory"); __builtin_amdgcn_s_barrier(); asm volatile("" ::: "memory");
        EPI_ROWS_BEGIN
            const unsigned long long sv = __hip_atomic_load(ss3 + row, __ATOMIC_RELAXED, __HIP_MEMORY_SCOPE_AGENT);
            const float r = rsqrtf((float)sv * (1.f / (16777216.f * DM)) + EPS);
#pragma unroll
            for (int bj = 0; bj < 2; ++bj) {
                const int col = u.pn * 256 + bj * 128 + wc * 32 + 8 * fq;
                const f32x4 g0 = *(const f32x4*)(g + col), g1 = *(const f32x4*)(g + col + 4);
                float* op = out + ((unsigned)row * (unsigned)DM + (unsigned)col);
                *(f32x4*)op = x[ai][bj][m][0] * r * g0; *(f32x4*)(op + 4) = x[ai][bj][m][1] * r * g1;
            }
        EPI_ROWS_END
    }
};
template <int MODE> __device__ __forceinline__ void mini_gemm_res(LAS unsigned char* lds, const bf16_t* A, const bf16_t* Bt, int K, const float* xin_s, float* out, bf16_t* XN, unsigned long long* ss, int tid, unsigned* cnt = nullptr, const float* gfin = nullptr) {
    const int bx = blockIdx.x, rg = bx & 7, cgp = bx >> 3, wave = tid >> 6, lane = tid & 63, lr = lane & 15, lg = lane >> 4;
    const int kw = K >> 3, k0 = wave * kw;
    const bf16_t* ap = A + (size_t)(MP + 16 * rg + lr) * K + k0 + lg * 8;
    const bf16_t* bp0 = Bt + (size_t)(32 * cgp + lr) * K + k0 + lg * 8; const bf16_t* bp1 = bp0 + (size_t)16 * K;
    f32x4 a0 = {0.f, 0.f, 0.f, 0.f}, a1 = a0;
#pragma unroll 11
    for (int ks = 0; ks < kw; ks += 32) { const bf16x8 af = *(const bf16x8*)(ap + ks);
        a0 = __builtin_amdgcn_mfma_f32_16x16x32_bf16(af, *(const bf16x8*)(bp0 + ks), a0, 0, 0, 0);
        a1 = __builtin_amdgcn_mfma_f32_16x16x32_bf16(af, *(const bf16x8*)(bp1 + ks), a1, 0, 0, 0); }
    LAS float* red = (LAS float*)lds;
    __syncthreads();
#pragma unroll
    for (int j = 0; j < 4; ++j) { red[(wave * 16 + lg * 4 + j) * 32 + lr] = a0[j]; red[(wave * 16 + lg * 4 + j) * 32 + 16 + lr] = a1[j]; }
    __syncthreads();
    const int m = tid >> 5, n = tid & 31;
    float v = 0.f;
#pragma unroll
    for (int w = 0; w < 8; ++w) v += red[(w * 16 + m) * 32 + n];
    const int row = MP + 16 * rg + m, col = 32 * cgp + n; const size_t o = (size_t)row * DM + col;
    if (MODE == 0) v += xin_s[(size_t)(row - MP) * DM + col]; else v += bf1(XN[o]);
    if (MODE != 2) XN[o] = (bf16_t)(pk2(v, 0.f) & 0xffffu);
    float sq = v * v;
#pragma unroll
    for (int s = 1; s < 32; s <<= 1) sq += __shfl_xor(sq, s);
    if (n == 0) (void)__hip_atomic_fetch_add(ss + row, (unsigned long long)(sq * 16777216.f), __ATOMIC_RELAXED, __HIP_MEMORY_SCOPE_AGENT);
    if (MODE == 2) {
        asm volatile("s_waitcnt vmcnt(0) lgkmcnt(0)" ::: "memory"); __syncthreads();
        if (tid == 0) { unsigned* c = cnt + 64 * (64 + rg); (void)__hip_atomic_fetch_add(c, 1u, __ATOMIC_RELAXED, __HIP_MEMORY_SCOPE_AGENT);
            unsigned spins = 0; while (__hip_atomic_load(c, __ATOMIC_RELAXED, __HIP_MEMORY_SCOPE_AGENT) < 32u && ++spins < (1u << 22)) __builtin_amdgcn_s_sleep(2); }
        __syncthreads();
        const unsigned long long sv = __hip_atomic_load(ss + row, __ATOMIC_RELAXED, __HIP_MEMORY_SCOPE_AGENT);
        out[o] = v * rsqrtf((float)sv * (1.f / (16777216.f * DM)) + EPS) * gfin[col];
    }
    __syncthreads();
}
template <int MODE> struct EpiRS {
    static constexpr bool PERM = true, AFTER_DRAIN = false;
    const unsigned long long* ss; bf16_t* O0; bf16_t* O1; float* out; float scale;
    __device__ __forceinline__ void operator()(const f32x4 (&acc)[2][2][4][2], const Unit& u, int wr, int wc, int fr, int fq) const {
        EPI_ROWS_BEGIN
            const float rs = rsqrtf((float)ss[row] * (1.f / (16777216.f * DM)) + EPS) * scale;
#pragma unroll
            for (int bj = 0; bj < 2; ++bj) {
                const int col = u.pn * 256 + bj * 128 + wc * 32 + 8 * fq;
                const f32x4 v0 = acc[ai][bj][m][0] * rs, v1 = acc[ai][bj][m][1] * rs;
                if (MODE == 0) store_bf16x8(O0 + (size_t)row * 512 + col, v0, v1);
                else {
                    const bool up = u.pn >= 11; const int c2 = up ? col - DFF : col;
                    store_bf16x8((up ? O1 : O0) + (size_t)row * DFF + c2, v0, v1);
                    if (!up) { float* dst = nullptr;
                        if (row < MP) { const int t = row & 4095; if (t >= 4094) dst = out + O_FCP + (size_t)((row >> 12) * 2 + t - 4094) * DFF + c2; }
                        else if (row < MT) { const int t = (row - MP) & 3; if (t >= 2) dst = out + O_FCS + (size_t)(((row - MP) >> 2) * 2 + t - 2) * DFF + c2; }
                        if (dst) { *(f32x4*)dst = v0; *(f32x4*)(dst + 4) = v1; } }
                }
            }
        EPI_ROWS_END
    }
};
struct EpiGU {
    static constexpr bool PERM = true, AFTER_DRAIN = false;
    const unsigned long long* ss; bf16_t* ACT; const float* cst; float* EDGE; float* PART; float* UPV; const float* cw; const float* cb; float* out; LAS unsigned char* xl;
    __device__ __forceinline__ void operator()(const f32x4 (&acc)[2][2][4][2], const Unit& u, int wr, int wc, int fr, int fq) const {
        const int c0 = u.pn * 128 + wc * 32 + 8 * fq;
        if (u.pm == 64) {
            const int lane = threadIdx.x & 63, i1 = (lane - 1) * 4, i2 = (lane - 2) * 4, t = fr & 3;
            f32x4 wv[2][4];
#pragma unroll
            for (int n = 0; n < 2; ++n) { wv[n][0] = *(const f32x4*)(cw + c0 + 4 * n); wv[n][1] = *(const f32x4*)(cw + DFF + c0 + 4 * n); wv[n][2] = *(const f32x4*)(cw + 2 * DFF + c0 + 4 * n); wv[n][3] = *(const f32x4*)(cb + c0 + 4 * n); }
#pragma unroll
            for (int m = 0; m < 4; ++m) {
                const int sr = wr * 64 + m * 16 + fr, b = sr >> 2;
                const float rs = rsqrtf((float)ss[(unsigned)(MP + sr)] * (1.f / (16777216.f * DM)) + EPS);
                u32x4 q;
#pragma unroll
                for (int n = 0; n < 2; ++n) {
                    const f32x4 cur = acc[0][0][m][n] * rs, upv = acc[0][1][m][n] * rs;
                    f32x4 x1, x2;
#pragma unroll
                    for (int c = 0; c < 4; ++c) { x1[c] = __int_as_float(__builtin_amdgcn_ds_bpermute(i1, __float_as_int(cur[c]))); x2[c] = __int_as_float(__builtin_amdgcn_ds_bpermute(i2, __float_as_int(cur[c]))); }
                    if (t < 1) x1 = *(const f32x4*)(cst + (unsigned)((b * 2 + 1) * DFF + c0 + 4 * n));
                    if (t < 2) x2 = *(const f32x4*)(cst + (unsigned)((b * 2 + t) * DFF + c0 + 4 * n));
                    f32x4 r;
#pragma unroll
                    for (int c = 0; c < 4; ++c) r[c] = silu_f(wv[n][3][c] + wv[n][0][c] * x2[c] + wv[n][1][c] * x1[c] + wv[n][2][c] * cur[c]) * upv[c];
                    if (n == 0) { q.x = pk2(r[0], r[1]); q.y = pk2(r[2], r[3]); } else { q.z = pk2(r[0], r[1]); q.w = pk2(r[2], r[3]); }
                    if (t >= 2) *(f32x4*)(out + O_FCS + (unsigned)(((sr >> 2) * 2 + t - 2) * DFF + c0 + 4 * n)) = cur;
                }
                *(u32x4*)(ACT + ((unsigned)(MP + sr) * (unsigned)DFF + (unsigned)c0)) = q;
            }
            return;
        }
        const int lane = threadIdx.x & 63;
        float rsv[2][4];
#pragma unroll
        for (int ai = 0; ai < 2; ++ai)
#pragma unroll
            for (int m = 0; m < 4; ++m) rsv[ai][m] = rsqrtf((float)ss[(unsigned)(u.pm * 256 + ai * 128 + wr * 64 + m * 16 + fr)] * (1.f / (16777216.f * DM)) + EPS);
        LAS float* ex = (LAS float*)xl;
#pragma unroll
        for (int ai = 0; ai < 2; ++ai) { const float rs = rsv[ai][3];
            if (fr >= 14) { LAS float* d = ex + (((wr * 4 + wc) * 2 + ai) * 2 + (fr - 14)) * 32 + 8 * fq; const f32x4 a0 = acc[ai][0][3][0] * rs, a1 = acc[ai][0][3][1] * rs;
                d[0] = a0[0]; d[1] = a0[1]; d[2] = a0[2]; d[3] = a0[3]; d[4] = a1[0]; d[5] = a1[1]; d[6] = a1[2]; d[7] = a1[3];
                if (ai == 1 && wr == 1) { float* e = EDGE + (unsigned)((u.pm * 2 + (fr - 14)) * DFF + c0); *(f32x4*)e = a0; *(f32x4*)(e + 4) = a1;
                    if ((u.pm & 15) == 15) { float* dst = out + O_FCP + (unsigned)(((u.pm >> 4) * 2 + fr - 14) * DFF + c0); *(f32x4*)dst = a0; *(f32x4*)(dst + 4) = a1; } } } }
        asm volatile("s_waitcnt lgkmcnt(0)" ::: "memory"); __builtin_amdgcn_s_barrier(); asm volatile("" ::: "memory");
        const int i1 = (fr >= 1 ? lane - 1 : lane + 15) * 4, i2 = (fr >= 2 ? lane - 2 : lane + 14) * 4;
        u32x2 stash[2][4];
#pragma unroll
        for (int n = 0; n < 2; ++n) {
            const int cn = c0 + 4 * n;
            const f32x4 w0 = *(const f32x4*)(cw + cn), w1 = *(const f32x4*)(cw + DFF + cn), w2 = *(const f32x4*)(cw + 2 * DFF + cn), bb = *(const f32x4*)(cb + cn);
#pragma unroll
            for (int ai = 0; ai < 2; ++ai) {
                const int swr = wr ^ 1, sai = (ai == 1 && wr == 1) ? 1 : 0;
                f32x4 prev = *(const LAS f32x4*)(ex + (((swr * 4 + wc) * 2 + sai) * 2 + (fr & 1)) * 32 + 8 * fq + 4 * n);
#pragma unroll
                for (int m = 0; m < 4; ++m) {
                    const int row = u.pm * 256 + ai * 128 + wr * 64 + m * 16 + fr;
                    const float rs = rsv[ai][m];
                    const f32x4 cur = acc[ai][0][m][n] * rs, upv = acc[ai][1][m][n] * rs;
                    f32x4 r;
                    const bool first = (ai == 0 && wr == 0 && m == 0);
#pragma unroll
                    for (int c = 0; c < 4; ++c) {
                        const float g1 = __int_as_float(__builtin_amdgcn_ds_bpermute(i1, __float_as_int(fr == 15 ? prev[c] : cur[c])));
                        const float g2 = __int_as_float(__builtin_amdgcn_ds_bpermute(i2, __float_as_int(fr >= 14 ? prev[c] : cur[c])));
                        if (first && fr < 2) { PART[(unsigned)((u.pm * 2 + fr) * DFF + cn + c)] = bb[c] + w2[c] * cur[c] + (fr == 1 ? w1[c] * g1 : 0.f); UPV[(unsigned)((u.pm * 2 + fr) * DFF + cn + c)] = upv[c]; }
                        r[c] = silu_f(bb[c] + w0[c] * g2 + w1[c] * g1 + w2[c] * cur[c]) * upv[c];
                    }
                    { u32x2 w; w.x = pk2(r[0], r[1]); w.y = pk2(r[2], r[3]);
                      if (n == 0) stash[ai][m] = w;
                      else if (!(first && fr < 2)) { u32x4 q; q.x = stash[ai][m].x; q.y = stash[ai][m].y; q.z = w.x; q.w = w.y; *(u32x4*)(ACT + ((unsigned)row * (unsigned)DFF + (unsigned)c0)) = q; } }
                    prev = cur;
                }
            }
        }
    }
};
__device__ __forceinline__ void ffn_fixup_local(const Args& a, int pm, int tid) {
    unsigned char* ws = a.ws;
    const float* EDGE = (const float*)(ws + WS_EDGE); const float* PART = (const float*)(ws + WS_PART); const float* UPV = (const float*)(ws + WS_UPV); bf16_t* ACT = (bf16_t*)(ws + WS_ACT);
    const float* cw = a.in[24];
    float part[11], upv[11], gm1[11], gm2[11], c0v[11], c1v[11];
#pragma unroll
    for (int j = 0; j < 11; ++j) { const int i = tid + 512 * j, fr = i >= DFF ? 1 : 0, c = i - fr * DFF; const unsigned rr = (unsigned)((pm * 2 + fr) * DFF + c);
        part[j] = PART[rr]; upv[j] = UPV[rr]; c0v[j] = cw[c]; c1v[j] = cw[DFF + c];
        gm1[j] = (pm & 15) ? EDGE[(unsigned)(((pm - 1) * 2 + 1) * DFF + c)] : 0.f; gm2[j] = (pm & 15) ? EDGE[(unsigned)(((pm - 1) * 2) * DFF + c)] : 0.f; }
#pragma unroll
    for (int j = 0; j < 11; ++j) { const int i = tid + 512 * j, fr = i >= DFF ? 1 : 0, c = i - fr * DFF;
        const float conv = part[j] + (fr == 0 ? c1v[j] * gm1[j] + c0v[j] * gm2[j] : c0v[j] * gm1[j]);
        ACT[(unsigned)((pm * 256 + fr) * DFF + c)] = (bf16_t)(pk2(silu_f(conv) * upv[j], 0.f) & 0xffffu); }
    asm volatile("s_waitcnt vmcnt(0)" ::: "memory");
    __syncthreads();
}
__device__ __forceinline__ void p0_transpose_item(const float* W, int K, int N, const float* gk, bf16_t* WT, int row_off, LAS float* scr, int item, int lane, bool il = false) {
    const int nblk = N / 32, kb = item / nblk, nb = item % nblk, k0 = 64 * kb, n0 = 32 * nb;
    { const int kq = lane >> 3, n4 = (lane & 7) * 4; f32x4 v[8]; float g[8];
#pragma unroll
      for (int i = 0; i < 8; ++i) { v[i] = *(const f32x4*)(W + (size_t)(k0 + kq + 8 * i) * N + n0 + n4); g[i] = gk ? gk[k0 + kq + 8 * i] : 1.f; }
#pragma unroll
      for (int i = 0; i < 8; ++i) { LAS float* d = scr + (kq + 8 * i) * 33 + n4; d[0] = v[i][0] * g[i]; d[1] = v[i][1] * g[i]; d[2] = v[i][2] * g[i]; d[3] = v[i][3] * g[i]; } }
    asm volatile("s_waitcnt lgkmcnt(0)" ::: "memory");
    const int c = lane & 7;
#pragma unroll
    for (int j = 0; j < 4; ++j) { const int n = (lane >> 3) + 8 * j; const LAS float* s = scr + (8 * c) * 33 + n;
        u32x4 o; o.x = pk2(s[0 * 33], s[1 * 33]); o.y = pk2(s[2 * 33], s[3 * 33]); o.z = pk2(s[4 * 33], s[5 * 33]); o.w = pk2(s[6 * 33], s[7 * 33]);
        const int drow = il ? ((n0 >> 7) << 8) + (n0 & 127) + n + row_off : row_off + n0 + n;
        *(u32x4*)(WT + (size_t)drow * K + k0 + 8 * c) = o; }
    asm volatile("s_waitcnt lgkmcnt(0)" ::: "memory");
}
__device__ __forceinline__ void rms_rows2_to_bf16(const float* x0, bf16_t* o0, const float* x1, bf16_t* o1, bool has1, int lane) {
    const f32x4* xr = (const f32x4*)x0 + lane; const f32x4* yr = (const f32x4*)x1 + lane;
    f32x4 v[4], w[4]; float s = 0.f, s2 = 0.f;
#pragma unroll
    for (int j = 0; j < 4; ++j) { v[j] = xr[64 * j]; w[j] = yr[64 * j]; }
#pragma unroll
    for (int j = 0; j < 4; ++j) { s += (v[j].x * v[j].x + v[j].y * v[j].y) + (v[j].z * v[j].z + v[j].w * v[j].w); s2 += (w[j].x * w[j].x + w[j].y * w[j].y) + (w[j].z * w[j].z + w[j].w * w[j].w); }
    const float r = rsqrtf(wave_sum(s) * (1.f / DM) + EPS), r2 = rsqrtf(wave_sum(s2) * (1.f / DM) + EPS);
    u32x2* a8 = (u32x2*)o0 + lane; u32x2* b8 = (u32x2*)o1 + lane;
#pragma unroll
    for (int j = 0; j < 4; ++j) { u32x2 p; p.x = pk2(v[j].x * r, v[j].y * r); p.y = pk2(v[j].z * r, v[j].w * r); a8[64 * j] = p;
        if (has1) { u32x2 p2; p2.x = pk2(w[j].x * r2, w[j].y * r2); p2.y = pk2(w[j].z * r2, w[j].w * r2); b8[64 * j] = p2; } }
}
constexpr int WI_IN = 16 * 112, WI_C = 16 * 16, WI_OUT = 16 * 32, WI_CO = 8 * 32, WI_G = 16 * 88, WI_D = 44 * 32;
constexpr int W_ITEMS_EARLY = WI_IN + 2 * WI_C, W_ITEMS = W_ITEMS_EARLY + WI_OUT + WI_C + WI_CO + 2 * WI_G + WI_D;
__device__ __forceinline__ void weight_item(const Args& a, LAS float* scr, int it, int lane) {
    unsigned char* ws = a.ws; int r = it;
    if (r < WI_IN) { p0_transpose_item(a.in[11], 1024, 3584, a.in[10], (bf16_t*)(ws + WS_WIN), 0, scr, r, lane); return; } r -= WI_IN;
    if (r < WI_C) { p0_transpose_item(a.in[18], 1024, 512, a.in[16], (bf16_t*)(ws + WS_WCKV), 0, scr, r, lane); return; } r -= WI_C;
    if (r < WI_C) { p0_transpose_item(a.in[19], 1024, 512, a.in[16], (bf16_t*)(ws + WS_WCKV), 512, scr, r, lane); return; } r -= WI_C;
    if (r < WI_OUT) { const int k0 = 64 * (r / 32); const float* g = k0 < 512 ? a.in[12] : a.in[13] - 512; p0_transpose_item(a.in[14], 1024, 1024, g, (bf16_t*)(ws + WS_WOUT), 0, scr, r, lane); return; } r -= WI_OUT;
    if (r < WI_C) { p0_transpose_item(a.in[17], 1024, 512, a.in[15], (bf16_t*)(ws + WS_WCQ), 0, scr, r, lane); return; } r -= WI_C;
    if (r < WI_CO) { p0_transpose_item(a.in[20], 512, 1024, nullptr, (bf16_t*)(ws + WS_WCO), 0, scr, r, lane); return; } r -= WI_CO;
    if (r < WI_G) { p0_transpose_item(a.in[22], 1024, DFF, a.in[21], (bf16_t*)(ws + WS_WGU), 0, scr, r, lane, true); return; } r -= WI_G;
    if (r < WI_G) { p0_transpose_item(a.in[23], 1024, DFF, a.in[21], (bf16_t*)(ws + WS_WGU), 128, scr, r, lane, true); return; } r -= WI_G;
    p0_transpose_item(a.in[26], DFF, 1024, nullptr, (bf16_t*)(ws + WS_WD), 0, scr, r, lane);
}
__device__ __forceinline__ void p0_prologue(const Args& a, LAS unsigned char* lds, int wave, int lane, int G) {
    unsigned char* ws = a.ws;
    LAS float* scr = (LAS float*)(lds + wave * 16384);
    const int gw = blockIdx.x * 8 + wave, NGW = G * 8;
    for (int it = gw; it < (MK_N_LAUNCHES == 1 ? W_ITEMS_EARLY : W_ITEMS); it += NGW) weight_item(a, scr, it, lane);
    bf16_t* XN = (bf16_t*)(ws + WS_XN); bf16_t* MN = (bf16_t*)(ws + WS_MN);
    for (int m = gw; m < MT + 1024; m += 2 * NGW) {
        const int m2 = m + NGW; const bool has1 = m2 < MT + 1024; const int mb = has1 ? m2 : m;
        const float* xa = m < MP ? a.in[0] + (size_t)m * DM : (m < MT ? a.in[1] + (size_t)(m - MP) * DM : a.in[8] + (size_t)(m - MT) * DM);
        const float* xb = mb < MP ? a.in[0] + (size_t)mb * DM : (mb < MT ? a.in[1] + (size_t)(mb - MP) * DM : a.in[8] + (size_t)(mb - MT) * DM);
        bf16_t* oa = m < MT ? XN + (size_t)m * DM : MN + (size_t)(m - MT) * DM; bf16_t* ob = mb < MT ? XN + (size_t)mb * DM : MN + (size_t)(mb - MT) * DM;
        rms_rows2_to_bf16(xa, oa, xb, ob, has1, lane);
    }
    const int gt = blockIdx.x * 512 + threadIdx.x, NT = G * 512;
    float* LB = (float*)(ws + WS_LB); unsigned long long* SS1 = (unsigned long long*)(ws + WS_SS1); unsigned long long* SS2 = (unsigned long long*)(ws + WS_SS2);
    for (int i = gt; i < 512; i += NT) LB[i] = 1.f / (1.f + __expf(a.in[9][512 + i] - a.in[9][i]));
    for (int i = gt; i < MPAD; i += NT) { SS1[i] = 0ull; SS2[i] = 0ull; }
    for (int i = gt; i < MT; i += NT) ((unsigned long long*)(ws + WS_SS3))[i] = 0ull;
    for (int i = gt; i < 64 * 72; i += NT) ((unsigned*)(ws + WS_CNT))[i] = 0u;
}

__device__ __forceinline__ void hgrn_step1(const Args& a, LAS unsigned char* lds, int ch, int tid) {
    unsigned char* ws = a.ws;
    float* LF = (float*)(ws + WS_LF); const bf16_t* VT = (const bf16_t*)(ws + WS_VT); float* KV = (float*)(ws + WS_KV);
    LAS float* bsm = (LAS float*)lds;
    const int bh = ch >> 6, c = ch & 63, b = bh >> 2, h = bh & 3;
    const int row0 = b * SEQ + c * 64;
    const int k = tid & 127, seg = tid >> 7;
    float loc[16];
#pragma unroll
    for (int i = 0; i < 16; ++i) loc[i] = LF[(size_t)(row0 + seg * 16 + i) * 512 + h * 128 + k];
#pragma unroll
    for (int i = 1; i < 16; ++i) loc[i] += loc[i - 1];
    bsm[(seg * 16 + 15) * 129 + k] = loc[15];
    __syncthreads();
    float off = 0.f;
    for (int s = 0; s < seg; ++s) off += bsm[(s * 16 + 15) * 129 + k];
    __syncthreads();
#pragma unroll
    for (int i = 0; i < 16; ++i) { const float v = loc[i] + off; bsm[(seg * 16 + i) * 129 + k] = v; LF[(size_t)(row0 + seg * 16 + i) * 512 + h * 128 + k] = v; }
    __syncthreads();
    const int wave = tid >> 6, lane = tid & 63, lr = lane & 15, lg = lane >> 4;
    const bf16_t* vrow = VT + (size_t)(bh * 128 + wave * 16 + lr) * 4096 + c * 64;
    const bf16x8 A0 = *(const bf16x8*)(vrow + lg * 8), A1 = *(const bf16x8*)(vrow + 32 + lg * 8);
#pragma unroll 2
    for (int kb = 0; kb < 8; ++kb) {
        const int kk = kb * 16 + lr; const float bl = bsm[63 * 129 + kk];
        f32x4 acc = {0.f, 0.f, 0.f, 0.f};
#pragma unroll
        for (int ks = 0; ks < 2; ++ks) {
            const int s0 = ks * 32 + lg * 8;
            float bprev = s0 > 0 ? bsm[(s0 - 1) * 129 + kk] : 0.f;
            float w[8];
#pragma unroll
            for (int i = 0; i < 8; ++i) { const float bs = bsm[(s0 + i) * 129 + kk]; w[i] = (1.f - __expf(bs - bprev)) * __expf(bl - bs); bprev = bs; }
            u32x4 pw; pw.x = pk2m(w[0], w[1]); pw.y = pk2m(w[2], w[3]); pw.z = pk2m(w[4], w[5]); pw.w = pk2m(w[6], w[7]);
            acc = __builtin_amdgcn_mfma_f32_16x16x32_bf16(ks == 0 ? A0 : A1, __builtin_bit_cast(bf16x8, pw), acc, 0, 0, 0);
        }
        float* kvp = KV + ((size_t)ch * 128 + wave * 16 + lg * 4) * 128 + kk;
#pragma unroll
        for (int j = 0; j < 4; ++j) kvp[j * 128] = acc[j];
    }
    __syncthreads();
}
__device__ __forceinline__ void hgrn_scan(const Args& a, int G) {
    unsigned char* ws = a.ws;
    const float* Bc = (const float*)(ws + WS_LF); const float* KV = (const float*)(ws + WS_KV); bf16_t* SP = (bf16_t*)(ws + WS_SP);
    const int NT = G * 512;
    for (int e0 = blockIdx.x * 512 + threadIdx.x; e0 < 16 * 16384; e0 += 2 * NT) {
        const int e1 = e0 + NT; const bool has1 = e1 < 16 * 16384; const int e1c = has1 ? e1 : e0;
        const int bh0 = e0 >> 14, vk0 = e0 & 16383, bh1 = e1c >> 14, vk1 = e1c & 16383;
        const float* d0 = Bc + (size_t)((bh0 >> 2) * SEQ + 63) * 512 + (bh0 & 3) * 128 + (e0 & 127);
        const float* d1 = Bc + (size_t)((bh1 >> 2) * SEQ + 63) * 512 + (bh1 & 3) * 128 + (e1c & 127);
        float S0 = 0.f, S1 = 0.f;
        for (int c0 = 0; c0 < 64; c0 += 8) {
            float kv0[8], dl0[8], kv1[8], dl1[8];
#pragma unroll
            for (int i = 0; i < 8; ++i) { kv0[i] = KV[((size_t)(bh0 * 64 + c0 + i) << 14) + vk0]; dl0[i] = d0[(size_t)(c0 + i) * 64 * 512];
                                          kv1[i] = KV[((size_t)(bh1 * 64 + c0 + i) << 14) + vk1]; dl1[i] = d1[(size_t)(c0 + i) * 64 * 512]; }
#pragma unroll
            for (int i = 0; i < 8; ++i) { SP[((size_t)(bh0 * 64 + c0 + i) << 14) + vk0] = (bf16_t)(pk2(S0, 0.f) & 0xffffu); S0 = __expf(dl0[i]) * S0 + kv0[i];
                if (has1) SP[((size_t)(bh1 * 64 + c0 + i) << 14) + vk1] = (bf16_t)(pk2(S1, 0.f) & 0xffffu); S1 = __expf(dl1[i]) * S1 + kv1[i]; }
        }
        a.out[O_HSP + ((size_t)bh0 * 128 + (e0 & 127)) * 128 + ((e0 >> 7) & 127)] = S0;
        if (has1) a.out[O_HSP + ((size_t)bh1 * 128 + (e1 & 127)) * 128 + ((e1 >> 7) & 127)] = S1;
    }
}
template <int I> __device__ __forceinline__ void hgrn_step3(const Args& a, int ch, int lane) {
    unsigned char* ws = a.ws;
    const float* Bc = (const float*)(ws + WS_LF); const bf16_t* VT = (const bf16_t*)(ws + WS_VT); const bf16_t* SP = (const bf16_t*)(ws + WS_SP);
    const bf16_t* QH = (const bf16_t*)(ws + WS_QH); const bf16_t* GH = (const bf16_t*)(ws + WS_GH); bf16_t* MIX = (bf16_t*)(ws + WS_MIX);
    const int bh = ch >> 6, c = ch & 63, b = bh >> 2, h = bh & 3;
    const int row0 = b * SEQ + c * 64, rowI = row0 + 16 * I, hk = h * 128, lr = lane & 15, lg = lane >> 4;
    bf16x8 Qi[4], Qr[4];
#pragma unroll
    for (int ks = 0; ks < 4; ++ks) {
        const size_t o = (size_t)(rowI + lr) * 512 + hk + ks * 32 + lg * 8;
        const u32x4 qw = *(const u32x4*)(QH + o); const f32x4 b0 = *(const f32x4*)(Bc + o), b1 = *(const f32x4*)(Bc + o + 4);
        f32x4 r0 = {0.f, 0.f, 0.f, 0.f}, r1 = r0;
        if (I > 0) { const size_t orf = (size_t)(rowI - 1) * 512 + hk + ks * 32 + lg * 8; r0 = *(const f32x4*)(Bc + orf); r1 = *(const f32x4*)(Bc + orf + 4); }
        const float q[8] = {bflo(qw.x), bfhi(qw.x), bflo(qw.y), bfhi(qw.y), bflo(qw.z), bfhi(qw.z), bflo(qw.w), bfhi(qw.w)};
        const float bb[8] = {b0[0], b0[1], b0[2], b0[3], b1[0], b1[1], b1[2], b1[3]}; const float rr[8] = {r0[0], r0[1], r0[2], r0[3], r1[0], r1[1], r1[2], r1[3]};
        u32x4 wi, wr2; float x[8], y[8];
#pragma unroll
        for (int i = 0; i < 8; ++i) { x[i] = q[i] * __expf(bb[i]); y[i] = q[i] * __expf(bb[i] - rr[i]); }
        wi.x = pk2m(x[0], x[1]); wi.y = pk2m(x[2], x[3]); wi.z = pk2m(x[4], x[5]); wi.w = pk2m(x[6], x[7]);
        wr2.x = pk2m(y[0], y[1]); wr2.y = pk2m(y[2], y[3]); wr2.z = pk2m(y[4], y[5]); wr2.w = pk2m(y[6], y[7]);
        Qi[ks] = __builtin_bit_cast(bf16x8, wi); Qr[ks] = __builtin_bit_cast(bf16x8, wr2);
    }
    f32x4 oacc[8];
#pragma unroll
    for (int vb = 0; vb < 8; ++vb) { oacc[vb] = (f32x4){0.f, 0.f, 0.f, 0.f};
        const bf16_t* sp = SP + ((size_t)ch * 128 + vb * 16 + lr) * 128 + lg * 8;
#pragma unroll
        for (int ks = 0; ks < 4; ++ks) oacc[vb] = __builtin_amdgcn_mfma_f32_16x16x32_bf16(*(const bf16x8*)(sp + ks * 32), Qi[ks], oacc[vb], 0, 0, 0); }
    s16x4 Avs[I + 1][8];
#pragma unroll
    for (int J = 0; J <= I; ++J)
#pragma unroll
        for (int vb = 0; vb < 8; ++vb) Avs[J][vb] = *(const s16x4*)(VT + (size_t)(bh * 128 + vb * 16 + lr) * 4096 + c * 64 + 16 * J + lg * 4);
#pragma unroll
    for (int J = 0; J <= I; ++J) {
        f32x4 st = {0.f, 0.f, 0.f, 0.f};
        const int s = 16 * J + lr;
#pragma unroll
        for (int ks = 0; ks < 4; ++ks) {
            const size_t o = (size_t)(row0 + s) * 512 + hk + ks * 32 + lg * 8;
            const f32x4 b0 = *(const f32x4*)(Bc + o), b1 = *(const f32x4*)(Bc + o + 4);
            f32x4 p0 = {0.f, 0.f, 0.f, 0.f}, p1 = p0, r0 = p0, r1 = p0;
            if (s > 0) { p0 = *(const f32x4*)(Bc + o - 512); p1 = *(const f32x4*)(Bc + o - 512 + 4); }
            if (I > 0) { const size_t orf = (size_t)(rowI - 1) * 512 + hk + ks * 32 + lg * 8; r0 = *(const f32x4*)(Bc + orf); r1 = *(const f32x4*)(Bc + orf + 4); }
            float w[8];
#pragma unroll
            for (int i = 0; i < 4; ++i) { w[i] = (1.f - __expf(b0[i] - p0[i])) * __expf(fminf(r0[i] - b0[i], 80.f)); w[i + 4] = (1.f - __expf(b1[i] - p1[i])) * __expf(fminf(r1[i] - b1[i], 80.f)); }
            u32x4 pw; pw.x = pk2m(w[0], w[1]); pw.y = pk2m(w[2], w[3]); pw.z = pk2m(w[4], w[5]); pw.w = pk2m(w[6], w[7]);
            st = __builtin_amdgcn_mfma_f32_16x16x32_bf16(__builtin_bit_cast(bf16x8, pw), Qr[ks], st, 0, 0, 0);
        }
#pragma unroll
        for (int j = 0; j < 4; ++j) if (J > I || (J == I && lg * 4 + j > lr)) st[j] = 0.f;
        u32x2 pb; pb.x = pk2m(st[0], st[1]); pb.y = pk2m(st[2], st[3]);
        const s16x4 P = __builtin_bit_cast(s16x4, pb);
#pragma unroll
        for (int vb = 0; vb < 8; ++vb) {
            oacc[vb] = __builtin_amdgcn_mfma_f32_16x16x16bf16_1k(Avs[J][vb], P, oacc[vb], 0, 0, 0);
        }
    }
    float ssq = 0.f;
#pragma unroll
    for (int vb = 0; vb < 8; ++vb) ssq += (oacc[vb][0] * oacc[vb][0] + oacc[vb][1] * oacc[vb][1]) + (oacc[vb][2] * oacc[vb][2] + oacc[vb][3] * oacc[vb][3]);
    ssq = xg_sum(ssq);
    const float r = rsqrtf(ssq * (1.f / 128.f) + EPS);
#pragma unroll
    for (int vb = 0; vb < 8; ++vb) {
        const u32x2 gw = *(const u32x2*)(GH + (size_t)(rowI + lr) * 512 + hk + vb * 16 + lg * 4);
        u32x2 w; w.x = pk2(oacc[vb][0] * r * silu_f(bflo(gw.x)), oacc[vb][1] * r * silu_f(bfhi(gw.x))); w.y = pk2(oacc[vb][2] * r * silu_f(bflo(gw.y)), oacc[vb][3] * r * silu_f(bfhi(gw.y)));
        *(u32x2*)(MIX + (size_t)(rowI + lr) * DM + 512 + hk + vb * 16 + lg * 4) = w;
    }
}
__device__ __forceinline__ void hgrn_sample(const Args& a, LAS unsigned char* lds, int unit, int tid) {
    unsigned char* ws = a.ws;
    const float* LF = (const float*)(ws + WS_LF); const bf16_t* QH = (const bf16_t*)(ws + WS_QH); const bf16_t* VH = (const bf16_t*)(ws + WS_VH);
    const bf16_t* GH = (const bf16_t*)(ws + WS_GH); bf16_t* MIX = (bf16_t*)(ws + WS_MIX);
    LAS float* red = (LAS float*)lds;
    LAS float* tv = red + 1024;
    const int b = unit >> 2, h = unit & 3, hk = h * 128, v = tid & 127, kq = tid >> 7;
    __syncthreads();
    { const int t = tid >> 7, i = tid & 127; const size_t ro = (size_t)(MP + b * 4 + t) * 512 + hk + i;
      tv[t * 512 + i] = __expf(LF[ro]); tv[t * 512 + 128 + i] = bf1(QH[ro]); tv[t * 512 + 256 + i] = bf1(VH[ro]); tv[t * 512 + 384 + i] = bf1(GH[ro]); }
    float S[32];
    const float* s0 = a.in[4] + ((size_t)(b * 4 + h) * 128 + kq * 32) * 128 + v;
#pragma unroll
    for (int i = 0; i < 32; ++i) S[i] = s0[(size_t)i * 128];
    __syncthreads();
    for (int t = 0; t < 4; ++t) {
        const LAS float* tt = tv + t * 512;
        const float vv = tt[256 + v]; float op = 0.f;
#pragma unroll
        for (int i = 0; i < 32; ++i) { const int k = kq * 32 + i; const float f = tt[k]; S[i] = f * S[i] + (1.f - f) * vv; op += tt[128 + k] * S[i]; }
        red[kq * 128 + v] = op;
        __syncthreads();
        const float o = (red[v] + red[128 + v]) + (red[256 + v] + red[384 + v]);
        const float wsq = wave_sum(o * o);
        __syncthreads();
        if ((tid & 63) == 0) red[512 + (tid >> 6)] = wsq;
        __syncthreads();
        const float ssq = red[512] + red[513];
        if (kq == 0) { const float r = rsqrtf(ssq * (1.f / 128.f) + EPS);
            MIX[(size_t)(MP + b * 4 + t) * DM + 512 + hk + v] = (bf16_t)(pk2(o * r * silu_f(tt[384 + v]), 0.f) & 0xffffu); }
        __syncthreads();
    }
    float* so = a.out + O_HSS + ((size_t)(b * 4 + h) * 128 + kq * 32) * 128 + v;
#pragma unroll
    for (int i = 0; i < 32; ++i) so[(size_t)i * 128] = S[i];
}
__device__ __forceinline__ s16x4 tr_read(const LAS unsigned char* p) { typedef short v4i16_t __attribute__((ext_vector_type(4))); return __builtin_bit_cast(s16x4, __builtin_amdgcn_ds_read_tr16_b64_v4i16((LAS v4i16_t*)p)); }
__device__ __forceinline__ int dil_first_kb3(int p, int t0) { const int dsh = 2 * p, neg = (128 << dsh) - t0; return neg <= 0 ? 0 : (((neg + (1 << dsh) - 1) >> dsh) / 48); }
struct DilKV { bf16x8 K0[3], K1[3]; u32x4 V0[3], V1[3]; };
struct DilState { bf16x8 Q0, Q1; f32x4 o[4]; float m, l; };
__device__ __forceinline__ void dil_load(DilKV& R, const bf16_t* Kb, const bf16_t* Vb, size_t rowb, int h, int t0, int p, int kb3, int lr, int lg, int vkey, int vpart) {
    const int dsh = 2 * p, tb = t0 - (128 << dsh);
#pragma unroll
    for (int i = 0; i < 3; ++i) {
        const int kb = 3 * kb3 + i;
        int tk = tb + ((16 * kb + lr) << dsh); tk = tk < 0 ? 0 : (tk > SEQ - 1 ? SEQ - 1 : tk);
        const bf16_t* kp = Kb + (rowb + tk) * 512 + h * 64 + lg * 8;
        R.K0[i] = *(const bf16x8*)kp; R.K1[i] = *(const bf16x8*)(kp + 32);
        int tv = tb + ((16 * kb + vkey) << dsh); tv = tv < 0 ? 0 : (tv > SEQ - 1 ? SEQ - 1 : tv);
        const u32x4* vp = (const u32x4*)(Vb + (rowb + tv) * 512 + h * 64 + vpart * 16);
        R.V0[i] = vp[0]; R.V1[i] = vp[1];
    }
}
__device__ __forceinline__ void dil_qk(f32x4 (&st)[3], const DilKV& R, const DilState& S) {
#pragma unroll
    for (int i = 0; i < 3; ++i) { st[i] = (f32x4){0.f, 0.f, 0.f, 0.f};
        st[i] = __builtin_amdgcn_mfma_f32_16x16x32_bf16(R.K0[i], S.Q0, st[i], 0, 0, 0);
        st[i] = __builtin_amdgcn_mfma_f32_16x16x32_bf16(R.K1[i], S.Q1, st[i], 0, 0, 0); }
}
__device__ __forceinline__ void dil_consume(DilState& S, f32x4 (&st)[3], int jj0, int jmax, float sd, const LAS unsigned char* trp) {
    float bm = -INFINITY; const float bias0 = -sd * (float)jj0;
#pragma unroll
    for (int i = 0; i < 3; ++i)
#pragma unroll
        for (int j = 0; j < 4; ++j) { const int kk = 16 * i + j; const bool ok = (unsigned)(jj0 - kk) <= (unsigned)jmax;
            st[i][j] = ok ? st[i][j] + (bias0 + sd * (float)kk) : -INFINITY; bm = fmaxf(bm, st[i][j]); }
    bm = xg_max(bm);
    const float mnew = fmaxf(S.m, bm), corr = ex2(S.m - mnew);
    float ps = 0.f;
#pragma unroll
    for (int i = 0; i < 3; ++i)
#pragma unroll
        for (int j = 0; j < 4; ++j) { st[i][j] = ex2(st[i][j] - mnew); ps += st[i][j]; }
    ps = xg_sum(ps);
    S.l = S.l * corr + ps; S.m = mnew;
#pragma unroll
    for (int db = 0; db < 4; ++db) S.o[db] *= corr;
#pragma unroll
    for (int i = 0; i < 3; ++i) {
        u32x2 pb; pb.x = pk2m(st[i][0], st[i][1]); pb.y = pk2m(st[i][2], st[i][3]);
        const s16x4 P = __builtin_bit_cast(s16x4, pb);
#pragma unroll
        for (int db = 0; db < 4; ++db) S.o[db] = __builtin_amdgcn_mfma_f32_16x16x16bf16_1k(tr_read(trp + i * 2304 + db * 32), P, S.o[db], 0, 0, 0);
    }
}
__device__ __forceinline__ void dil_finish(DilState& S, bf16_t* MIX, size_t row, int h, int lg) {
    const float il = 1.f / S.l; float ssq = 0.f;
#pragma unroll
    for (int db = 0; db < 4; ++db) { S.o[db] *= il; ssq += (S.o[db][0] * S.o[db][0] + S.o[db][1] * S.o[db][1]) + (S.o[db][2] * S.o[db][2] + S.o[db][3] * S.o[db][3]); }
    ssq = xg_sum(ssq);
    const float rn = rsqrtf(ssq * (1.f / 64.f) + EPS);
#pragma unroll
    for (int db = 0; db < 4; ++db) { u32x2 w; w.x = pk2(S.o[db][0] * rn, S.o[db][1] * rn); w.y = pk2(S.o[db][2] * rn, S.o[db][3] * rn);
        *(u32x2*)(MIX + row * DM + h * 64 + db * 16 + lg * 4) = w; }
}
__device__ __forceinline__ void dil_attn_unit(const Args& a, LAS unsigned char* vl  , int unit, int lane) {
    unsigned char* ws = a.ws;
    const bf16_t* Qb = (const bf16_t*)(ws + WS_QB); const bf16_t* Kb = (const bf16_t*)(ws + WS_KB); const bf16_t* Vb = (const bf16_t*)(ws + WS_VB); bf16_t* MIX = (bf16_t*)(ws + WS_MIX);
    const int rp = unit & 7, blk = (unit >> 3) & 15, h = (unit >> 7) & 7, b = unit >> 10;
    const int lr = lane & 15, lg = lane >> 4, t0A = blk * 256 + rp, t0B = t0A + 8;
    const float slope = exp2f(-(float)(h + 1)) * LOG2E;
    const size_t rowb = (size_t)b * SEQ;
    DilState A, B;
    { const bf16_t* qa = Qb + (rowb + t0A + 16 * lr) * 512 + h * 64 + lg * 8; A.Q0 = *(const bf16x8*)qa; A.Q1 = *(const bf16x8*)(qa + 32);
      const bf16_t* qb = qa + 8 * 512; B.Q0 = *(const bf16x8*)qb; B.Q1 = *(const bf16x8*)(qb + 32); }
#pragma unroll
    for (int db = 0; db < 4; ++db) { A.o[db] = (f32x4){0.f, 0.f, 0.f, 0.f}; B.o[db] = A.o[db]; }
    A.m = -1e30f; A.l = 0.f; B.m = -1e30f; B.l = 0.f;
    const int vkey = lane >> 2, vpart = lane & 3, li = lane & 15;
    const LAS unsigned char* trp = vl + (lg * 4 + (li >> 2)) * 144 + (li & 3) * 8;
    const int tqA = t0A + 16 * lr, tqB = tqA + 8;
    int sg = 0, kb3 = dil_first_kb3(0, t0A);
    DilKV cur;
    dil_load(cur, Kb, Vb, rowb, h, t0A, 0, kb3, lr, lg, vkey, vpart);
#pragma unroll 1
    for (;;) {
        const int p = sg < 2 ? sg : 2, dsh = 2 * p, step = 16 >> dsh;
        f32x4 stA[3], stB[3];
        if (sg != 3) dil_qk(stA, cur, A);
        if (sg != 2) dil_qk(stB, cur, B);
#pragma unroll
        for (int i = 0; i < 3; ++i) { *(LAS u32x4*)(vl + i * 2304 + vkey * 144 + vpart * 32) = cur.V0[i]; *(LAS u32x4*)(vl + i * 2304 + vkey * 144 + vpart * 32 + 16) = cur.V1[i]; }
        int sn = sg, kn = kb3 + 1; const int nb3 = sg == 0 ? 8 : (sg == 1 ? 4 : 3);
        if (kn == nb3) { sn = sg + 1; kn = sn < 4 ? dil_first_kb3(sn < 2 ? sn : 2, sn == 3 ? t0B : t0A) : 0; }
        const bool last = sn == 4;
        if (!last) dil_load(cur, Kb, Vb, rowb, h, sn == 3 ? t0B : t0A, sn < 2 ? sn : 2, kn, lr, lg, vkey, vpart);
        const float sd = slope * (float)(1 << dsh);
        const int jbase = 128 + step * lr - 48 * kb3 - 4 * lg;
        if (sg != 3) { const int jm = tqA >> dsh; dil_consume(A, stA, jbase, jm < 128 ? jm : 128, sd, trp); }
        if (sg != 2) { const int jm = tqB >> dsh; dil_consume(B, stB, jbase + (sg < 2 ? (8 >> dsh) : 0), jm < 128 ? jm : 128, sd, trp); }
        if (last) break;
        sg = sn; kb3 = kn;
    }
    dil_finish(A, MIX, rowb + tqA, h, lg);
    dil_finish(B, MIX, rowb + tqB, h, lg);
}

template <int MODE> __device__ __forceinline__ const float* samp_row(const Args& a, int b, int t, int h, int e, bool isv) {
    if (MODE == 0) { const int p = e / 129, j = e - p * 129, idx = 2048 + t - (j << (2 * p));
        if (idx < 2048) return a.in[isv ? 3 : 2] + (((size_t)b * 2048 + idx) * 8 + h) * 64;
        return a.out + (isv ? O_WVS : O_WKS) + ((size_t)(b * 4 + idx - 2048) * 8 + h) * 64; }
    return a.in[isv ? 7 : 6] + (((size_t)b * 256 + e) * 4 + h) * 128;
}
template <int MODE, int NP> __device__ __forceinline__ void sample_attn_unit(const Args& a, LAS unsigned char* wl  , LAS float* xch  , int unit, int ul, int part, int lane) {
    constexpr int DH = MODE == 0 ? 64 : 128, NK = MODE == 0 ? 387 : 256, NH = MODE == 0 ? 8 : 4, NV = DH / 64, NKP = (NK + NP - 1) / NP;
    unsigned char* ws = a.ws;
    const int h = unit % NH, bt = unit / NH, b = bt >> 2, t = bt & 3;
    const int e0 = part * NKP, e1 = e0 + NKP < NK ? e0 + NKP : NK, nk = e1 - e0;
    LAS float* qs = (LAS float*)wl; LAS float* sc = qs + DH;
    const bf16_t* qp = (MODE == 0 ? (const bf16_t*)(ws + WS_QB) : (const bf16_t*)(ws + WS_CQ)) + (size_t)(MP + bt) * 512 + h * DH;
    for (int i = lane; i < DH; i += 64) qs[i] = bf1(qp[i]);
    const float slope = MODE == 0 ? exp2f(-(float)(h + 1)) * LOG2E : 0.f;
    float mx = -INFINITY;
    for (int el = lane; el < nk; el += 64) { const int e = e0 + el;
        const f32x4* kp = (const f32x4*)samp_row<MODE>(a, b, t, h, e, false); float dot = 0.f;
#pragma unroll
        for (int i = 0; i < DH / 4; ++i) { const f32x4 kv = kp[i]; const f32x4 qv = *(const LAS f32x4*)(qs + 4 * i); dot += (kv[0] * qv[0] + kv[1] * qv[1]) + (kv[2] * qv[2] + kv[3] * qv[3]); }
        if (MODE == 0) { const int p = e / 129, j = e - p * 129; dot -= slope * (float)(j << (2 * p)); }
        sc[el] = dot; mx = fmaxf(mx, dot);
    }
    mx = wave_max(mx);
    float sum = 0.f;
    for (int el = lane; el < nk; el += 64) { const float pe = ex2(sc[el] - mx); sc[el] = pe; sum += pe; }
    sum = wave_sum(sum);
    const int g = lane >> 4, d4 = lane & 15;
    f32x4 acc[NV];
#pragma unroll
    for (int v = 0; v < NV; ++v) acc[v] = (f32x4){0.f, 0.f, 0.f, 0.f};
    constexpr int NIT = (NKP + 3) / 4;
#pragma unroll 16
    for (int it = 0; it < NIT; ++it) { const int el = it * 4 + g; const bool ok = el < nk; const int ec = ok ? el : nk - 1;
        const float* vp = samp_row<MODE>(a, b, t, h, e0 + ec, true) + 4 * d4; const float pe = ok ? sc[ec] : 0.f;
#pragma unroll
        for (int v = 0; v < NV; ++v) acc[v] += *(const f32x4*)(vp + 64 * v) * pe; }
#pragma unroll
    for (int v = 0; v < NV; ++v)
#pragma unroll
        for (int j = 0; j < 4; ++j) { float x = acc[v][j]; x = xg_sum(x); acc[v][j] = x; }
    LAS float* xp = xch + (ul * NP + part) * (DH + 2);
    if (g == 0) {
#pragma unroll
        for (int v = 0; v < NV; ++v) *(LAS f32x4*)(xp + 64 * v + 4 * d4) = acc[v];
        if (d4 == 0) { xp[DH] = mx; xp[DH + 1] = sum; } }
    __syncthreads();
    if (part == 0) {
        const LAS float* x0 = xch + (ul * NP) * (DH + 2);
        float M = -INFINITY;
#pragma unroll
        for (int i = 0; i < NP; ++i) M = fmaxf(M, x0[i * (DH + 2) + DH]);
        float l = 0.f, o0 = 0.f, o1 = 0.f;
#pragma unroll
        for (int i = 0; i < NP; ++i) { const float f = ex2(x0[i * (DH + 2) + DH] - M); l += x0[i * (DH + 2) + DH + 1] * f; o0 += x0[i * (DH + 2) + lane] * f; if (MODE == 1) o1 += x0[i * (DH + 2) + 64 + lane] * f; }
        const float il = 1.f / l; o0 *= il; o1 *= il;
        if (MODE == 0) { const float rn = rsqrtf(wave_sum(o0 * o0) * (1.f / 64.f) + EPS);
            ((bf16_t*)(ws + WS_MIX))[(size_t)(MP + bt) * DM + h * 64 + lane] = (bf16_t)(pk2(o0 * rn, 0.f) & 0xffffu); }
        else { bf16_t* cp = (bf16_t*)(ws + WS_CO) + (size_t)(MP + bt) * 512 + h * 128; cp[lane] = (bf16_t)(pk2(o0, 0.f) & 0xffffu); cp[lane + 64] = (bf16_t)(pk2(o1, 0.f) & 0xffffu); }
    }
}

__device__ __forceinline__ void cross_unit(const Args& a, LAS unsigned char* lds, int unit, int tid) {
    unsigned char* ws = a.ws;
    const bf16_t* CQ = (const bf16_t*)(ws + WS_CQ); const bf16_t* MKB = (const bf16_t*)(ws + WS_MKB); const bf16_t* MVB = (const bf16_t*)(ws + WS_MVB); bf16_t* CO = (bf16_t*)(ws + WS_CO);
    const int qblk = unit & 15, h = (unit >> 4) & 3, b = unit >> 6;
    LAS unsigned char* ksm = lds; LAS unsigned char* vsm = lds + 256 * 272;
    __syncthreads();
    for (int i = tid; i < 4096; i += 512) { const int m = i >> 4, ck = i & 15; const size_t g = (size_t)(b * 256 + m) * 512 + h * 128 + ck * 8;
        *(LAS u32x4*)(ksm + m * 272 + ck * 16) = *(const u32x4*)(MKB + g); *(LAS u32x4*)(vsm + m * 272 + ck * 16) = *(const u32x4*)(MVB + g); }
    __syncthreads();
    const int wave = tid >> 6, lane = tid & 63, lr = lane & 15, lg = lane >> 4, li = lane & 15;
#pragma unroll 1
    for (int qq = 0; qq < 2; ++qq) {
        const size_t row = (size_t)b * SEQ + qblk * 256 + (wave * 2 + qq) * 16 + lr;
        bf16x8 Qf[4];
#pragma unroll
        for (int ks = 0; ks < 4; ++ks) Qf[ks] = *(const bf16x8*)(CQ + row * 512 + h * 128 + ks * 32 + lg * 8);
        f32x4 st[16]; float mx = -INFINITY;
#pragma unroll
        for (int kb = 0; kb < 16; ++kb) { st[kb] = (f32x4){0.f, 0.f, 0.f, 0.f};
#pragma unroll
            for (int ks = 0; ks < 4; ++ks) st[kb] = __builtin_amdgcn_mfma_f32_16x16x32_bf16(*(const LAS bf16x8*)(ksm + (kb * 16 + lr) * 272 + (ks * 32 + lg * 8) * 2), Qf[ks], st[kb], 0, 0, 0);
            mx = fmaxf(mx, fmaxf(fmaxf(st[kb][0], st[kb][1]), fmaxf(st[kb][2], st[kb][3]))); }
        mx = xg_max(mx);
        float sum = 0.f; s16x4 P[16];
#pragma unroll
        for (int kb = 0; kb < 16; ++kb) { f32x4 e;
#pragma unroll
            for (int j = 0; j < 4; ++j) { e[j] = ex2(st[kb][j] - mx); sum += e[j]; }
            u32x2 pb; pb.x = pk2m(e[0], e[1]); pb.y = pk2m(e[2], e[3]); P[kb] = __builtin_bit_cast(s16x4, pb); }
        sum = xg_sum(sum);
        const float il = 1.f / sum;
        const LAS unsigned char* trp = vsm + (lg * 4 + (li >> 2)) * 272 + (li & 3) * 8;
#pragma unroll
        for (int db = 0; db < 8; ++db) { f32x4 o = {0.f, 0.f, 0.f, 0.f};
#pragma unroll
            for (int kb = 0; kb < 16; ++kb) o = __builtin_amdgcn_mfma_f32_16x16x16bf16_1k(tr_read(trp + kb * 16 * 272 + db * 32), P[kb], o, 0, 0, 0);
            u32x2 w; w.x = pk2(o[0] * il, o[1] * il); w.y = pk2(o[2] * il, o[3] * il);
            *(u32x2*)(CO + row * 512 + h * 128 + db * 16 + lg * 4) = w; }
    }
}

__device__ __forceinline__ void unpack8(const u32x4 g, float (&x)[8]) { x[0] = bflo(g.x); x[1] = bfhi(g.x); x[2] = bflo(g.y); x[3] = bfhi(g.y); x[4] = bflo(g.z); x[5] = bfhi(g.z); x[6] = bflo(g.w); x[7] = bfhi(g.w); }
__device__ __forceinline__ void act_pass(const Args& a, int G) {
    unsigned char* ws = a.ws;
    const bf16_t* UG = (const bf16_t*)(ws + WS_UG); const bf16_t* UP = (const bf16_t*)(ws + WS_UP); bf16_t* ACT = (bf16_t*)(ws + WS_ACT);
    const float* cw = a.in[24]; const float* cb = a.in[25]; const float* st = a.in[5];
    constexpr int CH = DFF / 8, RG = 45;
    const int gt = blockIdx.x * 512 + threadIdx.x;
    const int c0 = (gt % CH) * 8, r0 = (gt / CH) * RG;
    if (r0 >= MT) return;
    const int r1 = r0 + RG < MT ? r0 + RG : MT;
    float w0[8], w1[8], w2[8], bb[8];
#pragma unroll
    for (int j = 0; j < 8; ++j) { w0[j] = cw[c0 + j]; w1[j] = cw[DFF + c0 + j]; w2[j] = cw[2 * DFF + c0 + j]; bb[j] = cb[c0 + j]; }
    float x1[8], x2[8];
    { const int t = r0 < MP ? (r0 & 4095) : ((r0 - MP) & 3);
#pragma unroll
      for (int j = 0; j < 8; ++j) { x1[j] = 0.f; x2[j] = 0.f; }
      if (t >= 1) unpack8(*(const u32x4*)(UG + (size_t)(r0 - 1) * DFF + c0), x1);
      if (t >= 2) unpack8(*(const u32x4*)(UG + (size_t)(r0 - 2) * DFF + c0), x2);
      if (r0 >= MP && t == 1) { const float* sp = st + ((size_t)((r0 - MP) >> 2) * 2 + 1) * DFF + c0;
#pragma unroll
          for (int j = 0; j < 8; ++j) x2[j] = sp[j]; } }
#pragma unroll 5
    for (int row = r0; row < r1; ++row) {
        const int t = row < MP ? (row & 4095) : ((row - MP) & 3);
        if (t == 0) {
            if (row >= MP) { const float* sp = st + (size_t)((row - MP) >> 2) * 2 * DFF + c0;
#pragma unroll
                for (int j = 0; j < 8; ++j) { x2[j] = sp[j]; x1[j] = sp[DFF + j]; } }
            else {
#pragma unroll
                for (int j = 0; j < 8; ++j) { x1[j] = 0.f; x2[j] = 0.f; } }
        }
        float x0[8], uu[8];
        unpack8(*(const u32x4*)(UG + (size_t)row * DFF + c0), x0); unpack8(*(const u32x4*)(UP + (size_t)row * DFF + c0), uu);
        float r[8];
#pragma unroll
        for (int j = 0; j < 8; ++j) { const float cv = bb[j] + w0[j] * x2[j] + w1[j] * x1[j] + w2[j] * x0[j]; r[j] = silu_f(cv) * uu[j]; x2[j] = x1[j]; x1[j] = x0[j]; }
        u32x4 w; w.x = pk2(r[0], r[1]); w.y = pk2(r[2], r[3]); w.z = pk2(r[4], r[5]); w.w = pk2(r[6], r[7]);
        *(u32x4*)(ACT + (size_t)row * DFF + c0) = w;
    }
}
__device__ __forceinline__ void final_norm(const Args& a, int G, int wave, int lane) {
    const float* g = a.in[27]; const bf16_t* XN = (const bf16_t*)(a.ws + WS_XN);
    f32x4 gg[4];
#pragma unroll
    for (int j = 0; j < 4; ++j) gg[j] = *((const f32x4*)g + 2 * lane + (j & 1) + 128 * (j >> 1));
    const int NGW = G * 8;
    for (int m = MP + blockIdx.x * 8 + wave; m < MT; m += 2 * NGW) {
        const int m2 = m + NGW; const bool has2 = m2 < MT; const int mb = has2 ? m2 : m;
        const u32x4 a0 = *((const u32x4*)(XN + (size_t)m * DM) + lane), a1 = *((const u32x4*)(XN + (size_t)m * DM) + 64 + lane);
        const u32x4 b0 = *((const u32x4*)(XN + (size_t)mb * DM) + lane), b1 = *((const u32x4*)(XN + (size_t)mb * DM) + 64 + lane);
        f32x4 v[4] = {{bflo(a0.x), bfhi(a0.x), bflo(a0.y), bfhi(a0.y)}, {bflo(a0.z), bfhi(a0.z), bflo(a0.w), bfhi(a0.w)}, {bflo(a1.x), bfhi(a1.x), bflo(a1.y), bfhi(a1.y)}, {bflo(a1.z), bfhi(a1.z), bflo(a1.w), bfhi(a1.w)}};
        f32x4 w[4] = {{bflo(b0.x), bfhi(b0.x), bflo(b0.y), bfhi(b0.y)}, {bflo(b0.z), bfhi(b0.z), bflo(b0.w), bfhi(b0.w)}, {bflo(b1.x), bfhi(b1.x), bflo(b1.y), bfhi(b1.y)}, {bflo(b1.z), bfhi(b1.z), bflo(b1.w), bfhi(b1.w)}};
        float s = 0.f, s2 = 0.f;
#pragma unroll
        for (int j = 0; j < 4; ++j) { s += (v[j].x * v[j].x + v[j].y * v[j].y) + (v[j].z * v[j].z + v[j].w * v[j].w); s2 += (w[j].x * w[j].x + w[j].y * w[j].y) + (w[j].z * w[j].z + w[j].w * w[j].w); }
        const float r = rsqrtf(wave_sum(s) * (1.f / DM) + EPS), r2 = rsqrtf(wave_sum(s2) * (1.f / DM) + EPS);
        f32x4* y = (f32x4*)(a.out + (size_t)m * DM); f32x4* y2 = (f32x4*)(a.out + (size_t)mb * DM);
#pragma unroll
        for (int j = 0; j < 4; ++j) { const int q = 2 * lane + (j & 1) + 128 * (j >> 1); y[q] = v[j] * r * gg[j]; if (has2) y2[q] = w[j] * r2 * gg[j]; }
    }
}
#define XB_TMO      128
#define XB_XCNT(j)  (256  + 64 * (j))
#define XB_XSUB(j)  (1280 + 64 * (j))
#define XB_XGEN(j)  (2304 + 64 * (j))
#define XB_TOP      3328
#define XB_TOPGEN   3392
#define XCD_BAR_WORDS 3456
#define XB_SPIN_CAP (1u << 18)

__device__ __forceinline__ unsigned xb_ld(unsigned* p)              { return __hip_atomic_load(p, __ATOMIC_RELAXED, __HIP_MEMORY_SCOPE_AGENT); }
__device__ __forceinline__ unsigned xb_add(unsigned* p, unsigned v) { return __hip_atomic_fetch_add(p, v, __ATOMIC_RELAXED, __HIP_MEMORY_SCOPE_AGENT); }
__device__ __forceinline__ unsigned xb_xcc_id() { return (unsigned)__builtin_amdgcn_s_getreg((3 << 11) | 20) & 0xFu; }
#define XB_SPIN(cond, bar) do { unsigned _sp = 0; while (cond) { __builtin_amdgcn_s_sleep(1); \
    if ((++_sp & 255u) == 0u) { if (xb_ld(&(bar)[XB_TMO])) break; if (_sp > XB_SPIN_CAP) { atomicAdd(&(bar)[XB_TMO], 1u); break; } } } } while (0)

struct XcdBarrier {
    unsigned* bar; unsigned x;
    volatile LAS unsigned* st;
};

__device__ __forceinline__ XcdBarrier xcd_barrier_post(unsigned* bar, volatile LAS unsigned* st) {
    XcdBarrier b; b.bar = bar; b.x = xb_xcc_id(); b.st = st;
    if (threadIdx.x == 0) (void)xb_add(&bar[XB_XCNT(b.x)], 1u);
    return b;
}
__device__ __forceinline__ void xcd_barrier_complete(unsigned* bar, unsigned x, unsigned& nloc, unsigned& nx) {
    const unsigned G = gridDim.x * gridDim.y * gridDim.z;
    unsigned sum, cnt, mine, sp = 0u;
    for (;;) {
        sum = 0u; cnt = 0u; mine = 0u;
#pragma unroll
        for (unsigned j = 0; j < 16; ++j) { const unsigned c = xb_ld(&bar[XB_XCNT(j)]); sum += c; cnt += (c > 0u) ? 1u : 0u; mine = (j == x) ? c : mine; }
        if (sum == G) break;
        __builtin_amdgcn_s_sleep(1);
        if ((++sp & 255u) == 0u) { if (xb_ld(&bar[XB_TMO])) break; if (sp > XB_SPIN_CAP) { atomicAdd(&bar[XB_TMO], 1u); break; } }
    }
    nloc = mine > 0u ? mine : 1u; nx = cnt > 0u ? cnt : 1u;
}

__device__ __forceinline__ void xcd_barrier(const XcdBarrier& b) {
    asm volatile("s_waitcnt vmcnt(0)" ::: "memory");
    __syncthreads();
    if (threadIdx.x == 0) {
        unsigned* bar = b.bar;
        __builtin_amdgcn_s_waitcnt(0);
        unsigned nloc = b.st[0], nx = b.st[1];
        if (nloc == 0u) { xcd_barrier_complete(bar, b.x, nloc, nx); b.st[0] = nloc; b.st[1] = nx; }
        const unsigned old = xb_add(&bar[XB_XSUB(b.x)], 1u);
        const unsigned gen = old / nloc;
        if (old + 1u == (gen + 1u) * nloc) {
            __builtin_amdgcn_fence(__ATOMIC_RELEASE, "agent");
            asm volatile("s_waitcnt vmcnt(0)" ::: "memory");
            const unsigned og = xb_add(&bar[XB_TOP], 1u);
            const unsigned tg = og / nx;
            if (og + 1u == (tg + 1u) * nx) xb_add(&bar[XB_TOPGEN], 1u);
            else XB_SPIN(xb_ld(&bar[XB_TOPGEN]) == tg, bar);
            __builtin_amdgcn_fence(__ATOMIC_ACQUIRE, "agent");
            xb_add(&bar[XB_XGEN(b.x)], 1u);
            asm volatile("s_waitcnt vmcnt(0)" ::: "memory");
        } else {
            XB_SPIN(xb_ld(&bar[XB_XGEN(b.x)]) == gen, bar);
            __builtin_amdgcn_fence(__ATOMIC_ACQUIRE, "agent");
            asm volatile("s_waitcnt vmcnt(0)" ::: "memory");
        }
    }
    __syncthreads();
}

constexpr int NPH = 13;
__global__ void __launch_bounds__(512, 2) fwd_mega(Args args) {
    extern __shared__ __attribute__((aligned(16))) unsigned char lds_raw[];
    LAS unsigned char* lds = (LAS unsigned char*)lds_raw;
    cg::grid_group grid = cg::this_grid();
    const int tid = threadIdx.x, lane = tid & 63, wave = __builtin_amdgcn_readfirstlane(tid >> 6), G = gridDim.x, bx = blockIdx.x;
    unsigned char* ws = args.ws;
    const int lo = args.ph_lo, hi = args.ph_hi;
#define IN(k) (lo <= (k) && (k) < hi)
    volatile LAS unsigned* barst = (volatile LAS unsigned*)(lds + LDS_BARST);
    if (tid < 2) barst[tid] = 0u;
    __syncthreads();
    XcdBarrier xbar; xbar.bar = (unsigned*)(ws + WS_BAR); xbar.x = 0; xbar.st = barst;
    if (lo < 0) grid.sync();
    if (hi - lo > 1) xbar = xcd_barrier_post((unsigned*)(ws + WS_BAR), barst);
#define SEAM(k) do { if (IN(k) && IN((k) + 1)) xcd_barrier(xbar); } while (0)
    bf16_t* XN = (bf16_t*)(ws + WS_XN);
    if (IN(0)) { REPS(0) p0_prologue(args, lds, wave, lane, G); }
    SEAM(0);
    if (IN(1)) REPS(1) {
        { pg8::Gemm g{XN, (const bf16_t*)(ws + WS_WIN), MPAD, 3584, 1024}; pg8::StaticOrder S; S.init(MPAD, 3584, G, bx);
          EpiIn E{(bf16_t*)(ws + WS_QB), (bf16_t*)(ws + WS_KB), (bf16_t*)(ws + WS_VB), (bf16_t*)(ws + WS_QH), (bf16_t*)(ws + WS_VH), (bf16_t*)(ws + WS_GH), (bf16_t*)(ws + WS_VT),
                  (float*)(ws + WS_LF), (const float*)(ws + WS_LB), args.out};
          pg8::gemm_phase<EpiIn, pg8::StaticOrder, true, true>(lds, g, S, E); }
        { pg8::Gemm g{(const bf16_t*)(ws + WS_MN), (const bf16_t*)(ws + WS_WCKV), 1024, 1024, 1024}; pg8::StaticOrder S; S.init(1024, 1024, G, G - 1 - bx);
          EpiMem E{(bf16_t*)(ws + WS_MKB), (bf16_t*)(ws + WS_MVB), args.out};
          pg8::gemm_phase<EpiMem, pg8::StaticOrder, true, true>(lds, g, S, E); }
        if (MK_N_LAUNCHES == 1 && bx >= 142) {
            __syncthreads();
            LAS float* scr = (LAS float*)(lds + wave * 16384);
            for (int it = W_ITEMS_EARLY + (bx - 142) * 8 + wave; it < W_ITEMS; it += (G - 142) * 8) weight_item(args, scr, it, lane);
            __syncthreads();
        }
    }
    SEAM(1);
    if (IN(2)) {
        for (int ch = bx; ch < 1024; ch += G) hgrn_step1(args, lds, ch, tid);
        __syncthreads();
        LAS unsigned char* wl = lds + wave * 8192;
        {
            const int x = bx & 7, lw = (bx >> 3) * 8 + wave;
#pragma unroll 1
            REPS(2) for (int kk = 0; kk < 3; ++kk) { if (kk < 2) dil_attn_unit(args, wl, ((((kk * 2 + (lw >> 7)) * 8 + x) << 7) | (lw & 127)), lane);
                else sample_attn_unit<0, 2>(args, wl, (LAS float*)(lds + 65536), bx * 4 + (wave & 3), wave & 3, wave >> 2, lane); }
        }
    }
    SEAM(2);
    if (IN(3)) { REPS(3) hgrn_scan(args, G); }
    SEAM(3);
    if (IN(4)) REPS(4) {
#pragma unroll 1
        for (int u = bx * 8 + wave; u < 4096; u += G * 8) { const int I = u < 2048 ? 3 - (u & 3) : (u & 3), ch = u >> 2;
            if (I == 0) hgrn_step3<0>(args, ch, lane); else if (I == 1) hgrn_step3<1>(args, ch, lane); else if (I == 2) hgrn_step3<2>(args, ch, lane); else hgrn_step3<3>(args, ch, lane); }
        __syncthreads();
        for (int u = G - 1 - bx; u < 128; u += G) hgrn_sample(args, lds, u, tid);
    }
    SEAM(4);
    if (IN(5)) {
        pg8::Gemm g{(const bf16_t*)(ws + WS_MIX), (const bf16_t*)(ws + WS_WOUT), MP, 1024, 1024}; pg8::StaticOrder S; S.init(MP, 1024, G, bx);
        EpiRes<0> E{args.in[0], args.out, XN, (unsigned long long*)(ws + WS_SS1)};
        pg8::gemm_phase<EpiRes<0>, pg8::StaticOrder, false, true>(lds, g, S, E);
        mini_gemm_res<0>(lds, (const bf16_t*)(ws + WS_MIX), (const bf16_t*)(ws + WS_WOUT), 1024, args.in[1], args.out, XN, (unsigned long long*)(ws + WS_SS1), tid);
    }
    SEAM(5);
    if (IN(6)) REPS(6) {
        pg8::Gemm g{XN, (const bf16_t*)(ws + WS_WCQ), MPAD, 512, 1024}; pg8::StaticOrder S; S.init(MPAD, 512, G, bx);
        EpiRS<0> E{(const unsigned long long*)(ws + WS_SS1), (bf16_t*)(ws + WS_CQ), nullptr, args.out, CQSCALE};
        pg8::gemm_phase<EpiRS<0>, pg8::StaticOrder, true, true>(lds, g, S, E);
    }
    SEAM(6);
    if (IN(7)) {
        REPS(7) for (int u = bx; u < 256; u += G) cross_unit(args, lds, u, tid);
        __syncthreads();
        LAS unsigned char* wl = lds + wave * 4096;
        sample_attn_unit<1, 4>(args, wl, (LAS float*)(lds + 65536), bx * 2 + (wave >> 2), wave >> 2, wave & 3, lane);
    }
    SEAM(7);
    if (IN(8)) {
        pg8::Gemm g{(const bf16_t*)(ws + WS_CO), (const bf16_t*)(ws + WS_WCO), MP, 1024, 512}; pg8::StaticOrder S; S.init(MP, 1024, G, bx);
        EpiRes<1> E{nullptr, args.out, XN, (unsigned long long*)(ws + WS_SS2)};
        pg8::gemm_phase<EpiRes<1>, pg8::StaticOrder, false, true>(lds, g, S, E);
        mini_gemm_res<1>(lds, (const bf16_t*)(ws + WS_CO), (const bf16_t*)(ws + WS_WCO), 512, nullptr, args.out, XN, (unsigned long long*)(ws + WS_SS2), tid);
    }
    SEAM(8);
    if (IN(9)) REPS(9) {
        pg8::Gemm g{XN, (const bf16_t*)(ws + WS_WGU), MPAD, 2 * DFF, 1024}; pg8::StaticOrder S; S.init(MPAD, 2 * DFF, G, bx);
        EpiGU E{(const unsigned long long*)(ws + WS_SS2), (bf16_t*)(ws + WS_ACT), args.in[5], (float*)(ws + WS_EDGE), (float*)(ws + WS_PART), (float*)(ws + WS_UPV),
                args.in[24], args.in[25], args.out, lds + 131072};
        pg8::gemm_phase<EpiGU, pg8::StaticOrder, true, true>(lds, g, S, E);
    }
    SEAM(9);
    if (IN(11)) {
        { const int wg = (bx & 7) * 32 + (bx >> 3), pm0 = (wg >> 5) * 8 + (wg & 7);
          ffn_fixup_local(args, pm0, tid); }
        pg8::Gemm g{(const bf16_t*)(ws + WS_ACT), (const bf16_t*)(ws + WS_WD), MP, 1024, DFF}; pg8::StaticOrder S; S.init(MP, 1024, G, bx);
        EpiFinal E{XN, (unsigned long long*)(ws + WS_SS3), (unsigned*)(ws + WS_CNT), args.in[27], args.out};
        pg8::gemm_phase<EpiFinal, pg8::StaticOrder, true, true>(lds, g, S, E);
        mini_gemm_res<2>(lds, (const bf16_t*)(ws + WS_ACT), (const bf16_t*)(ws + WS_WD), DFF, nullptr, args.out, XN, (unsigned long long*)(ws + WS_SS3), tid, (unsigned*)(ws + WS_CNT), args.in[27]);
    }
#undef IN
#undef SEAM
}

extern "C" void kernel_launch(void* const* d_in, const int* in_sizes, int n_in, void* d_out, int out_size, void* d_ws, size_t ws_size, hipStream_t stream) {
    static int grid = 0;
    if (grid == 0) {
        int dev = 0, cus = 0, per_cu = 0;
        (void)hipGetDevice(&dev); (void)hipDeviceGetAttribute(&cus, hipDeviceAttributeMultiprocessorCount, dev);
        if (hipFuncSetAttribute((const void*)fwd_mega, hipFuncAttributeMaxDynamicSharedMemorySize, LDS_BYTES) != hipSuccess) fprintf(stderr, "hipFuncSetAttribute failed\n");
        (void)hipOccupancyMaxActiveBlocksPerMultiprocessor(&per_cu, (const void*)fwd_mega, 512, LDS_BYTES);
        (void)hipGetLastError();
        grid = 256;
        if (cus < 256) fprintf(stderr, "kernel_launch: device reports %d CUs, this kernel needs 256\n", cus);
        if (n_in != 28 || ws_size < 384 * MiB) { fprintf(stderr, "kernel_launch: unexpected inputs (n_in %d, ws %zu)\n", n_in, ws_size); }
    }
    Args a{};
    for (int i = 0; i < 28; ++i) a.in[i] = (const float*)d_in[i];
    a.out = (float*)d_out; a.ws = (unsigned char*)d_ws;
#if MK_N_LAUNCHES == 1
    a.ph_lo = 0; a.ph_hi = NPH;
    (void)hipMemsetAsync((unsigned char*)d_ws + WS_BAR, 0, 3456 * 4, stream);
    void* kargs[] = {&a};
    hipError_t e = hipLaunchCooperativeKernel((const void*)fwd_mega, dim3(grid), dim3(512), kargs, LDS_BYTES, stream);
    if (e != hipSuccess) fprintf(stderr, "cooperative launch failed: %s (grid %d)\n", hipGetErrorString(e), grid);
#else
    for (int p = 0; p < NPH; ++p) { a.ph_lo = p; a.ph_hi = p + 1; hipLaunchKernelGGL(fwd_mega, dim3(grid), dim3(512), LDS_BYTES, stream, a); }
#endif
}
```

```cpp
#include <hip/hip_runtime.h>
#include <hip/hip_cooperative_groups.h>
#include <cstdio>
#include <cstdint>
namespace cg = cooperative_groups;
#ifndef MK_N_LAUNCHES
#define MK_N_LAUNCHES 1
#endif
#ifndef REP_MASK
#define REP_MASK 0
#endif
#define REPS(k) for (int rep_ = 0; rep_ < 1 + ((REP_MASK >> (k)) & 1); ++rep_)
namespace pg8 {
#define PG8_LAS __attribute__((address_space(3)))
typedef unsigned short bf16_t;
typedef short bf16x8 __attribute__((ext_vector_type(8)));
typedef float f32x4 __attribute__((ext_vector_type(4)));
typedef unsigned u32x4 __attribute__((ext_vector_type(4)));
constexpr int BM = 256, BK = 64, HALF = 128, HTB = HALF * BK * 2  , STAGE_BYTES = 8 * HTB, NXCD = 8, WGM = 8;

__host__ __device__ __forceinline__ int lds_byte(int r, int c) { const int st = (r >> 4) * 2 + (c >> 5), rr = r & 15, cc = c & 31, ob = rr * 64 + cc * 2; return st * 1024 + (ob ^ (((ob >> 9) & 1) << 5)); }
__host__ __device__ __forceinline__ void stage_rc(int b, int& R, int& C) { const int st = b / 1024, sb = b % 1024, swz = sb ^ (((sb >> 9) & 1) << 5); R = (st >> 1) * 16 + swz / 64; C = (st & 1) * 32 + (swz % 64) / 2; }
__host__ __device__ __forceinline__ int perm32(int rho) { const int n = rho >> 4, i = rho & 15; return 8 * (i >> 2) + 4 * n + (i & 3); }

struct Unit { int pm, pn; };
struct Gemm { const bf16_t* A; const bf16_t* Bt; int M, N, K; };

struct StaticOrder {
    int nM, nN, nwg, G, c;
    __host__ __device__ void init(int M, int N, int G_, int c_) { nM = M / BM; nN = N / BM; nwg = nM * nN; G = G_; c = c_; }
    __host__ __device__ bool next(int i, Unit& u) const {
        const long L = (long)i * G + c; if (L >= nwg) return false;
        int wgid = (int)L; { const int q = nwg / NXCD, r = nwg % NXCD, xcd = wgid % NXCD, off = wgid / NXCD; wgid = (xcd < r ? xcd * (q + 1) : r * (q + 1) + (xcd - r) * q) + off; }
        const int nig = WGM * nN, gid = wgid / nig, fm = gid * WGM, gsz = (nM - fm) < WGM ? (nM - fm) : WGM;
        u.pm = fm + ((wgid % nig) % gsz); u.pn = (wgid % nig) / gsz; return true;
    }
    __device__ __forceinline__ void a_ready(const Unit&) const {}
    __device__ __forceinline__ void done(const Unit&) const {}
};


template <class Epi, class Sched, bool ALIGN_EPI = false, bool SP2 = false>
__device__ __forceinline__ void gemm_phase(PG8_LAS unsigned char* lds, const Gemm g, const Sched& S, const Epi& E) {
    const int tid = threadIdx.x, wid = __builtin_amdgcn_readfirstlane(tid >> 6), lane = tid & 63, wr = wid >> 2, wc = wid & 3, fr = lane & 15, fq = lane >> 4;
    const int K = g.K, nt = K / BK;
    unsigned voffA[2], voffB[2];
#pragma unroll
    for (int i = 0; i < 2; ++i) { int R, C; stage_rc(tid * 16 + i * 8192, R, C); const int Rb = Epi::PERM ? ((R & ~31) + perm32(R & 31)) : R;
        voffA[i] = (unsigned)(R * K + C) * 2u; voffB[i] = (unsigned)(Rb * K + C) * 2u; }
    const size_t kstep = (size_t)(BK * 2);
    const size_t hstep = (size_t)HALF * K * 2;
    const size_t tstep = 2 * hstep;
    const unsigned ldsw = (unsigned)wid * 1024u;
    const int aoff = lds_byte(wr * 64 + fr, fq * 8), boff = lds_byte(wc * 32 + fr, fq * 8);
#define PG8_SA(b, h) (((b) * 2 + (h)) * HTB)
#define PG8_SB(b, h) ((4 + (b) * 2 + (h)) * HTB)
#define PG8_STAGE(bufoff, gbase, voff) do { _Pragma("unroll") for (int _i = 0; _i < 2; ++_i) \
        __builtin_amdgcn_global_load_lds((const unsigned*)((const char*)(gbase) + (voff)[_i]), (PG8_LAS unsigned*)(lds + (bufoff) + ldsw + _i * 8192), 16, 0, 0); } while (0)
#define PG8_LDA(dst, b, h) do { _Pragma("unroll") for (int m = 0; m < 4; ++m) _Pragma("unroll") for (int k = 0; k < 2; ++k) dst[m][k] = *(const PG8_LAS bf16x8*)(lds + PG8_SA(b, h) + aoff + m * 2048 + k * 1024); } while (0)
#define PG8_LDB(dst, b, h) do { _Pragma("unroll") for (int n = 0; n < 2; ++n) _Pragma("unroll") for (int k = 0; k < 2; ++k) dst[n][k] = *(const PG8_LAS bf16x8*)(lds + PG8_SB(b, h) + boff + n * 2048 + k * 1024); } while (0)
#define PG8_MMA(ai, bj, At, Bt) do { __builtin_amdgcn_s_setprio(1); _Pragma("unroll") for (int m = 0; m < 4; ++m) _Pragma("unroll") for (int n = 0; n < 2; ++n) _Pragma("unroll") for (int k = 0; k < 2; ++k) \
        acc[ai][bj][m][n] = __builtin_amdgcn_mfma_f32_16x16x32_bf16(Bt[n][k], At[m][k], acc[ai][bj][m][n], 0, 0, 0); __builtin_amdgcn_s_setprio(0); } while (0)
#define PG8_WAIT_V(n) asm volatile("s_waitcnt vmcnt(" #n ")" ::: "memory")
#define PG8_WAIT_L(n) asm volatile("s_waitcnt lgkmcnt(" #n ")" ::: "memory")
#define PG8_BAR __builtin_amdgcn_s_barrier()
#define PG8_SCHED __builtin_amdgcn_sched_barrier(0)
    Unit cur, nxt; int ui = 0;
    if (!S.next(0, cur)) return;
    f32x4 acc[2][2][4][2];
#pragma unroll
    for (int a = 0; a < 2; ++a)
#pragma unroll
        for (int b = 0; b < 2; ++b)
#pragma unroll
            for (int m = 0; m < 4; ++m)
#pragma unroll
                for (int n = 0; n < 2; ++n) acc[a][b][m][n] = (f32x4){0.f, 0.f, 0.f, 0.f};
    bf16x8 At[4][2], B0[2][2], B1[2][2];
    const char* cA = (const char*)g.A + (size_t)cur.pm * tstep; const char* cB = (const char*)g.Bt + (size_t)cur.pn * tstep;
    S.a_ready(cur);
    if constexpr (SP2) {
        PG8_STAGE(PG8_SB(0, 0), cB, voffB); PG8_STAGE(PG8_SB(0, 1), cB + hstep, voffB); PG8_STAGE(PG8_SA(0, 0), cA, voffA); PG8_STAGE(PG8_SA(0, 1), cA + hstep, voffA);
        if (wr == 1) PG8_BAR;
        PG8_WAIT_V(2); PG8_BAR;
        PG8_STAGE(PG8_SB(1, 0), cB + kstep, voffB); PG8_STAGE(PG8_SA(1, 0), cA + kstep, voffA); PG8_STAGE(PG8_SB(1, 1), cB + hstep + kstep, voffB);
        PG8_WAIT_V(6); PG8_BAR;
    } else {
        PG8_STAGE(PG8_SB(0, 0), cB, voffB); PG8_STAGE(PG8_SA(0, 0), cA, voffA); PG8_STAGE(PG8_SB(0, 1), cB + hstep, voffB); PG8_STAGE(PG8_SA(0, 1), cA + hstep, voffA);
        if (wr == 1) PG8_BAR;
        PG8_WAIT_V(4); PG8_BAR;
        PG8_STAGE(PG8_SB(1, 0), cB + kstep, voffB); PG8_STAGE(PG8_SA(1, 0), cA + kstep, voffA); PG8_STAGE(PG8_SB(1, 1), cB + hstep + kstep, voffB);
        PG8_WAIT_V(6); PG8_BAR;
    }
    for (;;) {
        const bool has_next = S.next(ui + 1, nxt);
        const char* nA = has_next ? (const char*)g.A + (size_t)nxt.pm * tstep : cA; const char* nB = has_next ? (const char*)g.Bt + (size_t)nxt.pn * tstep : cB;
        for (int t = 0; t < nt; t += 2) {
            const bool last = (t == nt - 2);
            const char* a1 = cA + (size_t)(t + 1) * kstep;
            const char* a2 = last ? nA : cA + (size_t)(t + 2) * kstep; const char* b2 = last ? nB : cB + (size_t)(t + 2) * kstep;
            const char* a3 = a2 + kstep; const char* b3 = b2 + kstep;
            if (last && has_next) S.a_ready(nxt);
            if constexpr (SP2) {
            PG8_LDB(B0, 0, 0); PG8_LDB(B1, 0, 1); PG8_SCHED; PG8_LDA(At, 0, 0); PG8_STAGE(PG8_SA(1, 1), a1 + hstep, voffA);
            PG8_WAIT_V(8); PG8_WAIT_L(0); PG8_BAR; PG8_MMA(0, 0, At, B0); PG8_MMA(0, 1, At, B1); PG8_BAR; PG8_SCHED;
            PG8_LDA(At, 0, 1); PG8_STAGE(PG8_SB(0, 0), b2, voffB); PG8_STAGE(PG8_SB(0, 1), b2 + hstep, voffB); PG8_STAGE(PG8_SA(0, 0), a2, voffA);
            PG8_WAIT_V(8); PG8_WAIT_L(0); PG8_BAR; PG8_MMA(1, 0, At, B0); PG8_MMA(1, 1, At, B1); PG8_BAR; PG8_SCHED;
            PG8_LDB(B0, 1, 0); PG8_LDB(B1, 1, 1); PG8_SCHED; PG8_LDA(At, 1, 0); PG8_STAGE(PG8_SA(0, 1), a2 + hstep, voffA);
            PG8_WAIT_V(8); PG8_WAIT_L(0); PG8_BAR; PG8_MMA(0, 0, At, B0); PG8_MMA(0, 1, At, B1); PG8_BAR; PG8_SCHED;
            PG8_LDA(At, 1, 1); PG8_STAGE(PG8_SB(1, 0), b3, voffB); PG8_STAGE(PG8_SB(1, 1), b3 + hstep, voffB); PG8_STAGE(PG8_SA(1, 0), a3, voffA);
            PG8_WAIT_V(8); PG8_WAIT_L(0); PG8_BAR; PG8_MMA(1, 0, At, B0); PG8_MMA(1, 1, At, B1); PG8_BAR; PG8_SCHED;
            } else {
            PG8_LDB(B0, 0, 0); PG8_SCHED; PG8_LDA(At, 0, 0); PG8_STAGE(PG8_SA(1, 1), a1 + hstep, voffA);
            PG8_WAIT_L(8); PG8_BAR; PG8_WAIT_L(0); PG8_MMA(0, 0, At, B0); PG8_BAR; PG8_SCHED;
            PG8_LDB(B1, 0, 1); PG8_STAGE(PG8_SB(0, 0), b2, voffB);
            PG8_BAR; PG8_WAIT_L(0); PG8_MMA(0, 1, At, B1); PG8_BAR;
            PG8_LDA(At, 0, 1); PG8_STAGE(PG8_SA(0, 0), a2, voffA);
            PG8_BAR; PG8_WAIT_L(0); PG8_MMA(1, 0, At, B0); PG8_BAR; PG8_SCHED;
            PG8_STAGE(PG8_SB(0, 1), b2 + hstep, voffB);
            PG8_WAIT_V(6); PG8_BAR; PG8_MMA(1, 1, At, B1); PG8_BAR;
            PG8_LDB(B0, 1, 0); PG8_SCHED; PG8_LDA(At, 1, 0); PG8_STAGE(PG8_SA(0, 1), a2 + hstep, voffA);
            PG8_WAIT_L(8); PG8_BAR; PG8_WAIT_L(0); PG8_MMA(0, 0, At, B0); PG8_BAR; PG8_SCHED;
            PG8_LDB(B1, 1, 1); PG8_STAGE(PG8_SB(1, 0), b3, voffB);
            PG8_BAR; PG8_WAIT_L(0); PG8_MMA(0, 1, At, B1); PG8_BAR;
            PG8_LDA(At, 1, 1); PG8_STAGE(PG8_SA(1, 0), a3, voffA);
            PG8_BAR; PG8_WAIT_L(0); PG8_MMA(1, 0, At, B0); PG8_BAR; PG8_SCHED;
            PG8_STAGE(PG8_SB(1, 1), b3 + hstep, voffB);
            PG8_WAIT_V(6); PG8_BAR; PG8_MMA(1, 1, At, B1); PG8_BAR;
            }
        }
        if constexpr (ALIGN_EPI) { if (wr == 0) PG8_BAR; }
        if constexpr (!Epi::AFTER_DRAIN) { E(acc, cur, wr, wc, fr, fq); S.done(cur); }
        if (!has_next) break;
#pragma unroll
        for (int a = 0; a < 2; ++a)
#pragma unroll
            for (int b = 0; b < 2; ++b)
#pragma unroll
                for (int m = 0; m < 4; ++m)
#pragma unroll
                    for (int n = 0; n < 2; ++n) acc[a][b][m][n] = (f32x4){0.f, 0.f, 0.f, 0.f};
        cur = nxt; cA = nA; cB = nB; ++ui;
        if constexpr (ALIGN_EPI) { if (wr == 1) PG8_BAR; }
    }
    PG8_WAIT_V(0);
    if constexpr (!ALIGN_EPI) { if (wr == 0) PG8_BAR; }
    PG8_BAR;
    if constexpr (Epi::AFTER_DRAIN) { E.fused(acc, cur, wr, wc, fr, fq, lds, wid, lane); S.done(cur); }
#undef PG8_SA
#undef PG8_SB
#undef PG8_STAGE
#undef PG8_LDA
#undef PG8_LDB
#undef PG8_MMA
#undef PG8_WAIT_V
#undef PG8_WAIT_L
#undef PG8_BAR
#undef PG8_SCHED
}
}
using pg8::bf16_t; using pg8::bf16x8; using pg8::f32x4; using pg8::u32x4; using pg8::Unit;
typedef short s16x4 __attribute__((ext_vector_type(4)));
typedef unsigned u32x2 __attribute__((ext_vector_type(2)));
#define LAS __attribute__((address_space(3)))
constexpr int MP = 16384, MSAMP = 128, MT = MP + MSAMP, MPAD = 16640, DM = 1024, SEQ = 4096, DFF = 2816;
constexpr float EPS = 1e-6f, LOG2E = 1.4426950408889634f;
constexpr float QSCALE = 0.125f * LOG2E;
constexpr float CQSCALE = 0.08838834764831845f * LOG2E;
constexpr float HQSCALE = 0.08838834764831845f;
constexpr size_t O_Y = 0, O_WKP = 16908288, O_WVP = 21102592, O_HSP = 25296896, O_FCP = 25559040, O_MKP = 25581568, O_MVP = 26105856,
                 O_WKS = 26630144, O_WVS = 26695680, O_HSS = 26761216, O_FCS = 28858368;
constexpr size_t MiB = 1u << 20;
constexpr size_t WS_WIN = 0, WS_WOUT = 7 * MiB, WS_WCQ = 9 * MiB, WS_WCKV = 10 * MiB, WS_WCO = 12 * MiB, WS_WGU = 13 * MiB, WS_WD = 24 * MiB,
                 WS_LB = 30 * MiB, WS_SS1 = WS_LB + 4096, WS_SS2 = WS_SS1 + 256 * 1024, WS_XN = 32 * MiB, WS_CQ = 65 * MiB, WS_CO = 82 * MiB,
                 WS_MKB = 99 * MiB, WS_MVB = 100 * MiB, WS_MN = 101 * MiB,
                 WS_QB = 104 * MiB, WS_KB = 121 * MiB, WS_VB = 138 * MiB, WS_QH = 155 * MiB, WS_VH = 172 * MiB, WS_GH = 189 * MiB, WS_LF = 206 * MiB,
                 WS_VT = 239 * MiB, WS_KV = 255 * MiB, WS_SP = 319 * MiB, WS_MIX = 351 * MiB,
                 WS_UG = 104 * MiB, WS_UP = 194 * MiB, WS_ACT = 284 * MiB;
constexpr size_t WS_SS3 = 30 * MiB + 600 * 1024, WS_CNT = 30 * MiB + 800 * 1024, WS_BAR = 31 * MiB, WS_EDGE = 375 * MiB, WS_PART = 377 * MiB, WS_UPV = 379 * MiB, WS_UGS = 381 * MiB, WS_UPS = 382 * MiB;
constexpr int LDS_BYTES = 147456, LDS_BARST = 147456 - 64;

struct Args { const float* in[28]; float* out; unsigned char* ws; int ph_lo, ph_hi; };

typedef float f32x2_t __attribute__((ext_vector_type(2))); typedef __bf16 bf16x2_t __attribute__((ext_vector_type(2)));
__device__ __forceinline__ unsigned pk2(float lo, float hi) { unsigned r; asm volatile("v_cvt_pk_bf16_f32 %0, %1, %2" : "=v"(r) : "v"(lo), "v"(hi)); return r; }
__device__ __forceinline__ unsigned pk2m(float lo, float hi) { const f32x2_t v = {lo, hi}; const bf16x2_t b = __builtin_convertvector(v, bf16x2_t); return __builtin_bit_cast(unsigned, b); }
__device__ __forceinline__ float bflo(unsigned w) { return __uint_as_float(w << 16); }
__device__ __forceinline__ float bfhi(unsigned w) { return __uint_as_float(w & 0xffff0000u); }
__device__ __forceinline__ float bf1(bf16_t h) { return __uint_as_float((unsigned)h << 16); }
__device__ __forceinline__ void store_bf16x8(bf16_t* p, f32x4 a, f32x4 b) { u32x4 w; w.x = pk2(a[0], a[1]); w.y = pk2(a[2], a[3]); w.z = pk2(b[0], b[1]); w.w = pk2(b[2], b[3]); *(u32x4*)p = w; }
__device__ __forceinline__ float wave_sum(float v) {
#pragma unroll
    for (int o = 1; o < 64; o <<= 1) v += __shfl_xor(v, o);
    return v;
}
__device__ __forceinline__ float wave_max(float v) {
#pragma unroll
    for (int o = 1; o < 64; o <<= 1) v = fmaxf(v, __shfl_xor(v, o));
    return v;
}
__device__ __forceinline__ float xg_max(float x) {
    auto s = __builtin_amdgcn_permlane16_swap(__float_as_uint(x), __float_as_uint(x), false, false); x = fmaxf(__uint_as_float(s[0]), __uint_as_float(s[1]));
    auto u = __builtin_amdgcn_permlane32_swap(__float_as_uint(x), __float_as_uint(x), false, false); return fmaxf(__uint_as_float(u[0]), __uint_as_float(u[1]));
}
__device__ __forceinline__ float xg_sum(float x) {
    auto s = __builtin_amdgcn_permlane16_swap(__float_as_uint(x), __float_as_uint(x), false, false); x = __uint_as_float(s[0]) + __uint_as_float(s[1]);
    auto u = __builtin_amdgcn_permlane32_swap(__float_as_uint(x), __float_as_uint(x), false, false); return __uint_as_float(u[0]) + __uint_as_float(u[1]);
}
__device__ __forceinline__ float silu_f(float x) { return x * __builtin_amdgcn_rcpf(1.f + __expf(-x)); }
__device__ __forceinline__ float ex2(float x) { return __builtin_amdgcn_exp2f(x); }

#define EPI_ROWS_BEGIN  _Pragma("unroll") for (int ai = 0; ai < 2; ++ai) _Pragma("unroll") for (int m = 0; m < 4; ++m) { const int row = u.pm * 256 + ai * 128 + wr * 64 + m * 16 + fr;
#define EPI_ROWS_END }

struct EpiIn {
    static constexpr bool PERM = true, AFTER_DRAIN = false;
    bf16_t *Qb, *Kb, *Vb, *QH, *VH, *GH, *VT; float* LF; const float* LB; float* out;
    __device__ __forceinline__ void operator()(const f32x4 (&acc)[2][2][4][2], const Unit& u, int wr, int wc, int fr, int fq) const {
        const int grp = u.pn >> 1;
        EPI_ROWS_BEGIN
            if (row >= MT) continue;
#pragma unroll
            for (int bj = 0; bj < 2; ++bj) {
                const int cc = (u.pn & 1) * 256 + bj * 128 + wc * 32 + 8 * fq;
                f32x4 v0 = acc[ai][bj][m][0], v1 = acc[ai][bj][m][1];
                const size_t o = (size_t)row * 512 + cc;
                if (grp == 0) { store_bf16x8(Qb + o, v0 * QSCALE, v1 * QSCALE); }
                else if (grp == 1 || grp == 2) {
                    store_bf16x8((grp == 1 ? Kb : Vb) + o, v0, v1);
                    float* dst = nullptr;
                    if (row >= MP) dst = out + (grp == 1 ? O_WKS : O_WVS) + (size_t)(row - MP) * 512 + cc;
                    else { const int t = row & 4095, b = row >> 12; if (t >= 2048) dst = out + (grp == 1 ? O_WKP : O_WVP) + (size_t)(b * 2048 + t - 2048) * 512 + cc; }
                    if (dst) { *(f32x4*)dst = v0; *(f32x4*)(dst + 4) = v1; }
                } else if (grp == 3) {
#pragma unroll
                    for (int j = 0; j < 4; ++j) { v0[j] = silu_f(v0[j]) * HQSCALE; v1[j] = silu_f(v1[j]) * HQSCALE; }
                    store_bf16x8(QH + o, v0, v1);
                } else if (grp == 4) {
                    const f32x4 l0 = *(const f32x4*)(LB + cc), l1 = *(const f32x4*)(LB + cc + 4);
#pragma unroll
                    for (int j = 0; j < 4; ++j) { v0[j] = __logf(l0[j] + (1.f - l0[j]) * __builtin_amdgcn_rcpf(1.f + __expf(-v0[j]))); v1[j] = __logf(l1[j] + (1.f - l1[j]) * __builtin_amdgcn_rcpf(1.f + __expf(-v1[j]))); }
                    *(f32x4*)(LF + o) = v0; *(f32x4*)(LF + o + 4) = v1;
                } else if (grp == 5) {
                    store_bf16x8(VH + o, v0, v1);
                    if (row < MP) { const int t = row & 4095, b = row >> 12; bf16_t* vt = VT + (size_t)(b * 512 + cc) * 4096 + t;
#pragma unroll
                        for (int j = 0; j < 4; ++j) { vt[(size_t)j * 4096] = (bf16_t)(pk2(v0[j], 0.f) & 0xffffu); vt[(size_t)(j + 4) * 4096] = (bf16_t)(pk2(v1[j], 0.f) & 0xffffu); } }
                } else { store_bf16x8(GH + o, v0, v1); }
            }
        EPI_ROWS_END
    }
};

struct EpiMem {
    static constexpr bool PERM = true, AFTER_DRAIN = false;
    bf16_t *MKB, *MVB; float* out;
    __device__ __forceinline__ void operator()(const f32x4 (&acc)[2][2][4][2], const Unit& u, int wr, int wc, int fr, int fq) const {
        const bool isv = u.pn >= 2;
        EPI_ROWS_BEGIN
#pragma unroll
            for (int bj = 0; bj < 2; ++bj) {
                const int cc = (u.pn & 1) * 256 + bj * 128 + wc * 32 + 8 * fq;
                const f32x4 v0 = acc[ai][bj][m][0], v1 = acc[ai][bj][m][1];
                const size_t o = (size_t)row * 512 + cc;
                store_bf16x8((isv ? MVB : MKB) + o, v0, v1);
                float* dst = out + (isv ? O_MVP : O_MKP) + o; *(f32x4*)dst = v0; *(f32x4*)(dst + 4) = v1;
            }
        EPI_ROWS_END
    }
};

template <int MODE> struct EpiRes {
    static constexpr bool PERM = true, AFTER_DRAIN = false;
    const float* xin; float* out; bf16_t* XN; unsigned long long* ss;
    __device__ __forceinline__ void operator()(const f32x4 (&acc)[2][2][4][2], const Unit& u, int wr, int wc, int fr, int fq) const {
        EPI_ROWS_BEGIN
            float sq = 0.f;
#pragma unroll
            for (int bj = 0; bj < 2; ++bj) {
                const int col = u.pn * 256 + bj * 128 + wc * 32 + 8 * fq;
                f32x4 v0 = acc[ai][bj][m][0], v1 = acc[ai][bj][m][1];
                const size_t o = (size_t)row * DM + col;
                if (MODE == 0) { v0 += *(const f32x4*)(xin + o); v1 += *(const f32x4*)(xin + o + 4); }
                else { const u32x4 w = *(const u32x4*)(XN + o); v0 += (f32x4){bflo(w.x), bfhi(w.x), bflo(w.y), bfhi(w.y)}; v1 += (f32x4){bflo(w.z), bfhi(w.z), bflo(w.w), bfhi(w.w)}; }
                if (MODE == 2) { store_bf16x8(XN + o, v0, v1); }
                else { store_bf16x8(XN + o, v0, v1);
                    sq += (v0[0] * v0[0] + v0[1] * v0[1]) + (v0[2] * v0[2] + v0[3] * v0[3]) + (v1[0] * v1[0] + v1[1] * v1[1]) + (v1[2] * v1[2] + v1[3] * v1[3]); }
            }
            if (MODE != 2) { sq = xg_sum(sq); if (fq == 0) atomicAdd(ss + row, (unsigned long long)(sq * 16777216.f)); }
        EPI_ROWS_END
    }
};
struct EpiFinal {
    static constexpr bool PERM = true, AFTER_DRAIN = false;
    const bf16_t* XN; unsigned long long* ss3; unsigned* cnt; const float* g; float* out;
    __device__ __forceinline__ void operator()(const f32x4 (&acc_)[2][2][4][2], const Unit& u, int wr, int wc, int fr, int fq) const {
        f32x4 (&x)[2][2][4][2] = const_cast<f32x4 (&)[2][2][4][2]>(acc_);
        EPI_ROWS_BEGIN
            float sq = 0.f;
#pragma unroll
            for (int bj = 0; bj < 2; ++bj) {
                const int col = u.pn * 256 + bj * 128 + wc * 32 + 8 * fq;
                const u32x4 w = *(const u32x4*)(XN + ((unsigned)row * (unsigned)DM + (unsigned)col));
                f32x4 v0 = x[ai][bj][m][0] + (f32x4){bflo(w.x), bfhi(w.x), bflo(w.y), bfhi(w.y)}, v1 = x[ai][bj][m][1] + (f32x4){bflo(w.z), bfhi(w.z), bflo(w.w), bfhi(w.w)};
                x[ai][bj][m][0] = v0; x[ai][bj][m][1] = v1;
                sq += (v0[0] * v0[0] + v0[1] * v0[1]) + (v0[2] * v0[2] + v0[3] * v0[3]) + (v1[0] * v1[0] + v1[1] * v1[1]) + (v1[2] * v1[2] + v1[3] * v1[3]);
            }
            sq = xg_sum(sq);
            if (fq == 0) (void)__hip_atomic_fetch_add(ss3 + row, (unsigned long long)(sq * 16777216.f), __ATOMIC_RELAXED, __HIP_MEMORY_SCOPE_AGENT);
        EPI_ROWS_END
        asm volatile("s_waitcnt vmcnt(0) lgkmcnt(0)" ::: "memory"); __builtin_amdgcn_s_barrier(); asm volatile("" ::: "memory");
        if (threadIdx.x == 0) {
            unsigned* c = cnt + 64 * u.pm;
            (void)__hip_atomic_fetch_add(c, 1u, __ATOMIC_RELAXED, __HIP_MEMORY_SCOPE_AGENT);
            unsigned spins = 0;
            while (__hip_atomic_load(c, __ATOMIC_RELAXED, __HIP_MEMORY_SCOPE_AGENT) < 4u && ++spins < (1u << 22)) __builtin_amdgcn_s_sleep(2);
        }
        asm volatile("s_waitcnt vmcnt(0) lgkmcnt(0)" ::: "memory"); __builtin_amdgcn_s_barrier(); asm volatile("" ::: "memory");
        EPI_ROWS_BEGIN
            const unsigned long long sv = __hip_atomic_load(ss3 + row, __ATOMIC_RELAXED, __HIP_MEMORY_SCOPE_AGENT);
            const float r = rsqrtf((float)sv * (1.f / (16777216.f * DM)) + EPS);
#pragma unroll
            for (int bj = 0; bj < 2; ++bj) {
                const int col = u.pn * 256 + bj * 128 + wc * 32 + 8 * fq;
                const f32x4 g0 = *(const f32x4*)(g + col), g1 = *(const f32x4*)(g + col + 4);
                float* op = out + ((unsigned)row * (unsigned)DM + (unsigned)col);
                *(f32x4*)op = x[ai][bj][m][0] * r * g0; *(f32x4*)(op + 4) = x[ai][bj][m][1] * r * g1;
            }
        EPI_ROWS_END
    }
};
template <int MODE> __device__ __forceinline__ void mini_gemm_res(LAS unsigned char* lds, const bf16_t* A, const bf16_t* Bt, int K, const float* xin_s, float* out, bf16_t* XN, unsigned long long* ss, int tid, unsigned* cnt = nullptr, const float* gfin = nullptr) {
    const int bx = blockIdx.x, rg = bx & 7, cgp = bx >> 3, wave = tid >> 6, lane = tid & 63, lr = lane & 15, lg = lane >> 4;
    const int kw = K >> 3, k0 = wave * kw;
    const bf16_t* ap = A + (size_t)(MP + 16 * rg + lr) * K + k0 + lg * 8;
    const bf16_t* bp0 = Bt + (size_t)(32 * cgp + lr) * K + k0 + lg * 8; const bf16_t* bp1 = bp0 + (size_t)16 * K;
    f32x4 a0 = {0.f, 0.f, 0.f, 0.f}, a1 = a0;
#pragma unroll 11
    for (int ks = 0; ks < kw; ks += 32) { const bf16x8 af = *(const bf16x8*)(ap + ks);
        a0 = __builtin_amdgcn_mfma_f32_16x16x32_bf16(af, *(const bf16x8*)(bp0 + ks), a0, 0, 0, 0);
        a1 = __builtin_amdgcn_mfma_f32_16x16x32_bf16(af, *(const bf16x8*)(bp1 + ks), a1, 0, 0, 0); }
    LAS float* red = (LAS float*)lds;
    __syncthreads();
#pragma unroll
    for (int j = 0; j < 4; ++j) { red[(wave * 16 + lg * 4 + j) * 32 + lr] = a0[j]; red[(wave * 16 + lg * 4 + j) * 32 + 16 + lr] = a1[j]; }
    __syncthreads();
    const int m = tid >> 5, n = tid & 31;
    float v = 0.f;
#pragma unroll
    for (int w = 0; w < 8; ++w) v += red[(w * 16 + m) * 32 + n];
    const int row = MP + 16 * rg + m, col = 32 * cgp + n; const size_t o = (size_t)row * DM + col;
    if (MODE == 0) v += xin_s[(size_t)(row - MP) * DM + col]; else v += bf1(XN[o]);
    if (MODE != 2) XN[o] = (bf16_t)(pk2(v, 0.f) & 0xffffu);
    float sq = v * v;
#pragma unroll
    for (int s = 1; s < 32; s <<= 1) sq += __shfl_xor(sq, s);
    if (n == 0) (void)__hip_atomic_fetch_add(ss + row, (unsigned long long)(sq * 16777216.f), __ATOMIC_RELAXED, __HIP_MEMORY_SCOPE_AGENT);
    if (MODE == 2) {
        asm volatile("s_waitcnt vmcnt(0) lgkmcnt(0)" ::: "memory"); __syncthreads();
        if (tid == 0) { unsigned* c = cnt + 64 * (64 + rg); (void)__hip_atomic_fetch_add(c, 1u, __ATOMIC_RELAXED, __HIP_MEMORY_SCOPE_AGENT);
            unsigned spins = 0; while (__hip_atomic_load(c, __ATOMIC_RELAXED, __HIP_MEMORY_SCOPE_AGENT) < 32u && ++spins < (1u << 22)) __builtin_amdgcn_s_sleep(2); }
        __syncthreads();
        const unsigned long long sv = __hip_atomic_load(ss + row, __ATOMIC_RELAXED, __HIP_MEMORY_SCOPE_AGENT);
        out[o] = v * rsqrtf((float)sv * (1.f / (16777216.f * DM)) + EPS) * gfin[col];
    }
    __syncthreads();
}
template <int MODE> struct EpiRS {
    static constexpr bool PERM = true, AFTER_DRAIN = false;
    const unsigned long long* ss; bf16_t* O0; bf16_t* O1; float* out; float scale;
    __device__ __forceinline__ void operator()(const f32x4 (&acc)[2][2][4][2], const Unit& u, int wr, int wc, int fr, int fq) const {
        EPI_ROWS_BEGIN
            const float rs = rsqrtf((float)ss[row] * (1.f / (16777216.f * DM)) + EPS) * scale;
#pragma unroll
            for (int bj = 0; bj < 2; ++bj) {
                const int col = u.pn * 256 + bj * 128 + wc * 32 + 8 * fq;
                const f32x4 v0 = acc[ai][bj][m][0] * rs, v1 = acc[ai][bj][m][1] * rs;
                if (MODE == 0) store_bf16x8(O0 + (size_t)row * 512 + col, v0, v1);
                else {
                    const bool up = u.pn >= 11; const int c2 = up ? col - DFF : col;
                    store_bf16x8((up ? O1 : O0) + (size_t)row * DFF + c2, v0, v1);
                    if (!up) { float* dst = nullptr;
                        if (row < MP) { const int t = row & 4095; if (t >= 4094) dst = out + O_FCP + (size_t)((row >> 12) * 2 + t - 4094) * DFF + c2; }
                        else if (row < MT) { const int t = (row - MP) & 3; if (t >= 2) dst = out + O_FCS + (size_t)(((row - MP) >> 2) * 2 + t - 2) * DFF + c2; }
                        if (dst) { *(f32x4*)dst = v0; *(f32x4*)(dst + 4) = v1; } }
                }
            }
        EPI_ROWS_END
    }
};
struct EpiGU {
    static constexpr bool PERM = true, AFTER_DRAIN = false;
    const unsigned long long* ss; bf16_t* ACT; const float* cst; float* EDGE; float* PART; float* UPV; const float* cw; const float* cb; float* out; LAS unsigned char* xl;
    __device__ __forceinline__ void operator()(const f32x4 (&acc)[2][2][4][2], const Unit& u, int wr, int wc, int fr, int fq) const {
        const int c0 = u.pn * 128 + wc * 32 + 8 * fq;
        if (u.pm == 64) {
            const int lane = threadIdx.x & 63, i1 = (lane - 1) * 4, i2 = (lane - 2) * 4, t = fr & 3;
            f32x4 wv[2][4];
#pragma unroll
            for (int n = 0; n < 2; ++n) { wv[n][0] = *(const f32x4*)(cw + c0 + 4 * n); wv[n][1] = *(const f32x4*)(cw + DFF + c0 + 4 * n); wv[n][2] = *(const f32x4*)(cw + 2 * DFF + c0 + 4 * n); wv[n][3] = *(const f32x4*)(cb + c0 + 4 * n); }
#pragma unroll
            for (int m = 0; m < 4; ++m) {
                const int sr = wr * 64 + m * 16 + fr, b = sr >> 2;
                const float rs = rsqrtf((float)ss[(unsigned)(MP + sr)] * (1.f / (16777216.f * DM)) + EPS);
                u32x4 q;
#pragma unroll
                for (int n = 0; n < 2; ++n) {
                    const f32x4 cur = acc[0][0][m][n] * rs, upv = acc[0][1][m][n] * rs;
                    f32x4 x1, x2;
#pragma unroll
                    for (int c = 0; c < 4; ++c) { x1[c] = __int_as_float(__builtin_amdgcn_ds_bpermute(i1, __float_as_int(cur[c]))); x2[c] = __int_as_float(__builtin_amdgcn_ds_bpermute(i2, __float_as_int(cur[c]))); }
                    if (t < 1) x1 = *(const f32x4*)(cst + (unsigned)((b * 2 + 1) * DFF + c0 + 4 * n));
                    if (t < 2) x2 = *(const f32x4*)(cst + (unsigned)((b * 2 + t) * DFF + c0 + 4 * n));
                    f32x4 r;
#pragma unroll
                    for (int c = 0; c < 4; ++c) r[c] = silu_f(wv[n][3][c] + wv[n][0][c] * x2[c] + wv[n][1][c] * x1[c] + wv[n][2][c] * cur[c]) * upv[c];
                    if (n == 0) { q.x = pk2(r[0], r[1]); q.y = pk2(r[2], r[3]); } else { q.z = pk2(r[0], r[1]); q.w = pk2(r[2], r[3]); }
                    if (t >= 2) *(f32x4*)(out + O_FCS + (unsigned)(((sr >> 2) * 2 + t - 2) * DFF + c0 + 4 * n)) = cur;
                }
                *(u32x4*)(ACT + ((unsigned)(MP + sr) * (unsigned)DFF + (unsigned)c0)) = q;
            }
            return;
        }
        const int lane = threadIdx.x & 63;
        float rsv[2][4];
#pragma unroll
        for (int ai = 0; ai < 2; ++ai)
#pragma unroll
            for (int m = 0; m < 4; ++m) rsv[ai][m] = rsqrtf((float)ss[(unsigned)(u.pm * 256 + ai * 128 + wr * 64 + m * 16 + fr)] * (1.f / (16777216.f * DM)) + EPS);
        LAS float* ex = (LAS float*)xl;
#pragma unroll
        for (int ai = 0; ai < 2; ++ai) { const float rs = rsv[ai][3];
            if (fr >= 14) { LAS float* d = ex + (((wr * 4 + wc) * 2 + ai) * 2 + (fr - 14)) * 32 + 8 * fq; const f32x4 a0 = acc[ai][0][3][0] * rs, a1 = acc[ai][0][3][1] * rs;
                d[0] = a0[0]; d[1] = a0[1]; d[2] = a0[2]; d[3] = a0[3]; d[4] = a1[0]; d[5] = a1[1]; d[6] = a1[2]; d[7] = a1[3];
                if (ai == 1 && wr == 1) { float* e = EDGE + (unsigned)((u.pm * 2 + (fr - 14)) * DFF + c0); *(f32x4*)e = a0; *(f32x4*)(e + 4) = a1;
                    if ((u.pm & 15) == 15) { float* dst = out + O_FCP + (unsigned)(((u.pm >> 4) * 2 + fr - 14) * DFF + c0); *(f32x4*)dst = a0; *(f32x4*)(dst + 4) = a1; } } } }
        asm volatile("s_waitcnt lgkmcnt(0)" ::: "memory"); __builtin_amdgcn_s_barrier(); asm volatile("" ::: "memory");
        const int i1 = (fr >= 1 ? lane - 1 : lane + 15) * 4, i2 = (fr >= 2 ? lane - 2 : lane + 14) * 4;
        u32x2 stash[2][4];
#pragma unroll
        for (int n = 0; n < 2; ++n) {
            const int cn = c0 + 4 * n;
            const f32x4 w0 = *(const f32x4*)(cw + cn), w1 = *(const f32x4*)(cw + DFF + cn), w2 = *(const f32x4*)(cw + 2 * DFF + cn), bb = *(const f32x4*)(cb + cn);
#pragma unroll
            for (int ai = 0; ai < 2; ++ai) {
                const int swr = wr ^ 1, sai = (ai == 1 && wr == 1) ? 1 : 0;
                f32x4 prev = *(const LAS f32x4*)(ex + (((swr * 4 + wc) * 2 + sai) * 2 + (fr & 1)) * 32 + 8 * fq + 4 * n);
#pragma unroll
                for (int m = 0; m < 4; ++m) {
                    const int row = u.pm * 256 + ai * 128 + wr * 64 + m * 16 + fr;
                    const float rs = rsv[ai][m];
                    const f32x4 cur = acc[ai][0][m][n] * rs, upv = acc[ai][1][m][n] * rs;
                    f32x4 r;
                    const bool first = (ai == 0 && wr == 0 && m == 0);
#pragma unroll
                    for (int c = 0; c < 4; ++c) {
                        const float g1 = __int_as_float(__builtin_amdgcn_ds_bpermute(i1, __float_as_int(fr == 15 ? prev[c] : cur[c])));
                        const float g2 = __int_as_float(__builtin_amdgcn_ds_bpermute(i2, __float_as_int(fr >= 14 ? prev[c] : cur[c])));
                        if (first && fr < 2) { PART[(unsigned)((u.pm * 2 + fr) * DFF + cn + c)] = bb[c] + w2[c] * cur[c] + (fr == 1 ? w1[c] * g1 : 0.f); UPV[(unsigned)((u.pm * 2 + fr) * DFF + cn + c)] = upv[c]; }
                        r[c] = silu_f(bb[c] + w0[c] * g2 + w1[c] * g1 + w2[c] * cur[c]) * upv[c];
                    }
                    { u32x2 w; w.x = pk2(r[0], r[1]); w.y = pk2(r[2], r[3]);
                      if (n == 0) stash[ai][m] = w;
                      else if (!(first && fr < 2)) { u32x4 q; q.x = stash[ai][m].x; q.y = stash[ai][m].y; q.z = w.x; q.w = w.y; *(u32x4*)(ACT + ((unsigned)row * (unsigned)DFF + (unsigned)c0)) = q; } }
                    prev = cur;
                }
            }
        }
    }
};
__device__ __forceinline__ void ffn_fixup_local(const Args& a, int pm, int tid) {
    unsigned char* ws = a.ws;
    const float* EDGE = (const float*)(ws + WS_EDGE); const float* PART = (const float*)(ws + WS_PART); const float* UPV = (const float*)(ws + WS_UPV); bf16_t* ACT = (bf16_t*)(ws + WS_ACT);
    const float* cw = a.in[24];
    float part[11], upv[11], gm1[11], gm2[11], c0v[11], c1v[11];
#pragma unroll
    for (int j = 0; j < 11; ++j) { const int i = tid + 512 * j, fr = i >= DFF ? 1 : 0, c = i - fr * DFF; const unsigned rr = (unsigned)((pm * 2 + fr) * DFF + c);
        part[j] = PART[rr]; upv[j] = UPV[rr]; c0v[j] = cw[c]; c1v[j] = cw[DFF + c];
        gm1[j] = (pm & 15) ? EDGE[(unsigned)(((pm - 1) * 2 + 1) * DFF + c)] : 0.f; gm2[j] = (pm & 15) ? EDGE[(unsigned)(((pm - 1) * 2) * DFF + c)] : 0.f; }
#pragma unroll
    for (int j = 0; j < 11; ++j) { const int i = tid + 512 * j, fr = i >= DFF ? 1 : 0, c = i - fr * DFF;
        const float conv = part[j] + (fr == 0 ? c1v[j] * gm1[j] + c0v[j] * gm2[j] : c0v[j] * gm1[j]);
        ACT[(unsigned)((pm * 256 + fr) * DFF + c)] = (bf16_t)(pk2(silu_f(conv) * upv[j], 0.f) & 0xffffu); }
    asm volatile("s_waitcnt vmcnt(0)" ::: "memory");
    __syncthreads();
}
__device__ __forceinline__ void p0_transpose_item(const float* W, int K, int N, const float* gk, bf16_t* WT, int row_off, LAS float* scr, int item, int lane, bool il = false) {
    const int nblk = N / 32, kb = item / nblk, nb = item % nblk, k0 = 64 * kb, n0 = 32 * nb;
    { const int kq = lane >> 3, n4 = (lane & 7) * 4; f32x4 v[8]; float g[8];
#pragma unroll
      for (int i = 0; i < 8; ++i) { v[i] = *(const f32x4*)(W + (size_t)(k0 + kq + 8 * i) * N + n0 + n4); g[i] = gk ? gk[k0 + kq + 8 * i] : 1.f; }
#pragma unroll
      for (int i = 0; i < 8; ++i) { LAS float* d = scr + (kq + 8 * i) * 33 + n4; d[0] = v[i][0] * g[i]; d[1] = v[i][1] * g[i]; d[2] = v[i][2] * g[i]; d[3] = v[i][3] * g[i]; } }
    asm volatile("s_waitcnt lgkmcnt(0)" ::: "memory");
    const int c = lane & 7;
#pragma unroll
    for (int j = 0; j < 4; ++j) { const int n = (lane >> 3) + 8 * j; const LAS float* s = scr + (8 * c) * 33 + n;
        u32x4 o; o.x = pk2(s[0 * 33], s[1 * 33]); o.y = pk2(s[2 * 33], s[3 * 33]); o.z = pk2(s[4 * 33], s[5 * 33]); o.w = pk2(s[6 * 33], s[7 * 33]);
        const int drow = il ? ((n0 >> 7) << 8) + (n0 & 127) + n + row_off : row_off + n0 + n;
        *(u32x4*)(WT + (size_t)drow * K + k0 + 8 * c) = o; }
    asm volatile("s_waitcnt lgkmcnt(0)" ::: "memory");
}
__device__ __forceinline__ void rms_rows2_to_bf16(const float* x0, bf16_t* o0, const float* x1, bf16_t* o1, bool has1, int lane) {
    const f32x4* xr = (const f32x4*)x0 + lane; const f32x4* yr = (const f32x4*)x1 + lane;
    f32x4 v[4], w[4]; float s = 0.f, s2 = 0.f;
#pragma unroll
    for (int j = 0; j < 4; ++j) { v[j] = xr[64 * j]; w[j] = yr[64 * j]; }
#pragma unroll
    for (int j = 0; j < 4; ++j) { s += (v[j].x * v[j].x + v[j].y * v[j].y) + (v[j].z * v[j].z + v[j].w * v[j].w); s2 += (w[j].x * w[j].x + w[j].y * w[j].y) + (w[j].z * w[j].z + w[j].w * w[j].w); }
    const float r = rsqrtf(wave_sum(s) * (1.f / DM) + EPS), r2 = rsqrtf(wave_sum(s2) * (1.f / DM) + EPS);
    u32x2* a8 = (u32x2*)o0 + lane; u32x2* b8 = (u32x2*)o1 + lane;
#pragma unroll
    for (int j = 0; j < 4; ++j) { u32x2 p; p.x = pk2(v[j].x * r, v[j].y * r); p.y = pk2(v[j].z * r, v[j].w * r); a8[64 * j] = p;
        if (has1) { u32x2 p2; p2.x = pk2(w[j].x * r2, w[j].y * r2); p2.y = pk2(w[j].z * r2, w[j].w * r2); b8[64 * j] = p2; } }
}
constexpr int WI_IN = 16 * 112, WI_C = 16 * 16, WI_OUT = 16 * 32, WI_CO = 8 * 32, WI_G = 16 * 88, WI_D = 44 * 32;
constexpr int W_ITEMS_EARLY = WI_IN + 2 * WI_C, W_ITEMS = W_ITEMS_EARLY + WI_OUT + WI_C + WI_CO + 2 * WI_G + WI_D;
__device__ __forceinline__ void weight_item(const Args& a, LAS float* scr, int it, int lane) {
    unsigned char* ws = a.ws; int r = it;
    if (r < WI_IN) { p0_transpose_item(a.in[11], 1024, 3584, a.in[10], (bf16_t*)(ws + WS_WIN), 0, scr, r, lane); return; } r -= WI_IN;
    if (r < WI_C) { p0_transpose_item(a.in[18], 1024, 512, a.in[16], (bf16_t*)(ws + WS_WCKV), 0, scr, r, lane); return; } r -= WI_C;
    if (r < WI_C) { p0_transpose_item(a.in[19], 1024, 512, a.in[16], (bf16_t*)(ws + WS_WCKV), 512, scr, r, lane); return; } r -= WI_C;
    if (r < WI_OUT) { const int k0 = 64 * (r / 32); const float* g = k0 < 512 ? a.in[12] : a.in[13] - 512; p0_transpose_item(a.in[14], 1024, 1024, g, (bf16_t*)(ws + WS_WOUT), 0, scr, r, lane); return; } r -= WI_OUT;
    if (r < WI_C) { p0_transpose_item(a.in[17], 1024, 512, a.in[15], (bf16_t*)(ws + WS_WCQ), 0, scr, r, lane); return; } r -= WI_C;
    if (r < WI_CO) { p0_transpose_item(a.in[20], 512, 1024, nullptr, (bf16_t*)(ws + WS_WCO), 0, scr, r, lane); return; } r -= WI_CO;
    if (r < WI_G) { p0_transpose_item(a.in[22], 1024, DFF, a.in[21], (bf16_t*)(ws + WS_WGU), 0, scr, r, lane, true); return; } r -= WI_G;
    if (r < WI_G) { p0_transpose_item(a.in[23], 1024, DFF, a.in[21], (bf16_t*)(ws + WS_WGU), 128, scr, r, lane, true); return; } r -= WI_G;
    p0_transpose_item(a.in[26], DFF, 1024, nullptr, (bf16_t*)(ws + WS_WD), 0, scr, r, lane);
}
__device__ __forceinline__ void p0_prologue(const Args& a, LAS unsigned char* lds, int wave, int lane, int G) {
    unsigned char* ws = a.ws;
    LAS float* scr = (LAS float*)(lds + wave * 16384);
    const int gw = blockIdx.x * 8 + wave, NGW = G * 8;
    for (int it = gw; it < (MK_N_LAUNCHES == 1 ? W_ITEMS_EARLY : W_ITEMS); it += NGW) weight_item(a, scr, it, lane);
    bf16_t* XN = (bf16_t*)(ws + WS_XN); bf16_t* MN = (bf16_t*)(ws + WS_MN);
    for (int m = gw; m < MT + 1024; m += 2 * NGW) {
        const int m2 = m + NGW; const bool has1 = m2 < MT + 1024; const int mb = has1 ? m2 : m;
        const float* xa = m < MP ? a.in[0] + (size_t)m * DM : (m < MT ? a.in[1] + (size_t)(m - MP) * DM : a.in[8] + (size_t)(m - MT) * DM);
        const float* xb = mb < MP ? a.in[0] + (size_t)mb * DM : (mb < MT ? a.in[1] + (size_t)(mb - MP) * DM : a.in[8] + (size_t)(mb - MT) * DM);
        bf16_t* oa = m < MT ? XN + (size_t)m * DM : MN + (size_t)(m - MT) * DM; bf16_t* ob = mb < MT ? XN + (size_t)mb * DM : MN + (size_t)(mb - MT) * DM;
        rms_rows2_to_bf16(xa, oa, xb, ob, has1, lane);
    }
    const int gt = blockIdx.x * 512 + threadIdx.x, NT = G * 512;
    float* LB = (float*)(ws + WS_LB); unsigned long long* SS1 = (unsigned long long*)(ws + WS_SS1); unsigned long long* SS2 = (unsigned long long*)(ws + WS_SS2);
    for (int i = gt; i < 512; i += NT) LB[i] = 1.f / (1.f + __expf(a.in[9][512 + i] - a.in[9][i]));
    for (int i = gt; i < MPAD; i += NT) { SS1[i] = 0ull; SS2[i] = 0ull; }
    for (int i = gt; i < MT; i += NT) ((unsigned long long*)(ws + WS_SS3))[i] = 0ull;
    for (int i = gt; i < 64 * 72; i += NT) ((unsigned*)(ws + WS_CNT))[i] = 0u;
}

__device__ __forceinline__ void hgrn_step1(const Args& a, LAS unsigned char* lds, int ch, int tid) {
    unsigned char* ws = a.ws;
    float* LF = (float*)(ws + WS_LF); const bf16_t* VT = (const bf16_t*)(ws + WS_VT); float* KV = (float*)(ws + WS_KV);
    LAS float* bsm = (LAS float*)lds;
    const int bh = ch >> 6, c = ch & 63, b = bh >> 2, h = bh & 3;
    const int row0 = b * SEQ + c * 64;
    const int k = tid & 127, seg = tid >> 7;
    float loc[16];
#pragma unroll
    for (int i = 0; i < 16; ++i) loc[i] = LF[(size_t)(row0 + seg * 16 + i) * 512 + h * 128 + k];
#pragma unroll
    for (int i = 1; i < 16; ++i) loc[i] += loc[i - 1];
    bsm[(seg * 16 + 15) * 129 + k] = loc[15];
    __syncthreads();
    float off = 0.f;
    for (int s = 0; s < seg; ++s) off += bsm[(s * 16 + 15) * 129 + k];
    __syncthreads();
#pragma unroll
    for (int i = 0; i < 16; ++i) { const float v = loc[i] + off; bsm[(seg * 16 + i) * 129 + k] = v; LF[(size_t)(row0 + seg * 16 + i) * 512 + h * 128 + k] = v; }
    __syncthreads();
    const int wave = tid >> 6, lane = tid & 63, lr = lane & 15, lg = lane >> 4;
    const bf16_t* vrow = VT + (size_t)(bh * 128 + wave * 16 + lr) * 4096 + c * 64;
    const bf16x8 A0 = *(const bf16x8*)(vrow + lg * 8), A1 = *(const bf16x8*)(vrow + 32 + lg * 8);
#pragma unroll 2
    for (int kb = 0; kb < 8; ++kb) {
        const int kk = kb * 16 + lr; const float bl = bsm[63 * 129 + kk];
        f32x4 acc = {0.f, 0.f, 0.f, 0.f};
#pragma unroll
        for (int ks = 0; ks < 2; ++ks) {
            const int s0 = ks * 32 + lg * 8;
            float bprev = s0 > 0 ? bsm[(s0 - 1) * 129 + kk] : 0.f;
            float w[8];
#pragma unroll
            for (int i = 0; i < 8; ++i) { const float bs = bsm[(s0 + i) * 129 + kk]; w[i] = (1.f - __expf(bs - bprev)) * __expf(bl - bs); bprev = bs; }
            u32x4 pw; pw.x = pk2m(w[0], w[1]); pw.y = pk2m(w[2], w[3]); pw.z = pk2m(w[4], w[5]); pw.w = pk2m(w[6], w[7]);
            acc = __builtin_amdgcn_mfma_f32_16x16x32_bf16(ks == 0 ? A0 : A1, __builtin_bit_cast(bf16x8, pw), acc, 0, 0, 0);
        }
        float* kvp = KV + ((size_t)ch * 128 + wave * 16 + lg * 4) * 128 + kk;
#pragma unroll
        for (int j = 0; j < 4; ++j) kvp[j * 128] = acc[j];
    }
    __syncthreads();
}
__device__ __forceinline__ void hgrn_scan(const Args& a, int G) {
    unsigned char* ws = a.ws;
    const float* Bc = (const float*)(ws + WS_LF); const float* KV = (const float*)(ws + WS_KV); bf16_t* SP = (bf16_t*)(ws + WS_SP);
    const int NT = G * 512;
    for (int e0 = blockIdx.x * 512 + threadIdx.x; e0 < 16 * 16384; e0 += 2 * NT) {
        const int e1 = e0 + NT; const bool has1 = e1 < 16 * 16384; const int e1c = has1 ? e1 : e0;
        const int bh0 = e0 >> 14, vk0 = e0 & 16383, bh1 = e1c >> 14, vk1 = e1c & 16383;
        const float* d0 = Bc + (size_t)((bh0 >> 2) * SEQ + 63) * 512 + (bh0 & 3) * 128 + (e0 & 127);
        const float* d1 = Bc + (size_t)((bh1 >> 2) * SEQ + 63) * 512 + (bh1 & 3) * 128 + (e1c & 127);
        float S0 = 0.f, S1 = 0.f;
        for (int c0 = 0; c0 < 64; c0 += 8) {
            float kv0[8], dl0[8], kv1[8], dl1[8];
#pragma unroll
            for (int i = 0; i < 8; ++i) { kv0[i] = KV[((size_t)(bh0 * 64 + c0 + i) << 14) + vk0]; dl0[i] = d0[(size_t)(c0 + i) * 64 * 512];
                                          kv1[i] = KV[((size_t)(bh1 * 64 + c0 + i) << 14) + vk1]; dl1[i] = d1[(size_t)(c0 + i) * 64 * 512]; }
#pragma unroll
            for (int i = 0; i < 8; ++i) { SP[((size_t)(bh0 * 64 + c0 + i) << 14) + vk0] = (bf16_t)(pk2(S0, 0.f) & 0xffffu); S0 = __expf(dl0[i]) * S0 + kv0[i];
                if (has1) SP[((size_t)(bh1 * 64 + c0 + i) << 14) + vk1] = (bf16_t)(pk2(S1, 0.f) & 0xffffu); S1 = __expf(dl1[i]) * S1 + kv1[i]; }
        }
        a.out[O_HSP + ((size_t)bh0 * 128 + (e0 & 127)) * 128 + ((e0 >> 7) & 127)] = S0;
        if (has1) a.out[O_HSP + ((size_t)bh1 * 128 + (e1 & 127)) * 128 + ((e1 >> 7) & 127)] = S1;
    }
}
template <int I> __device__ __forceinline__ void hgrn_step3(const Args& a, int ch, int lane) {
    unsigned char* ws = a.ws;
    const float* Bc = (const float*)(ws + WS_LF); const bf16_t* VT = (const bf16_t*)(ws + WS_VT); const bf16_t* SP = (const bf16_t*)(ws + WS_SP);
    const bf16_t* QH = (const bf16_t*)(ws + WS_QH); const bf16_t* GH = (const bf16_t*)(ws + WS_GH); bf16_t* MIX = (bf16_t*)(ws + WS_MIX);
    const int bh = ch >> 6, c = ch & 63, b = bh >> 2, h = bh & 3;
    const int row0 = b * SEQ + c * 64, rowI = row0 + 16 * I, hk = h * 128, lr = lane & 15, lg = lane >> 4;
    bf16x8 Qi[4], Qr[4];
#pragma unroll
    for (int ks = 0; ks < 4; ++ks) {
        const size_t o = (size_t)(rowI + lr) * 512 + hk + ks * 32 + lg * 8;
        const u32x4 qw = *(const u32x4*)(QH + o); const f32x4 b0 = *(const f32x4*)(Bc + o), b1 = *(const f32x4*)(Bc + o + 4);
        f32x4 r0 = {0.f, 0.f, 0.f, 0.f}, r1 = r0;
        if (I > 0) { const size_t orf = (size_t)(rowI - 1) * 512 + hk + ks * 32 + lg * 8; r0 = *(const f32x4*)(Bc + orf); r1 = *(const f32x4*)(Bc + orf + 4); }
        const float q[8] = {bflo(qw.x), bfhi(qw.x), bflo(qw.y), bfhi(qw.y), bflo(qw.z), bfhi(qw.z), bflo(qw.w), bfhi(qw.w)};
        const float bb[8] = {b0[0], b0[1], b0[2], b0[3], b1[0], b1[1], b1[2], b1[3]}; const float rr[8] = {r0[0], r0[1], r0[2], r0[3], r1[0], r1[1], r1[2], r1[3]};
        u32x4 wi, wr2; float x[8], y[8];
#pragma unroll
        for (int i = 0; i < 8; ++i) { x[i] = q[i] * __expf(bb[i]); y[i] = q[i] * __expf(bb[i] - rr[i]); }
        wi.x = pk2m(x[0], x[1]); wi.y = pk2m(x[2], x[3]); wi.z = pk2m(x[4], x[5]); wi.w = pk2m(x[6], x[7]);
        wr2.x = pk2m(y[0], y[1]); wr2.y = pk2m(y[2], y[3]); wr2.z = pk2m(y[4], y[5]); wr2.w = pk2m(y[6], y[7]);
        Qi[ks] = __builtin_bit_cast(bf16x8, wi); Qr[ks] = __builtin_bit_cast(bf16x8, wr2);
    }
    f32x4 oacc[8];
#pragma unroll
    for (int vb = 0; vb < 8; ++vb) { oacc[vb] = (f32x4){0.f, 0.f, 0.f, 0.f};
        const bf16_t* sp = SP + ((size_t)ch * 128 + vb * 16 + lr) * 128 + lg * 8;
#pragma unroll
        for (int ks = 0; ks < 4; ++ks) oacc[vb] = __builtin_amdgcn_mfma_f32_16x16x32_bf16(*(const bf16x8*)(sp + ks * 32), Qi[ks], oacc[vb], 0, 0, 0); }
    s16x4 Avs[I + 1][8];
#pragma unroll
    for (int J = 0; J <= I; ++J)
#pragma unroll
        for (int vb = 0; vb < 8; ++vb) Avs[J][vb] = *(const s16x4*)(VT + (size_t)(bh * 128 + vb * 16 + lr) * 4096 + c * 64 + 16 * J + lg * 4);
#pragma unroll
    for (int J = 0; J <= I; ++J) {
        f32x4 st = {0.f, 0.f, 0.f, 0.f};
        const int s = 16 * J + lr;
#pragma unroll
        for (int ks = 0; ks < 4; ++ks) {
            const size_t o = (size_t)(row0 + s) * 512 + hk + ks * 32 + lg * 8;
            const f32x4 b0 = *(const f32x4*)(Bc + o), b1 = *(const f32x4*)(Bc + o + 4);
            f32x4 p0 = {0.f, 0.f, 0.f, 0.f}, p1 = p0, r0 = p0, r1 = p0;
            if (s > 0) { p0 = *(const f32x4*)(Bc + o - 512); p1 = *(const f32x4*)(Bc + o - 512 + 4); }
            if (I > 0) { const size_t orf = (size_t)(rowI - 1) * 512 + hk + ks * 32 + lg * 8; r0 = *(const f32x4*)(Bc + orf); r1 = *(const f32x4*)(Bc + orf + 4); }
            float w[8];
#pragma unroll
            for (int i = 0; i < 4; ++i) { w[i] = (1.f - __expf(b0[i] - p0[i])) * __expf(fminf(r0[i] - b0[i], 80.f)); w[i + 4] = (1.f - __expf(b1[i] - p1[i])) * __expf(fminf(r1[i] - b1[i], 80.f)); }
            u32x4 pw; pw.x = pk2m(w[0], w[1]); pw.y = pk2m(w[2], w[3]); pw.z = pk2m(w[4], w[5]); pw.w = pk2m(w[6], w[7]);
            st = __builtin_amdgcn_mfma_f32_16x16x32_bf16(__builtin_bit_cast(bf16x8, pw), Qr[ks], st, 0, 0, 0);
        }
#pragma unroll
        for (int j = 0; j < 4; ++j) if (J > I || (J == I && lg * 4 + j > lr)) st[j] = 0.f;
        u32x2 pb; pb.x = pk2m(st[0], st[1]); pb.y = pk2m(st[2], st[3]);
        const s16x4 P = __builtin_bit_cast(s16x4, pb);
#pragma unroll
        for (int vb = 0; vb < 8; ++vb) {
            oacc[vb] = __builtin_amdgcn_mfma_f32_16x16x16bf16_1k(Avs[J][vb], P, oacc[vb], 0, 0, 0);
        }
    }
    float ssq = 0.f;
#pragma unroll
    for (int vb = 0; vb < 8; ++vb) ssq += (oacc[vb][0] * oacc[vb][0] + oacc[vb][1] * oacc[vb][1]) + (oacc[vb][2] * oacc[vb][2] + oacc[vb][3] * oacc[vb][3]);
    ssq = xg_sum(ssq);
    const float r = rsqrtf(ssq * (1.f / 128.f) + EPS);
#pragma unroll
    for (int vb = 0; vb < 8; ++vb) {
        const u32x2 gw = *(const u32x2*)(GH + (size_t)(rowI + lr) * 512 + hk + vb * 16 + lg * 4);
        u32x2 w; w.x = pk2(oacc[vb][0] * r * silu_f(bflo(gw.x)), oacc[vb][1] * r * silu_f(bfhi(gw.x))); w.y = pk2(oacc[vb][2] * r * silu_f(bflo(gw.y)), oacc[vb][3] * r * silu_f(bfhi(gw.y)));
        *(u32x2*)(MIX + (size_t)(rowI + lr) * DM + 512 + hk + vb * 16 + lg * 4) = w;
    }
}
__device__ __forceinline__ void hgrn_sample(const Args& a, LAS unsigned char* lds, int unit, int tid) {
    unsigned char* ws = a.ws;
    const float* LF = (const float*)(ws + WS_LF); const bf16_t* QH = (const bf16_t*)(ws + WS_QH); const bf16_t* VH = (const bf16_t*)(ws + WS_VH);
    const bf16_t* GH = (const bf16_t*)(ws + WS_GH); bf16_t* MIX = (bf16_t*)(ws + WS_MIX);
    LAS float* red = (LAS float*)lds;
    LAS float* tv = red + 1024;
    const int b = unit >> 2, h = unit & 3, hk = h * 128, v = tid & 127, kq = tid >> 7;
    __syncthreads();
    { const int t = tid >> 7, i = tid & 127; const size_t ro = (size_t)(MP + b * 4 + t) * 512 + hk + i;
      tv[t * 512 + i] = __expf(LF[ro]); tv[t * 512 + 128 + i] = bf1(QH[ro]); tv[t * 512 + 256 + i] = bf1(VH[ro]); tv[t * 512 + 384 + i] = bf1(GH[ro]); }
    float S[32];
    const float* s0 = a.in[4] + ((size_t)(b * 4 + h) * 128 + kq * 32) * 128 + v;
#pragma unroll
    for (int i = 0; i < 32; ++i) S[i] = s0[(size_t)i * 128];
    __syncthreads();
    for (int t = 0; t < 4; ++t) {
        const LAS float* tt = tv + t * 512;
        const float vv = tt[256 + v]; float op = 0.f;
#pragma unroll
        for (int i = 0; i < 32; ++i) { const int k = kq * 32 + i; const float f = tt[k]; S[i] = f * S[i] + (1.f - f) * vv; op += tt[128 + k] * S[i]; }
        red[kq * 128 + v] = op;
        __syncthreads();
        const float o = (red[v] + red[128 + v]) + (red[256 + v] + red[384 + v]);
        const float wsq = wave_sum(o * o);
        __syncthreads();
        if ((tid & 63) == 0) red[512 + (tid >> 6)] = wsq;
        __syncthreads();
        const float ssq = red[512] + red[513];
        if (kq == 0) { const float r = rsqrtf(ssq * (1.f / 128.f) + EPS);
            MIX[(size_t)(MP + b * 4 + t) * DM + 512 + hk + v] = (bf16_t)(pk2(o * r * silu_f(tt[384 + v]), 0.f) & 0xffffu); }
        __syncthreads();
    }
    float* so = a.out + O_HSS + ((size_t)(b * 4 + h) * 128 + kq * 32) * 128 + v;
#pragma unroll
    for (int i = 0; i < 32; ++i) so[(size_t)i * 128] = S[i];
}
__device__ __forceinline__ s16x4 tr_read(const LAS unsigned char* p) { typedef short v4i16_t __attribute__((ext_vector_type(4))); return __builtin_bit_cast(s16x4, __builtin_amdgcn_ds_read_tr16_b64_v4i16((LAS v4i16_t*)p)); }
__device__ __forceinline__ int dil_first_kb3(int p, int t0) { const int dsh = 2 * p, neg = (128 << dsh) - t0; return neg <= 0 ? 0 : (((neg + (1 << dsh) - 1) >> dsh) / 48); }
struct DilKV { bf16x8 K0[3], K1[3]; u32x4 V0[3], V1[3]; };
struct DilState { bf16x8 Q0, Q1; f32x4 o[4]; float m, l; };
__device__ __forceinline__ void dil_load(DilKV& R, const bf16_t* Kb, const bf16_t* Vb, size_t rowb, int h, int t0, int p, int kb3, int lr, int lg, int vkey, int vpart) {
    const int dsh = 2 * p, tb = t0 - (128 << dsh);
#pragma unroll
    for (int i = 0; i < 3; ++i) {
        const int kb = 3 * kb3 + i;
        int tk = tb + ((16 * kb + lr) << dsh); tk = tk < 0 ? 0 : (tk > SEQ - 1 ? SEQ - 1 : tk);
        const bf16_t* kp = Kb + (rowb + tk) * 512 + h * 64 + lg * 8;
        R.K0[i] = *(const bf16x8*)kp; R.K1[i] = *(const bf16x8*)(kp + 32);
        int tv = tb + ((16 * kb + vkey) << dsh); tv = tv < 0 ? 0 : (tv > SEQ - 1 ? SEQ - 1 : tv);
        const u32x4* vp = (const u32x4*)(Vb + (rowb + tv) * 512 + h * 64 + vpart * 16);
        R.V0[i] = vp[0]; R.V1[i] = vp[1];
    }
}
__device__ __forceinline__ void dil_qk(f32x4 (&st)[3], const DilKV& R, const DilState& S) {
#pragma unroll
    for (int i = 0; i < 3; ++i) { st[i] = (f32x4){0.f, 0.f, 0.f, 0.f};
        st[i] = __builtin_amdgcn_mfma_f32_16x16x32_bf16(R.K0[i], S.Q0, st[i], 0, 0, 0);
        st[i] = __builtin_amdgcn_mfma_f32_16x16x32_bf16(R.K1[i], S.Q1, st[i], 0, 0, 0); }
}
__device__ __forceinline__ void dil_consume(DilState& S, f32x4 (&st)[3], int jj0, int jmax, float sd, const LAS unsigned char* trp) {
    float bm = -INFINITY; const float bias0 = -sd * (float)jj0;
#pragma unroll
    for (int i = 0; i < 3; ++i)
#pragma unroll
        for (int j = 0; j < 4; ++j) { const int kk = 16 * i + j; const bool ok = (unsigned)(jj0 - kk) <= (unsigned)jmax;
            st[i][j] = ok ? st[i][j] + (bias0 + sd * (float)kk) : -INFINITY; bm = fmaxf(bm, st[i][j]); }
    bm = xg_max(bm);
    const float mnew = fmaxf(S.m, bm), corr = ex2(S.m - mnew);
    float ps = 0.f;
#pragma unroll
    for (int i = 0; i < 3; ++i)
#pragma unroll
        for (int j = 0; j < 4; ++j) { st[i][j] = ex2(st[i][j] - mnew); ps += st[i][j]; }
    ps = xg_sum(ps);
    S.l = S.l * corr + ps; S.m = mnew;
#pragma unroll
    for (int db = 0; db < 4; ++db) S.o[db] *= corr;
#pragma unroll
    for (int i = 0; i < 3; ++i) {
        u32x2 pb; pb.x = pk2m(st[i][0], st[i][1]); pb.y = pk2m(st[i][2], st[i][3]);
        const s16x4 P = __builtin_bit_cast(s16x4, pb);
#pragma unroll
        for (int db = 0; db < 4; ++db) S.o[db] = __builtin_amdgcn_mfma_f32_16x16x16bf16_1k(tr_read(trp + i * 2304 + db * 32), P, S.o[db], 0, 0, 0);
    }
}
__device__ __forceinline__ void dil_finish(DilState& S, bf16_t* MIX, size_t row, int h, int lg) {
    const float il = 1.f / S.l; float ssq = 0.f;
#pragma unroll
    for (int db = 0; db < 4; ++db) { S.o[db] *= il; ssq += (S.o[db][0] * S.o[db][0] + S.o[db][1] * S.o[db][1]) + (S.o[db][2] * S.o[db][2] + S.o[db][3] * S.o[db][3]); }
    ssq = xg_sum(ssq);
    const float rn = rsqrtf(ssq * (1.f / 64.f) + EPS);
#pragma unroll
    for (int db = 0; db < 4; ++db) { u32x2 w; w.x = pk2(S.o[db][0] * rn, S.o[db][1] * rn); w.y = pk2(S.o[db][2] * rn, S.o[db][3] * rn);
        *(u32x2*)(MIX + row * DM + h * 64 + db * 16 + lg * 4) = w; }
}
__device__ __forceinline__ void dil_attn_unit(const Args& a, LAS unsigned char* vl  , int unit, int lane) {
    unsigned char* ws = a.ws;
    const bf16_t* Qb = (const bf16_t*)(ws + WS_QB); const bf16_t* Kb = (const bf16_t*)(ws + WS_KB); const bf16_t* Vb = (const bf16_t*)(ws + WS_VB); bf16_t* MIX = (bf16_t*)(ws + WS_MIX);
    const int rp = unit & 7, blk = (unit >> 3) & 15, h = (unit >> 7) & 7, b = unit >> 10;
    const int lr = lane & 15, lg = lane >> 4, t0A = blk * 256 + rp, t0B = t0A + 8;
    const float slope = exp2f(-(float)(h + 1)) * LOG2E;
    const size_t rowb = (size_t)b * SEQ;
    DilState A, B;
    { const bf16_t* qa = Qb + (rowb + t0A + 16 * lr) * 512 + h * 64 + lg * 8; A.Q0 = *(const bf16x8*)qa; A.Q1 = *(const bf16x8*)(qa + 32);
      const bf16_t* qb = qa + 8 * 512; B.Q0 = *(const bf16x8*)qb; B.Q1 = *(const bf16x8*)(qb + 32); }
#pragma unroll
    for (int db = 0; db < 4; ++db) { A.o[db] = (f32x4){0.f, 0.f, 0.f, 0.f}; B.o[db] = A.o[db]; }
    A.m = -1e30f; A.l = 0.f; B.m = -1e30f; B.l = 0.f;
    const int vkey = lane >> 2, vpart = lane & 3, li = lane & 15;
    const LAS unsigned char* trp = vl + (lg * 4 + (li >> 2)) * 144 + (li & 3) * 8;
    const int tqA = t0A + 16 * lr, tqB = tqA + 8;
    int sg = 0, kb3 = dil_first_kb3(0, t0A);
    DilKV cur;
    dil_load(cur, Kb, Vb, rowb, h, t0A, 0, kb3, lr, lg, vkey, vpart);
#pragma unroll 1
    for (;;) {
        const int p = sg < 2 ? sg : 2, dsh = 2 * p, step = 16 >> dsh;
        f32x4 stA[3], stB[3];
        if (sg != 3) dil_qk(stA, cur, A);
        if (sg != 2) dil_qk(stB, cur, B);
#pragma unroll
        for (int i = 0; i < 3; ++i) { *(LAS u32x4*)(vl + i * 2304 + vkey * 144 + vpart * 32) = cur.V0[i]; *(LAS u32x4*)(vl + i * 2304 + vkey * 144 + vpart * 32 + 16) = cur.V1[i]; }
        int sn = sg, kn = kb3 + 1; const int nb3 = sg == 0 ? 8 : (sg == 1 ? 4 : 3);
        if (kn == nb3) { sn = sg + 1; kn = sn < 4 ? dil_first_kb3(sn < 2 ? sn : 2, sn == 3 ? t0B : t0A) : 0; }
        const bool last = sn == 4;
        if (!last) dil_load(cur, Kb, Vb, rowb, h, sn == 3 ? t0B : t0A, sn < 2 ? sn : 2, kn, lr, lg, vkey, vpart);
        const float sd = slope * (float)(1 << dsh);
        const int jbase = 128 + step * lr - 48 * kb3 - 4 * lg;
        if (sg != 3) { const int jm = tqA >> dsh; dil_consume(A, stA, jbase, jm < 128 ? jm : 128, sd, trp); }
        if (sg != 2) { const int jm = tqB >> dsh; dil_consume(B, stB, jbase + (sg < 2 ? (8 >> dsh) : 0), jm < 128 ? jm : 128, sd, trp); }
        if (last) break;
        sg = sn; kb3 = kn;
    }
    dil_finish(A, MIX, rowb + tqA, h, lg);
    dil_finish(B, MIX, rowb + tqB, h, lg);
}

template <int MODE> __device__ __forceinline__ const float* samp_row(const Args& a, int b, int t, int h, int e, bool isv) {
    if (MODE == 0) { const int p = e / 129, j = e - p * 129, idx = 2048 + t - (j << (2 * p));
        if (idx < 2048) return a.in[isv ? 3 : 2] + (((size_t)b * 2048 + idx) * 8 + h) * 64;
        return a.out + (isv ? O_WVS : O_WKS) + ((size_t)(b * 4 + idx - 2048) * 8 + h) * 64; }
    return a.in[isv ? 7 : 6] + (((size_t)b * 256 + e) * 4 + h) * 128;
}
template <int MODE, int NP, bool WSYNC = true> __device__ __forceinline__ void sample_attn_unit(const Args& a, LAS unsigned char* wl  , LAS float* xch  , int unit, int ul, int part, int lane) {
    constexpr int DH = MODE == 0 ? 64 : 128, NK = MODE == 0 ? 387 : 256, NH = MODE == 0 ? 8 : 4, NV = DH / 64, NKP = (NK + NP - 1) / NP;
    unsigned char* ws = a.ws;
    const int h = unit % NH, bt = unit / NH, b = bt >> 2, t = bt & 3;
    const int e0 = part * NKP, e1 = e0 + NKP < NK ? e0 + NKP : NK, nk = e1 - e0;
    LAS float* qs = (LAS float*)wl; LAS float* sc = qs + DH;
    const bf16_t* qp = (MODE == 0 ? (const bf16_t*)(ws + WS_QB) : (const bf16_t*)(ws + WS_CQ)) + (size_t)(MP + bt) * 512 + h * DH;
    for (int i = lane; i < DH; i += 64) qs[i] = bf1(qp[i]);
    const float slope = MODE == 0 ? exp2f(-(float)(h + 1)) * LOG2E : 0.f;
    float mx = -INFINITY;
    for (int el = lane; el < nk; el += 64) { const int e = e0 + el;
        const f32x4* kp = (const f32x4*)samp_row<MODE>(a, b, t, h, e, false); float dot = 0.f;
#pragma unroll
        for (int i = 0; i < DH / 4; ++i) { const f32x4 kv = kp[i]; const f32x4 qv = *(const LAS f32x4*)(qs + 4 * i); dot += (kv[0] * qv[0] + kv[1] * qv[1]) + (kv[2] * qv[2] + kv[3] * qv[3]); }
        if (MODE == 0) { const int p = e / 129, j = e - p * 129; dot -= slope * (float)(j << (2 * p)); }
        sc[el] = dot; mx = fmaxf(mx, dot);
    }
    mx = wave_max(mx);
    float sum = 0.f;
    for (int el = lane; el < nk; el += 64) { const float pe = ex2(sc[el] - mx); sc[el] = pe; sum += pe; }
    sum = wave_sum(sum);
    const int g = lane >> 4, d4 = lane & 15;
    f32x4 acc[NV];
#pragma unroll
    for (int v = 0; v < NV; ++v) acc[v] = (f32x4){0.f, 0.f, 0.f, 0.f};
    constexpr int NIT = (NKP + 3) / 4;
#pragma unroll 16
    for (int it = 0; it < NIT; ++it) { const int el = it * 4 + g; const bool ok = el < nk; const int ec = ok ? el : nk - 1;
        const float* vp = samp_row<MODE>(a, b, t, h, e0 + ec, true) + 4 * d4; const float pe = ok ? sc[ec] : 0.f;
#pragma unroll
        for (int v = 0; v < NV; ++v) acc[v] += *(const f32x4*)(vp + 64 * v) * pe; }
#pragma unroll
    for (int v = 0; v < NV; ++v)
#pragma unroll
        for (int j = 0; j < 4; ++j) { float x = acc[v][j]; x = xg_sum(x); acc[v][j] = x; }
    LAS float* xp = xch + (ul * NP + part) * (DH + 2);
    if (g == 0) {
#pragma unroll
        for (int v = 0; v < NV; ++v) *(LAS f32x4*)(xp + 64 * v + 4 * d4) = acc[v];
        if (d4 == 0) { xp[DH] = mx; xp[DH + 1] = sum; } }
    if (WSYNC) __syncthreads();
    else {
        volatile LAS unsigned* fl = (volatile LAS unsigned*)(xch + 1024) + ul * NP;
        asm volatile("s_waitcnt lgkmcnt(0)" ::: "memory");
        if (part != 0) { if (lane == 0) fl[part] = 1u; }
        else {
#pragma unroll
            for (int i = 1; i < NP; ++i) while (fl[i] == 0u) __builtin_amdgcn_s_sleep(1);
            asm volatile("" ::: "memory");
        }
    }
    if (part == 0) {
        const LAS float* x0 = xch + (ul * NP) * (DH + 2);
        float M = -INFINITY;
#pragma unroll
        for (int i = 0; i < NP; ++i) M = fmaxf(M, x0[i * (DH + 2) + DH]);
        float l = 0.f, o0 = 0.f, o1 = 0.f;
#pragma unroll
        for (int i = 0; i < NP; ++i) { const float f = ex2(x0[i * (DH + 2) + DH] - M); l += x0[i * (DH + 2) + DH + 1] * f; o0 += x0[i * (DH + 2) + lane] * f; if (MODE == 1) o1 += x0[i * (DH + 2) + 64 + lane] * f; }
        const float il = 1.f / l; o0 *= il; o1 *= il;
        if (MODE == 0) { const float rn = rsqrtf(wave_sum(o0 * o0) * (1.f / 64.f) + EPS);
            ((bf16_t*)(ws + WS_MIX))[(size_t)(MP + bt) * DM + h * 64 + lane] = (bf16_t)(pk2(o0 * rn, 0.f) & 0xffffu); }
        else { bf16_t* cp = (bf16_t*)(ws + WS_CO) + (size_t)(MP + bt) * 512 + h * 128; cp[lane] = (bf16_t)(pk2(o0, 0.f) & 0xffffu); cp[lane + 64] = (bf16_t)(pk2(o1, 0.f) & 0xffffu); }
    }
}

__device__ __forceinline__ void cross_unit(const Args& a, LAS unsigned char* lds, int unit, int tid) {
    unsigned char* ws = a.ws;
    const bf16_t* CQ = (const bf16_t*)(ws + WS_CQ); const bf16_t* MKB = (const bf16_t*)(ws + WS_MKB); const bf16_t* MVB = (const bf16_t*)(ws + WS_MVB); bf16_t* CO = (bf16_t*)(ws + WS_CO);
    const int qblk = unit & 15, h = (unit >> 4) & 3, b = unit >> 6;
    LAS unsigned char* ksm = lds; LAS unsigned char* vsm = lds + 256 * 272;
    __syncthreads();
    for (int i = tid; i < 4096; i += 512) { const int m = i >> 4, ck = i & 15; const size_t g = (size_t)(b * 256 + m) * 512 + h * 128 + ck * 8;
        *(LAS u32x4*)(ksm + m * 272 + ck * 16) = *(const u32x4*)(MKB + g); *(LAS u32x4*)(vsm + m * 272 + ck * 16) = *(const u32x4*)(MVB + g); }
    __syncthreads();
    const int wave = tid >> 6, lane = tid & 63, lr = lane & 15, lg = lane >> 4, li = lane & 15;
#pragma unroll 1
    for (int qq = 0; qq < 2; ++qq) {
        const size_t row = (size_t)b * SEQ + qblk * 256 + (wave * 2 + qq) * 16 + lr;
        bf16x8 Qf[4];
#pragma unroll
        for (int ks = 0; ks < 4; ++ks) Qf[ks] = *(const bf16x8*)(CQ + row * 512 + h * 128 + ks * 32 + lg * 8);
        f32x4 st[16]; float mx = -INFINITY;
#pragma unroll
        for (int kb = 0; kb < 16; ++kb) { st[kb] = (f32x4){0.f, 0.f, 0.f, 0.f};
#pragma unroll
            for (int ks = 0; ks < 4; ++ks) st[kb] = __builtin_amdgcn_mfma_f32_16x16x32_bf16(*(const LAS bf16x8*)(ksm + (kb * 16 + lr) * 272 + (ks * 32 + lg * 8) * 2), Qf[ks], st[kb], 0, 0, 0);
            mx = fmaxf(mx, fmaxf(fmaxf(st[kb][0], st[kb][1]), fmaxf(st[kb][2], st[kb][3]))); }
        mx = xg_max(mx);
        float sum = 0.f; s16x4 P[16];
#pragma unroll
        for (int kb = 0; kb < 16; ++kb) { f32x4 e;
#pragma unroll
            for (int j = 0; j < 4; ++j) { e[j] = ex2(st[kb][j] - mx); sum += e[j]; }
            u32x2 pb; pb.x = pk2m(e[0], e[1]); pb.y = pk2m(e[2], e[3]); P[kb] = __builtin_bit_cast(s16x4, pb); }
        sum = xg_sum(sum);
        const float il = 1.f / sum;
        const LAS unsigned char* trp = vsm + (lg * 4 + (li >> 2)) * 272 + (li & 3) * 8;
#pragma unroll
        for (int db = 0; db < 8; ++db) { f32x4 o = {0.f, 0.f, 0.f, 0.f};
#pragma unroll
            for (int kb = 0; kb < 16; ++kb) o = __builtin_amdgcn_mfma_f32_16x16x16bf16_1k(tr_read(trp + kb * 16 * 272 + db * 32), P[kb], o, 0, 0, 0);
            u32x2 w; w.x = pk2(o[0] * il, o[1] * il); w.y = pk2(o[2] * il, o[3] * il);
            *(u32x2*)(CO + row * 512 + h * 128 + db * 16 + lg * 4) = w; }
    }
}

__device__ __forceinline__ void unpack8(const u32x4 g, float (&x)[8]) { x[0] = bflo(g.x); x[1] = bfhi(g.x); x[2] = bflo(g.y); x[3] = bfhi(g.y); x[4] = bflo(g.z); x[5] = bfhi(g.z); x[6] = bflo(g.w); x[7] = bfhi(g.w); }
__device__ __forceinline__ void act_pass(const Args& a, int G) {
    unsigned char* ws = a.ws;
    const bf16_t* UG = (const bf16_t*)(ws + WS_UG); const bf16_t* UP = (const bf16_t*)(ws + WS_UP); bf16_t* ACT = (bf16_t*)(ws + WS_ACT);
    const float* cw = a.in[24]; const float* cb = a.in[25]; const float* st = a.in[5];
    constexpr int CH = DFF / 8, RG = 45;
    const int gt = blockIdx.x * 512 + threadIdx.x;
    const int c0 = (gt % CH) * 8, r0 = (gt / CH) * RG;
    if (r0 >= MT) return;
    const int r1 = r0 + RG < MT ? r0 + RG : MT;
    float w0[8], w1[8], w2[8], bb[8];
#pragma unroll
    for (int j = 0; j < 8; ++j) { w0[j] = cw[c0 + j]; w1[j] = cw[DFF + c0 + j]; w2[j] = cw[2 * DFF + c0 + j]; bb[j] = cb[c0 + j]; }
    float x1[8], x2[8];
    { const int t = r0 < MP ? (r0 & 4095) : ((r0 - MP) & 3);
#pragma unroll
      for (int j = 0; j < 8; ++j) { x1[j] = 0.f; x2[j] = 0.f; }
      if (t >= 1) unpack8(*(const u32x4*)(UG + (size_t)(r0 - 1) * DFF + c0), x1);
      if (t >= 2) unpack8(*(const u32x4*)(UG + (size_t)(r0 - 2) * DFF + c0), x2);
      if (r0 >= MP && t == 1) { const float* sp = st + ((size_t)((r0 - MP) >> 2) * 2 + 1) * DFF + c0;
#pragma unroll
          for (int j = 0; j < 8; ++j) x2[j] = sp[j]; } }
#pragma unroll 5
    for (int row = r0; row < r1; ++row) {
        const int t = row < MP ? (row & 4095) : ((row - MP) & 3);
        if (t == 0) {
            if (row >= MP) { const float* sp = st + (size_t)((row - MP) >> 2) * 2 * DFF + c0;
#pragma unroll
                for (int j = 0; j < 8; ++j) { x2[j] = sp[j]; x1[j] = sp[DFF + j]; } }
            else {
#pragma unroll
                for (int j = 0; j < 8; ++j) { x1[j] = 0.f; x2[j] = 0.f; } }
        }
        float x0[8], uu[8];
        unpack8(*(const u32x4*)(UG + (size_t)row * DFF + c0), x0); unpack8(*(const u32x4*)(UP + (size_t)row * DFF + c0), uu);
        float r[8];
#pragma unroll
        for (int j = 0; j < 8; ++j) { const float cv = bb[j] + w0[j] * x2[j] + w1[j] * x1[j] + w2[j] * x0[j]; r[j] = silu_f(cv) * uu[j]; x2[j] = x1[j]; x1[j] = x0[j]; }
        u32x4 w; w.x = pk2(r[0], r[1]); w.y = pk2(r[2], r[3]); w.z = pk2(r[4], r[5]); w.w = pk2(r[6], r[7]);
        *(u32x4*)(ACT + (size_t)row * DFF + c0) = w;
    }
}
__device__ __forceinline__ void final_norm(const Args& a, int G, int wave, int lane) {
    const float* g = a.in[27]; const bf16_t* XN = (const bf16_t*)(a.ws + WS_XN);
    f32x4 gg[4];
#pragma unroll
    for (int j = 0; j < 4; ++j) gg[j] = *((const f32x4*)g + 2 * lane + (j & 1) + 128 * (j >> 1));
    const int NGW = G * 8;
    for (int m = MP + blockIdx.x * 8 + wave; m < MT; m += 2 * NGW) {
        const int m2 = m + NGW; const bool has2 = m2 < MT; const int mb = has2 ? m2 : m;
        const u32x4 a0 = *((const u32x4*)(XN + (size_t)m * DM) + lane), a1 = *((const u32x4*)(XN + (size_t)m * DM) + 64 + lane);
        const u32x4 b0 = *((const u32x4*)(XN + (size_t)mb * DM) + lane), b1 = *((const u32x4*)(XN + (size_t)mb * DM) + 64 + lane);
        f32x4 v[4] = {{bflo(a0.x), bfhi(a0.x), bflo(a0.y), bfhi(a0.y)}, {bflo(a0.z), bfhi(a0.z), bflo(a0.w), bfhi(a0.w)}, {bflo(a1.x), bfhi(a1.x), bflo(a1.y), bfhi(a1.y)}, {bflo(a1.z), bfhi(a1.z), bflo(a1.w), bfhi(a1.w)}};
        f32x4 w[4] = {{bflo(b0.x), bfhi(b0.x), bflo(b0.y), bfhi(b0.y)}, {bflo(b0.z), bfhi(b0.z), bflo(b0.w), bfhi(b0.w)}, {bflo(b1.x), bfhi(b1.x), bflo(b1.y), bfhi(b1.y)}, {bflo(b1.z), bfhi(b1.z), bflo(b1.w), bfhi(b1.w)}};
        float s = 0.f, s2 = 0.f;
#pragma unroll
        for (int j = 0; j < 4; ++j) { s += (v[j].x * v[j].x + v[j].y * v[j].y) + (v[j].z * v[j].z + v[j].w * v[j].w); s2 += (w[j].x * w[j].x + w[j].y * w[j].y) + (w[j].z * w[j].z + w[j].w * w[j].w); }
        const float r = rsqrtf(wave_sum(s) * (1.f / DM) + EPS), r2 = rsqrtf(wave_sum(s2) * (1.f / DM) + EPS);
        f32x4* y = (f32x4*)(a.out + (size_t)m * DM); f32x4* y2 = (f32x4*)(a.out + (size_t)mb * DM);
#pragma unroll
        for (int j = 0; j < 4; ++j) { const int q = 2 * lane + (j & 1) + 128 * (j >> 1); y[q] = v[j] * r * gg[j]; if (has2) y2[q] = w[j] * r2 * gg[j]; }
    }
}
#define XB_TMO      128
#define XB_XCNT(j)  (256  + 64 * (j))
#define XB_XSUB(j)  (1280 + 64 * (j))
#define XB_XGEN(j)  (2304 + 64 * (j))
#define XB_TOP      3328
#define XB_TOPGEN   3392
#define XCD_BAR_WORDS 3456
#define XB_SPIN_CAP (1u << 18)

__device__ __forceinline__ unsigned xb_ld(unsigned* p)              { return __hip_atomic_load(p, __ATOMIC_RELAXED, __HIP_MEMORY_SCOPE_AGENT); }
__device__ __forceinline__ unsigned xb_add(unsigned* p, unsigned v) { return __hip_atomic_fetch_add(p, v, __ATOMIC_RELAXED, __HIP_MEMORY_SCOPE_AGENT); }
__device__ __forceinline__ unsigned xb_xcc_id() { return (unsigned)__builtin_amdgcn_s_getreg((3 << 11) | 20) & 0xFu; }
#define XB_SPIN(cond, bar) do { unsigned _sp = 0; while (cond) { __builtin_amdgcn_s_sleep(1); \
    if ((++_sp & 255u) == 0u) { if (xb_ld(&(bar)[XB_TMO])) break; if (_sp > XB_SPIN_CAP) { atomicAdd(&(bar)[XB_TMO], 1u); break; } } } } while (0)

struct XcdBarrier {
    unsigned* bar; unsigned x;
    volatile LAS unsigned* st;
};

__device__ __forceinline__ XcdBarrier xcd_barrier_post(unsigned* bar, volatile LAS unsigned* st) {
    XcdBarrier b; b.bar = bar; b.x = xb_xcc_id(); b.st = st;
    if (threadIdx.x == 0) (void)xb_add(&bar[XB_XCNT(b.x)], 1u);
    return b;
}
__device__ __forceinline__ void xcd_barrier_complete(unsigned* bar, unsigned x, unsigned& nloc, unsigned& nx) {
    const unsigned G = gridDim.x * gridDim.y * gridDim.z;
    unsigned sum, cnt, mine, sp = 0u;
    for (;;) {
        sum = 0u; cnt = 0u; mine = 0u;
#pragma unroll
        for (unsigned j = 0; j < 16; ++j) { const unsigned c = xb_ld(&bar[XB_XCNT(j)]); sum += c; cnt += (c > 0u) ? 1u : 0u; mine = (j == x) ? c : mine; }
        if (sum == G) break;
        __builtin_amdgcn_s_sleep(1);
        if ((++sp & 255u) == 0u) { if (xb_ld(&bar[XB_TMO])) break; if (sp > XB_SPIN_CAP) { atomicAdd(&bar[XB_TMO], 1u); break; } }
    }
    nloc = mine > 0u ? mine : 1u; nx = cnt > 0u ? cnt : 1u;
}

__device__ __forceinline__ void xcd_barrier(const XcdBarrier& b) {
    asm volatile("s_waitcnt vmcnt(0)" ::: "memory");
    __syncthreads();
    if (threadIdx.x == 0) {
        unsigned* bar = b.bar;
        __builtin_amdgcn_s_waitcnt(0);
        unsigned nloc = b.st[0], nx = b.st[1];
        if (nloc == 0u) { xcd_barrier_complete(bar, b.x, nloc, nx); b.st[0] = nloc; b.st[1] = nx; }
        const unsigned old = xb_add(&bar[XB_XSUB(b.x)], 1u);
        const unsigned gen = old / nloc;
        if (old + 1u == (gen + 1u) * nloc) {
            __builtin_amdgcn_fence(__ATOMIC_RELEASE, "agent");
            asm volatile("s_waitcnt vmcnt(0)" ::: "memory");
            const unsigned og = xb_add(&bar[XB_TOP], 1u);
            const unsigned tg = og / nx;
            if (og + 1u == (tg + 1u) * nx) xb_add(&bar[XB_TOPGEN], 1u);
            else XB_SPIN(xb_ld(&bar[XB_TOPGEN]) == tg, bar);
            __builtin_amdgcn_fence(__ATOMIC_ACQUIRE, "agent");
            xb_add(&bar[XB_XGEN(b.x)], 1u);
            asm volatile("s_waitcnt vmcnt(0)" ::: "memory");
        } else {
            XB_SPIN(xb_ld(&bar[XB_XGEN(b.x)]) == gen, bar);
            __builtin_amdgcn_fence(__ATOMIC_ACQUIRE, "agent");
            asm volatile("s_waitcnt vmcnt(0)" ::: "memory");
        }
    }
    __syncthreads();
}

constexpr int NPH = 13;
__global__ void __launch_bounds__(512, 2) fwd_mega(Args args) {
    extern __shared__ __attribute__((aligned(16))) unsigned char lds_raw[];
    LAS unsigned char* lds = (LAS unsigned char*)lds_raw;
    cg::grid_group grid = cg::this_grid();
    const int tid = threadIdx.x, lane = tid & 63, wave = __builtin_amdgcn_readfirstlane(tid >> 6), G = gridDim.x, bx = blockIdx.x;
    unsigned char* ws = args.ws;
    const int lo = args.ph_lo, hi = args.ph_hi;
#define IN(k) (lo <= (k) && (k) < hi)
    volatile LAS unsigned* barst = (volatile LAS unsigned*)(lds + LDS_BARST);
    if (tid < 2) barst[tid] = 0u;
    __syncthreads();
    XcdBarrier xbar; xbar.bar = (unsigned*)(ws + WS_BAR); xbar.x = 0; xbar.st = barst;
    if (lo < 0) grid.sync();
    if (hi - lo > 1) xbar = xcd_barrier_post((unsigned*)(ws + WS_BAR), barst);
#define SEAM(k) do { if (IN(k) && IN((k) + 1)) xcd_barrier(xbar); } while (0)
    bf16_t* XN = (bf16_t*)(ws + WS_XN);
    if (IN(0)) { REPS(0) p0_prologue(args, lds, wave, lane, G); }
    SEAM(0);
    if (IN(1)) REPS(1) {
        { pg8::Gemm g{XN, (const bf16_t*)(ws + WS_WIN), MPAD, 3584, 1024}; pg8::StaticOrder S; S.init(MPAD, 3584, G, bx);
          EpiIn E{(bf16_t*)(ws + WS_QB), (bf16_t*)(ws + WS_KB), (bf16_t*)(ws + WS_VB), (bf16_t*)(ws + WS_QH), (bf16_t*)(ws + WS_VH), (bf16_t*)(ws + WS_GH), (bf16_t*)(ws + WS_VT),
                  (float*)(ws + WS_LF), (const float*)(ws + WS_LB), args.out};
          pg8::gemm_phase<EpiIn, pg8::StaticOrder, true, true>(lds, g, S, E); }
        { pg8::Gemm g{(const bf16_t*)(ws + WS_MN), (const bf16_t*)(ws + WS_WCKV), 1024, 1024, 1024}; pg8::StaticOrder S; S.init(1024, 1024, G, G - 1 - bx);
          EpiMem E{(bf16_t*)(ws + WS_MKB), (bf16_t*)(ws + WS_MVB), args.out};
          pg8::gemm_phase<EpiMem, pg8::StaticOrder, true, true>(lds, g, S, E); }
        if (MK_N_LAUNCHES == 1 && bx >= 142) {
            __syncthreads();
            LAS float* scr = (LAS float*)(lds + wave * 16384);
            for (int it = W_ITEMS_EARLY + (bx - 142) * 8 + wave; it < W_ITEMS; it += (G - 142) * 8) weight_item(args, scr, it, lane);
            __syncthreads();
        }
    }
    SEAM(1);
    if (IN(2)) {
        for (int ch = bx; ch < 1024; ch += G) hgrn_step1(args, lds, ch, tid);
        __syncthreads();
        LAS unsigned char* wl = lds + wave * 8192;
        {
            const int x = bx & 7, lw = (bx >> 3) * 8 + wave;
            if (tid < 8) ((LAS unsigned*)(lds + 65536) + 1024)[tid] = 0u;
            __syncthreads();
            const bool sfirst = wave < 4;
#pragma unroll 1
            for (int kk = 0; kk < 3; ++kk) { const int job = sfirst ? kk - 1 : kk;
                if (job >= 0 && job < 2) dil_attn_unit(args, wl, ((((job * 2 + (lw >> 7)) * 8 + x) << 7) | (lw & 127)), lane);
                else sample_attn_unit<0, 2, false>(args, wl, (LAS float*)(lds + 65536), bx * 4 + (wave >> 1), wave >> 1, wave & 1, lane); }
        }
    }
    SEAM(2);
    if (IN(3)) { REPS(3) hgrn_scan(args, G); }
    SEAM(3);
    if (IN(4)) REPS(4) {
#pragma unroll 1
        for (int u = bx * 8 + wave; u < 4096; u += G * 8) { const int I = u < 2048 ? 3 - (u & 3) : (u & 3), ch = u >> 2;
            if (I == 0) hgrn_step3<0>(args, ch, lane); else if (I == 1) hgrn_step3<1>(args, ch, lane); else if (I == 2) hgrn_step3<2>(args, ch, lane); else hgrn_step3<3>(args, ch, lane); }
        __syncthreads();
        for (int u = G - 1 - bx; u < 128; u += G) hgrn_sample(args, lds, u, tid);
    }
    SEAM(4);
    if (IN(5)) {
        pg8::Gemm g{(const bf16_t*)(ws + WS_MIX), (const bf16_t*)(ws + WS_WOUT), MP, 1024, 1024}; pg8::StaticOrder S; S.init(MP, 1024, G, bx);
        EpiRes<0> E{args.in[0], args.out, XN, (unsigned long long*)(ws + WS_SS1)};
        pg8::gemm_phase<EpiRes<0>, pg8::StaticOrder, true, true>(lds, g, S, E);
        mini_gemm_res<0>(lds, (const bf16_t*)(ws + WS_MIX), (const bf16_t*)(ws + WS_WOUT), 1024, args.in[1], args.out, XN, (unsigned long long*)(ws + WS_SS1), tid);
    }
    SEAM(5);
    if (IN(6)) REPS(6) {
        pg8::Gemm g{XN, (const bf16_t*)(ws + WS_WCQ), MPAD, 512, 1024}; pg8::StaticOrder S; S.init(MPAD, 512, G, bx);
        EpiRS<0> E{(const unsigned long long*)(ws + WS_SS1), (bf16_t*)(ws + WS_CQ), nullptr, args.out, CQSCALE};
        pg8::gemm_phase<EpiRS<0>, pg8::StaticOrder, true, true>(lds, g, S, E);
    }
    SEAM(6);
    if (IN(7)) {
        REPS(7) for (int u = bx; u < 256; u += G) cross_unit(args, lds, u, tid);
        __syncthreads();
        LAS unsigned char* wl = lds + wave * 4096;
        sample_attn_unit<1, 4>(args, wl, (LAS float*)(lds + 65536), bx * 2 + (wave >> 2), wave >> 2, wave & 3, lane);
    }
    SEAM(7);
    if (IN(8)) {
        pg8::Gemm g{(const bf16_t*)(ws + WS_CO), (const bf16_t*)(ws + WS_WCO), MP, 1024, 512}; pg8::StaticOrder S; S.init(MP, 1024, G, bx);
        EpiRes<1> E{nullptr, args.out, XN, (unsigned long long*)(ws + WS_SS2)};
        pg8::gemm_phase<EpiRes<1>, pg8::StaticOrder, true, true>(lds, g, S, E);
        mini_gemm_res<1>(lds, (const bf16_t*)(ws + WS_CO), (const bf16_t*)(ws + WS_WCO), 512, nullptr, args.out, XN, (unsigned long long*)(ws + WS_SS2), tid);
    }
    SEAM(8);
    if (IN(9)) REPS(9) {
        pg8::Gemm g{XN, (const bf16_t*)(ws + WS_WGU), MPAD, 2 * DFF, 1024}; pg8::StaticOrder S; S.init(MPAD, 2 * DFF, G, bx);
        EpiGU E{(const unsigned long long*)(ws + WS_SS2), (bf16_t*)(ws + WS_ACT), args.in[5], (float*)(ws + WS_EDGE), (float*)(ws + WS_PART), (float*)(ws + WS_UPV),
                args.in[24], args.in[25], args.out, lds + 131072};
        pg8::gemm_phase<EpiGU, pg8::StaticOrder, true, true>(lds, g, S, E);
    }
    SEAM(9);
    if (IN(11)) {
        { const int wg = (bx & 7) * 32 + (bx >> 3), pm0 = (wg >> 5) * 8 + (wg & 7);
          ffn_fixup_local(args, pm0, tid); }
        pg8::Gemm g{(const bf16_t*)(ws + WS_ACT), (const bf16_t*)(ws + WS_WD), MP, 1024, DFF}; pg8::StaticOrder S; S.init(MP, 1024, G, bx);
        EpiFinal E{XN, (unsigned long long*)(ws + WS_SS3), (unsigned*)(ws + WS_CNT), args.in[27], args.out};
        pg8::gemm_phase<EpiFinal, pg8::StaticOrder, true, true>(lds, g, S, E);
        mini_gemm_res<2>(lds, (const bf16_t*)(ws + WS_ACT), (const bf16_t*)(ws + WS_WD), DFF, nullptr, args.out, XN, (unsigned long long*)(ws + WS_SS3), tid, (unsigned*)(ws + WS_CNT), args.in[27]);
    }
#undef IN
#undef SEAM
}

extern "C" void kernel_launch(void* const* d_in, const int* in_sizes, int n_in, void* d_out, int out_size, void* d_ws, size_t ws_size, hipStream_t stream) {
    static int grid = 0;
    if (grid == 0) {
        int dev = 0, cus = 0, per_cu = 0;
        (void)hipGetDevice(&dev); (void)hipDeviceGetAttribute(&cus, hipDeviceAttributeMultiprocessorCount, dev);
        if (hipFuncSetAttribute((const void*)fwd_mega, hipFuncAttributeMaxDynamicSharedMemorySize, LDS_BYTES) != hipSuccess) fprintf(stderr, "hipFuncSetAttribute failed\n");
        (void)hipOccupancyMaxActiveBlocksPerMultiprocessor(&per_cu, (const void*)fwd_mega, 512, LDS_BYTES);
        (void)hipGetLastError();
        grid = 256;
        if (cus < 256) fprintf(stderr, "kernel_launch: device reports %d CUs, this kernel needs 256\n", cus);
        if (n_in != 28 || ws_size < 384 * MiB) { fprintf(stderr, "kernel_launch: unexpected inputs (n_in %d, ws %zu)\n", n_in, ws_size); }
    }
    Args a{};
    for (int i = 0; i < 28; ++i) a.in[i] = (const float*)d_in[i];
    a.out = (float*)d_out; a.ws = (unsigned char*)d_ws;
#if MK_N_LAUNCHES == 1
    a.ph_lo = 0; a.ph_hi = NPH;
    (void)hipMemsetAsync((unsigned char*)d_ws + WS_BAR, 0, 3456 * 4, stream);
    void* kargs[] = {&a};
    hipError_t e = hipLaunchCooperativeKernel((const void*)fwd_mega, dim3(grid), dim3(512), kargs, LDS_BYTES, stream);
    if (e != hipSuccess) fprintf(stderr, "cooperative launch failed: %s (grid %d)\n", hipGetErrorString(e), grid);
#else
    for (int p = 0; p < NPH; ++p) { a.ph_lo = p; a.ph_hi = p + 1; hipLaunchKernelGGL(fwd_mega, dim3(grid), dim3(512), LDS_BYTES, stream, a); }
#endif
}
```

```cpp
#include <hip/hip_runtime.h>
#include <hip/hip_cooperative_groups.h>
#include <cstdio>
#include <cstdint>
namespace cg = cooperative_groups;
#ifndef MK_N_LAUNCHES
#define MK_N_LAUNCHES 1
#endif
#ifndef REP_MASK
#define REP_MASK 0
#endif
#define REPS(k) for (int rep_ = 0; rep_ < 1 + ((REP_MASK >> (k)) & 1); ++rep_)
namespace pg8 {
#define PG8_LAS __attribute__((address_space(3)))
typedef unsigned short bf16_t;
typedef short bf16x8 __attribute__((ext_vector_type(8)));
typedef float f32x4 __attribute__((ext_vector_type(4)));
typedef unsigned u32x4 __attribute__((ext_vector_type(4)));
constexpr int BM = 256, BK = 64, HALF = 128, HTB = HALF * BK * 2  , STAGE_BYTES = 8 * HTB, NXCD = 8, WGM = 8;

__host__ __device__ __forceinline__ int lds_byte(int r, int c) { const int st = (r >> 4) * 2 + (c >> 5), rr = r & 15, cc = c & 31, ob = rr * 64 + cc * 2; return st * 1024 + (ob ^ (((ob >> 9) & 1) << 5)); }
__host__ __device__ __forceinline__ void stage_rc(int b, int& R, int& C) { const int st = b / 1024, sb = b % 1024, swz = sb ^ (((sb >> 9) & 1) << 5); R = (st >> 1) * 16 + swz / 64; C = (st & 1) * 32 + (swz % 64) / 2; }
__host__ __device__ __forceinline__ int perm32(int rho) { const int n = rho >> 4, i = rho & 15; return 8 * (i >> 2) + 4 * n + (i & 3); }

struct Unit { int pm, pn; };
struct Gemm { const bf16_t* A; const bf16_t* Bt; int M, N, K; };

struct StaticOrder {
    int nM, nN, nwg, G, c;
    __host__ __device__ void init(int M, int N, int G_, int c_) { nM = M / BM; nN = N / BM; nwg = nM * nN; G = G_; c = c_; }
    __host__ __device__ bool next(int i, Unit& u) const {
        const long L = (long)i * G + c; if (L >= nwg) return false;
        int wgid = (int)L; { const int q = nwg / NXCD, r = nwg % NXCD, xcd = wgid % NXCD, off = wgid / NXCD; wgid = (xcd < r ? xcd * (q + 1) : r * (q + 1) + (xcd - r) * q) + off; }
        const int nig = WGM * nN, gid = wgid / nig, fm = gid * WGM, gsz = (nM - fm) < WGM ? (nM - fm) : WGM;
        u.pm = fm + ((wgid % nig) % gsz); u.pn = (wgid % nig) / gsz; return true;
    }
    __device__ __forceinline__ void a_ready(const Unit&) const {}
    __device__ __forceinline__ void done(const Unit&) const {}
};


template <class Epi, class Sched, bool ALIGN_EPI = false, bool SP2 = false>
__device__ __forceinline__ void gemm_phase(PG8_LAS unsigned char* lds, const Gemm g, const Sched& S, const Epi& E) {
    const int tid = threadIdx.x, wid = __builtin_amdgcn_readfirstlane(tid >> 6), lane = tid & 63, wr = wid >> 2, wc = wid & 3, fr = lane & 15, fq = lane >> 4;
    const int K = g.K, nt = K / BK;
    unsigned voffA[2], voffB[2];
#pragma unroll
    for (int i = 0; i < 2; ++i) { int R, C; stage_rc(tid * 16 + i * 8192, R, C); const int Rb = Epi::PERM ? ((R & ~31) + perm32(R & 31)) : R;
        voffA[i] = (unsigned)(R * K + C) * 2u; voffB[i] = (unsigned)(Rb * K + C) * 2u; }
    const size_t kstep = (size_t)(BK * 2);
    const size_t hstep = (size_t)HALF * K * 2;
    const size_t tstep = 2 * hstep;
    const unsigned ldsw = (unsigned)wid * 1024u;
    const int aoff = lds_byte(wr * 64 + fr, fq * 8), boff = lds_byte(wc * 32 + fr, fq * 8);
#define PG8_SA(b, h) (((b) * 2 + (h)) * HTB)
#define PG8_SB(b, h) ((4 + (b) * 2 + (h)) * HTB)
#define PG8_STAGE(bufoff, gbase, voff) do { _Pragma("unroll") for (int _i = 0; _i < 2; ++_i) \
        __builtin_amdgcn_global_load_lds((const unsigned*)((const char*)(gbase) + (voff)[_i]), (PG8_LAS unsigned*)(lds + (bufoff) + ldsw + _i * 8192), 16, 0, 0); } while (0)
#define PG8_LDA(dst, b, h) do { _Pragma("unroll") for (int m = 0; m < 4; ++m) _Pragma("unroll") for (int k = 0; k < 2; ++k) dst[m][k] = *(const PG8_LAS bf16x8*)(lds + PG8_SA(b, h) + aoff + m * 2048 + k * 1024); } while (0)
#define PG8_LDB(dst, b, h) do { _Pragma("unroll") for (int n = 0; n < 2; ++n) _Pragma("unroll") for (int k = 0; k < 2; ++k) dst[n][k] = *(const PG8_LAS bf16x8*)(lds + PG8_SB(b, h) + boff + n * 2048 + k * 1024); } while (0)
#define PG8_MMA(ai, bj, At, Bt) do { __builtin_amdgcn_s_setprio(1); _Pragma("unroll") for (int m = 0; m < 4; ++m) _Pragma("unroll") for (int n = 0; n < 2; ++n) _Pragma("unroll") for (int k = 0; k < 2; ++k) \
        acc[ai][bj][m][n] = __builtin_amdgcn_mfma_f32_16x16x32_bf16(Bt[n][k], At[m][k], acc[ai][bj][m][n], 0, 0, 0); __builtin_amdgcn_s_setprio(0); } while (0)
#define PG8_WAIT_V(n) asm volatile("s_waitcnt vmcnt(" #n ")" ::: "memory")
#define PG8_WAIT_L(n) asm volatile("s_waitcnt lgkmcnt(" #n ")" ::: "memory")
#define PG8_BAR __builtin_amdgcn_s_barrier()
#define PG8_SCHED __builtin_amdgcn_sched_barrier(0)
    Unit cur, nxt; int ui = 0;
    if (!S.next(0, cur)) return;
    f32x4 acc[2][2][4][2];
#pragma unroll
    for (int a = 0; a < 2; ++a)
#pragma unroll
        for (int b = 0; b < 2; ++b)
#pragma unroll
            for (int m = 0; m < 4; ++m)
#pragma unroll
                for (int n = 0; n < 2; ++n) acc[a][b][m][n] = (f32x4){0.f, 0.f, 0.f, 0.f};
    bf16x8 At[4][2], B0[2][2], B1[2][2];
    const char* cA = (const char*)g.A + (size_t)cur.pm * tstep; const char* cB = (const char*)g.Bt + (size_t)cur.pn * tstep;
    S.a_ready(cur);
    if constexpr (SP2) {
        PG8_STAGE(PG8_SB(0, 0), cB, voffB); PG8_STAGE(PG8_SB(0, 1), cB + hstep, voffB); PG8_STAGE(PG8_SA(0, 0), cA, voffA); PG8_STAGE(PG8_SA(0, 1), cA + hstep, voffA);
        if (wr == 1) PG8_BAR;
        PG8_WAIT_V(2); PG8_BAR;
        PG8_STAGE(PG8_SB(1, 0), cB + kstep, voffB); PG8_STAGE(PG8_SA(1, 0), cA + kstep, voffA); PG8_STAGE(PG8_SB(1, 1), cB + hstep + kstep, voffB);
        PG8_WAIT_V(6); PG8_BAR;
    } else {
        PG8_STAGE(PG8_SB(0, 0), cB, voffB); PG8_STAGE(PG8_SA(0, 0), cA, voffA); PG8_STAGE(PG8_SB(0, 1), cB + hstep, voffB); PG8_STAGE(PG8_SA(0, 1), cA + hstep, voffA);
        if (wr == 1) PG8_BAR;
        PG8_WAIT_V(4); PG8_BAR;
        PG8_STAGE(PG8_SB(1, 0), cB + kstep, voffB); PG8_STAGE(PG8_SA(1, 0), cA + kstep, voffA); PG8_STAGE(PG8_SB(1, 1), cB + hstep + kstep, voffB);
        PG8_WAIT_V(6); PG8_BAR;
    }
    for (;;) {
        const bool has_next = S.next(ui + 1, nxt);
        const char* nA = has_next ? (const char*)g.A + (size_t)nxt.pm * tstep : cA; const char* nB = has_next ? (const char*)g.Bt + (size_t)nxt.pn * tstep : cB;
        for (int t = 0; t < nt; t += 2) {
            const bool last = (t == nt - 2);
            const char* a1 = cA + (size_t)(t + 1) * kstep;
            const char* a2 = last ? nA : cA + (size_t)(t + 2) * kstep; const char* b2 = last ? nB : cB + (size_t)(t + 2) * kstep;
            const char* a3 = a2 + kstep; const char* b3 = b2 + kstep;
            if (last && has_next) S.a_ready(nxt);
            if constexpr (SP2) {
            PG8_LDB(B0, 0, 0); PG8_LDB(B1, 0, 1); PG8_SCHED; PG8_LDA(At, 0, 0); PG8_STAGE(PG8_SA(1, 1), a1 + hstep, voffA);
            PG8_WAIT_V(8); PG8_WAIT_L(0); PG8_BAR; PG8_MMA(0, 0, At, B0); PG8_MMA(0, 1, At, B1); PG8_BAR; PG8_SCHED;
            PG8_LDA(At, 0, 1); PG8_STAGE(PG8_SB(0, 0), b2, voffB); PG8_STAGE(PG8_SB(0, 1), b2 + hstep, voffB); PG8_STAGE(PG8_SA(0, 0), a2, voffA);
            PG8_WAIT_V(8); PG8_WAIT_L(0); PG8_BAR; PG8_MMA(1, 0, At, B0); PG8_MMA(1, 1, At, B1); PG8_BAR; PG8_SCHED;
            PG8_LDB(B0, 1, 0); PG8_LDB(B1, 1, 1); PG8_SCHED; PG8_LDA(At, 1, 0); PG8_STAGE(PG8_SA(0, 1), a2 + hstep, voffA);
            PG8_WAIT_V(8); PG8_WAIT_L(0); PG8_BAR; PG8_MMA(0, 0, At, B0); PG8_MMA(0, 1, At, B1); PG8_BAR; PG8_SCHED;
            PG8_LDA(At, 1, 1); PG8_STAGE(PG8_SB(1, 0), b3, voffB); PG8_STAGE(PG8_SB(1, 1), b3 + hstep, voffB); PG8_STAGE(PG8_SA(1, 0), a3, voffA);
            PG8_WAIT_V(8); PG8_WAIT_L(0); PG8_BAR; PG8_MMA(1, 0, At, B0); PG8_MMA(1, 1, At, B1); PG8_BAR; PG8_SCHED;
            } else {
            PG8_LDB(B0, 0, 0); PG8_SCHED; PG8_LDA(At, 0, 0); PG8_STAGE(PG8_SA(1, 1), a1 + hstep, voffA);
            PG8_WAIT_L(8); PG8_BAR; PG8_WAIT_L(0); PG8_MMA(0, 0, At, B0); PG8_BAR; PG8_SCHED;
            PG8_LDB(B1, 0, 1); PG8_STAGE(PG8_SB(0, 0), b2, voffB);
            PG8_BAR; PG8_WAIT_L(0); PG8_MMA(0, 1, At, B1); PG8_BAR;
            PG8_LDA(At, 0, 1); PG8_STAGE(PG8_SA(0, 0), a2, voffA);
            PG8_BAR; PG8_WAIT_L(0); PG8_MMA(1, 0, At, B0); PG8_BAR; PG8_SCHED;
            PG8_STAGE(PG8_SB(0, 1), b2 + hstep, voffB);
            PG8_WAIT_V(6); PG8_BAR; PG8_MMA(1, 1, At, B1); PG8_BAR;
            PG8_LDB(B0, 1, 0); PG8_SCHED; PG8_LDA(At, 1, 0); PG8_STAGE(PG8_SA(0, 1), a2 + hstep, voffA);
            PG8_WAIT_L(8); PG8_BAR; PG8_WAIT_L(0); PG8_MMA(0, 0, At, B0); PG8_BAR; PG8_SCHED;
            PG8_LDB(B1, 1, 1); PG8_STAGE(PG8_SB(1, 0), b3, voffB);
            PG8_BAR; PG8_WAIT_L(0); PG8_MMA(0, 1, At, B1); PG8_BAR;
            PG8_LDA(At, 1, 1); PG8_STAGE(PG8_SA(1, 0), a3, voffA);
            PG8_BAR; PG8_WAIT_L(0); PG8_MMA(1, 0, At, B0); PG8_BAR; PG8_SCHED;
            PG8_STAGE(PG8_SB(1, 1), b3 + hstep, voffB);
            PG8_WAIT_V(6); PG8_BAR; PG8_MMA(1, 1, At, B1); PG8_BAR;
            }
        }
        if constexpr (ALIGN_EPI) { if (wr == 0) PG8_BAR; }
        if constexpr (!Epi::AFTER_DRAIN) { E(acc, cur, wr, wc, fr, fq); S.done(cur); }
        if (!has_next) break;
#pragma unroll
        for (int a = 0; a < 2; ++a)
#pragma unroll
            for (int b = 0; b < 2; ++b)
#pragma unroll
                for (int m = 0; m < 4; ++m)
#pragma unroll
                    for (int n = 0; n < 2; ++n) acc[a][b][m][n] = (f32x4){0.f, 0.f, 0.f, 0.f};
        cur = nxt; cA = nA; cB = nB; ++ui;
        if constexpr (ALIGN_EPI) { if (wr == 1) PG8_BAR; }
    }
    PG8_WAIT_V(0);
    if constexpr (!ALIGN_EPI) { if (wr == 0) PG8_BAR; }
    PG8_BAR;
    if constexpr (Epi::AFTER_DRAIN) { E.fused(acc, cur, wr, wc, fr, fq, lds, wid, lane); S.done(cur); }
#undef PG8_SA
#undef PG8_SB
#undef PG8_STAGE
#undef PG8_LDA
#undef PG8_LDB
#undef PG8_MMA
#undef PG8_WAIT_V
#undef PG8_WAIT_L
#undef PG8_BAR
#undef PG8_SCHED
}
}
using pg8::bf16_t; using pg8::bf16x8; using pg8::f32x4; using pg8::u32x4; using pg8::Unit;
typedef short s16x4 __attribute__((ext_vector_type(4)));
typedef unsigned u32x2 __attribute__((ext_vector_type(2)));
#define LAS __attribute__((address_space(3)))
constexpr int MP = 16384, MSAMP = 128, MT = MP + MSAMP, MPAD = 16640, DM = 1024, SEQ = 4096, DFF = 2816;
constexpr float EPS = 1e-6f, LOG2E = 1.4426950408889634f;
constexpr float QSCALE = 0.125f * LOG2E;
constexpr float CQSCALE = 0.08838834764831845f * LOG2E;
constexpr float HQSCALE = 0.08838834764831845f;
constexpr size_t O_Y = 0, O_WKP = 16908288, O_WVP = 21102592, O_HSP = 25296896, O_FCP = 25559040, O_MKP = 25581568, O_MVP = 26105856,
                 O_WKS = 26630144, O_WVS = 26695680, O_HSS = 26761216, O_FCS = 28858368;
constexpr size_t MiB = 1u << 20;
constexpr size_t WS_WIN = 0, WS_WOUT = 7 * MiB, WS_WCQ = 9 * MiB, WS_WCKV = 10 * MiB, WS_WCO = 12 * MiB, WS_WGU = 13 * MiB, WS_WD = 24 * MiB,
                 WS_LB = 30 * MiB, WS_SS1 = WS_LB + 4096, WS_SS2 = WS_SS1 + 256 * 1024, WS_XN = 32 * MiB, WS_CQ = 65 * MiB, WS_CO = 82 * MiB,
                 WS_MKB = 99 * MiB, WS_MVB = 100 * MiB, WS_MN = 101 * MiB,
                 WS_QB = 104 * MiB, WS_KB = 121 * MiB, WS_VB = 138 * MiB, WS_QH = 155 * MiB, WS_VH = 172 * MiB, WS_GH = 189 * MiB, WS_LF = 206 * MiB,
                 WS_VT = 239 * MiB, WS_KV = 255 * MiB, WS_SP = 319 * MiB, WS_MIX = 351 * MiB,
                 WS_UG = 104 * MiB, WS_UP = 194 * MiB, WS_ACT = 284 * MiB;
constexpr size_t WS_SS3 = 30 * MiB + 600 * 1024, WS_CNT = 30 * MiB + 800 * 1024, WS_BAR = 31 * MiB, WS_EDGE = 375 * MiB, WS_PART = 377 * MiB, WS_UPV = 379 * MiB, WS_UGS = 381 * MiB, WS_UPS = 382 * MiB;
constexpr int LDS_BYTES = 147456, LDS_BARST = 147456 - 64;

struct Args { const float* in[28]; float* out; unsigned char* ws; int ph_lo, ph_hi; };

typedef float f32x2_t __attribute__((ext_vector_type(2))); typedef __bf16 bf16x2_t __attribute__((ext_vector_type(2)));
__device__ __forceinline__ unsigned pk2(float lo, float hi) { unsigned r; asm volatile("v_cvt_pk_bf16_f32 %0, %1, %2" : "=v"(r) : "v"(lo), "v"(hi)); return r; }
__device__ __forceinline__ unsigned pk2m(float lo, float hi) { const f32x2_t v = {lo, hi}; const bf16x2_t b = __builtin_convertvector(v, bf16x2_t); return __builtin_bit_cast(unsigned, b); }
__device__ __forceinline__ float bflo(unsigned w) { return __uint_as_float(w << 16); }
__device__ __forceinline__ float bfhi(unsigned w) { return __uint_as_float(w & 0xffff0000u); }
__device__ __forceinline__ float bf1(bf16_t h) { return __uint_as_float((unsigned)h << 16); }
__device__ __forceinline__ void store_bf16x8(bf16_t* p, f32x4 a, f32x4 b) { u32x4 w; w.x = pk2(a[0], a[1]); w.y = pk2(a[2], a[3]); w.z = pk2(b[0], b[1]); w.w = pk2(b[2], b[3]); *(u32x4*)p = w; }
__device__ __forceinline__ float wave_sum(float v) {
#pragma unroll
    for (int o = 1; o < 64; o <<= 1) v += __shfl_xor(v, o);
    return v;
}
__device__ __forceinline__ float wave_max(float v) {
#pragma unroll
    for (int o = 1; o < 64; o <<= 1) v = fmaxf(v, __shfl_xor(v, o));
    return v;
}
__device__ __forceinline__ float xg_max(float x) {
    auto s = __builtin_amdgcn_permlane16_swap(__float_as_uint(x), __float_as_uint(x), false, false); x = fmaxf(__uint_as_float(s[0]), __uint_as_float(s[1]));
    auto u = __builtin_amdgcn_permlane32_swap(__float_as_uint(x), __float_as_uint(x), false, false); return fmaxf(__uint_as_float(u[0]), __uint_as_float(u[1]));
}
__device__ __forceinline__ float xg_sum(float x) {
    auto s = __builtin_amdgcn_permlane16_swap(__float_as_uint(x), __float_as_uint(x), false, false); x = __uint_as_float(s[0]) + __uint_as_float(s[1]);
    auto u = __builtin_amdgcn_permlane32_swap(__float_as_uint(x), __float_as_uint(x), false, false); return __uint_as_float(u[0]) + __uint_as_float(u[1]);
}
__device__ __forceinline__ float silu_f(float x) { return x * __builtin_amdgcn_rcpf(1.f + __expf(-x)); }
__device__ __forceinline__ float ex2(float x) { return __builtin_amdgcn_exp2f(x); }

#define EPI_ROWS_BEGIN  _Pragma("unroll") for (int ai = 0; ai < 2; ++ai) _Pragma("unroll") for (int m = 0; m < 4; ++m) { const int row = u.pm * 256 + ai * 128 + wr * 64 + m * 16 + fr;
#define EPI_ROWS_END }

struct EpiIn {
    static constexpr bool PERM = true, AFTER_DRAIN = false;
    bf16_t *Qb, *Kb, *Vb, *QH, *VH, *GH, *VT; float* LF; const float* LB; float* out;
    __device__ __forceinline__ void operator()(const f32x4 (&acc)[2][2][4][2], const Unit& u, int wr, int wc, int fr, int fq) const {
        const int grp = u.pn >> 1;
        EPI_ROWS_BEGIN
            if (row >= MT) continue;
#pragma unroll
            for (int bj = 0; bj < 2; ++bj) {
                const int cc = (u.pn & 1) * 256 + bj * 128 + wc * 32 + 8 * fq;
                f32x4 v0 = acc[ai][bj][m][0], v1 = acc[ai][bj][m][1];
                const size_t o = (size_t)row * 512 + cc;
                if (grp == 0) { store_bf16x8(Qb + o, v0 * QSCALE, v1 * QSCALE); }
                else if (grp == 1 || grp == 2) {
                    store_bf16x8((grp == 1 ? Kb : Vb) + o, v0, v1);
                    float* dst = nullptr;
                    if (row >= MP) dst = out + (grp == 1 ? O_WKS : O_WVS) + (size_t)(row - MP) * 512 + cc;
                    else { const int t = row & 4095, b = row >> 12; if (t >= 2048) dst = out + (grp == 1 ? O_WKP : O_WVP) + (size_t)(b * 2048 + t - 2048) * 512 + cc; }
                    if (dst) { *(f32x4*)dst = v0; *(f32x4*)(dst + 4) = v1; }
                } else if (grp == 3) {
#pragma unroll
                    for (int j = 0; j < 4; ++j) { v0[j] = silu_f(v0[j]) * HQSCALE; v1[j] = silu_f(v1[j]) * HQSCALE; }
                    store_bf16x8(QH + o, v0, v1);
                } else if (grp == 4) {
                    const f32x4 l0 = *(const f32x4*)(LB + cc), l1 = *(const f32x4*)(LB + cc + 4);
#pragma unroll
                    for (int j = 0; j < 4; ++j) { v0[j] = __logf(l0[j] + (1.f - l0[j]) * __builtin_amdgcn_rcpf(1.f + __expf(-v0[j]))); v1[j] = __logf(l1[j] + (1.f - l1[j]) * __builtin_amdgcn_rcpf(1.f + __expf(-v1[j]))); }
                    *(f32x4*)(LF + o) = v0; *(f32x4*)(LF + o + 4) = v1;
                } else if (grp == 5) {
                    store_bf16x8(VH + o, v0, v1);
                    if (row < MP) { const int t = row & 4095, b = row >> 12; bf16_t* vt = VT + (size_t)(b * 512 + cc) * 4096 + t;
#pragma unroll
                        for (int j = 0; j < 4; ++j) { vt[(size_t)j * 4096] = (bf16_t)(pk2(v0[j], 0.f) & 0xffffu); vt[(size_t)(j + 4) * 4096] = (bf16_t)(pk2(v1[j], 0.f) & 0xffffu); } }
                } else { store_bf16x8(GH + o, v0, v1); }
            }
        EPI_ROWS_END
    }
};

struct EpiMem {
    static constexpr bool PERM = true, AFTER_DRAIN = false;
    bf16_t *MKB, *MVB; float* out;
    __device__ __forceinline__ void operator()(const f32x4 (&acc)[2][2][4][2], const Unit& u, int wr, int wc, int fr, int fq) const {
        const bool isv = u.pn >= 2;
        EPI_ROWS_BEGIN
#pragma unroll
            for (int bj = 0; bj < 2; ++bj) {
                const int cc = (u.pn & 1) * 256 + bj * 128 + wc * 32 + 8 * fq;
                const f32x4 v0 = acc[ai][bj][m][0], v1 = acc[ai][bj][m][1];
                const size_t o = (size_t)row * 512 + cc;
                store_bf16x8((isv ? MVB : MKB) + o, v0, v1);
                float* dst = out + (isv ? O_MVP : O_MKP) + o; *(f32x4*)dst = v0; *(f32x4*)(dst + 4) = v1;
            }
        EPI_ROWS_END
    }
};

template <int MODE> struct EpiRes {
    static constexpr bool PERM = true, AFTER_DRAIN = false;
    const float* xin; float* out; bf16_t* XN; unsigned long long* ss;
    __device__ __forceinline__ void operator()(const f32x4 (&acc)[2][2][4][2], const Unit& u, int wr, int wc, int fr, int fq) const {
        EPI_ROWS_BEGIN
            float sq = 0.f;
#pragma unroll
            for (int bj = 0; bj < 2; ++bj) {
                const int col = u.pn * 256 + bj * 128 + wc * 32 + 8 * fq;
                f32x4 v0 = acc[ai][bj][m][0], v1 = acc[ai][bj][m][1];
                const size_t o = (size_t)row * DM + col;
                if (MODE == 0) { v0 += *(const f32x4*)(xin + o); v1 += *(const f32x4*)(xin + o + 4); }
                else { const u32x4 w = *(const u32x4*)(XN + o); v0 += (f32x4){bflo(w.x), bfhi(w.x), bflo(w.y), bfhi(w.y)}; v1 += (f32x4){bflo(w.z), bfhi(w.z), bflo(w.w), bfhi(w.w)}; }
                if (MODE == 2) { store_bf16x8(XN + o, v0, v1); }
                else { store_bf16x8(XN + o, v0, v1);
                    sq += (v0[0] * v0[0] + v0[1] * v0[1]) + (v0[2] * v0[2] + v0[3] * v0[3]) + (v1[0] * v1[0] + v1[1] * v1[1]) + (v1[2] * v1[2] + v1[3] * v1[3]); }
            }
            if (MODE != 2) { sq = xg_sum(sq); if (fq == 0) atomicAdd(ss + row, (unsigned long long)(sq * 16777216.f)); }
        EPI_ROWS_END
    }
};
struct EpiFinal {
    static constexpr bool PERM = true, AFTER_DRAIN = false;
    const bf16_t* XN; unsigned long long* ss3; unsigned* cnt; const float* g; float* out;
    __device__ __forceinline__ void operator()(const f32x4 (&acc_)[2][2][4][2], const Unit& u, int wr, int wc, int fr, int fq) const {
        f32x4 (&x)[2][2][4][2] = const_cast<f32x4 (&)[2][2][4][2]>(acc_);
        EPI_ROWS_BEGIN
            float sq = 0.f;
#pragma unroll
            for (int bj = 0; bj < 2; ++bj) {
                const int col = u.pn * 256 + bj * 128 + wc * 32 + 8 * fq;
                const u32x4 w = *(const u32x4*)(XN + ((unsigned)row * (unsigned)DM + (unsigned)col));
                f32x4 v0 = x[ai][bj][m][0] + (f32x4){bflo(w.x), bfhi(w.x), bflo(w.y), bfhi(w.y)}, v1 = x[ai][bj][m][1] + (f32x4){bflo(w.z), bfhi(w.z), bflo(w.w), bfhi(w.w)};
                x[ai][bj][m][0] = v0; x[ai][bj][m][1] = v1;
                sq += (v0[0] * v0[0] + v0[1] * v0[1]) + (v0[2] * v0[2] + v0[3] * v0[3]) + (v1[0] * v1[0] + v1[1] * v1[1]) + (v1[2] * v1[2] + v1[3] * v1[3]);
            }
            sq = xg_sum(sq);
            if (fq == 0) (void)__hip_atomic_fetch_add(ss3 + row, (unsigned long long)(sq * 16777216.f), __ATOMIC_RELAXED, __HIP_MEMORY_SCOPE_AGENT);
        EPI_ROWS_END
        asm volatile("s_waitcnt vmcnt(0) lgkmcnt(0)" ::: "memory"); __builtin_amdgcn_s_barrier(); asm volatile("" ::: "memory");
        if (threadIdx.x == 0) {
            unsigned* c = cnt + 64 * u.pm;
            (void)__hip_atomic_fetch_add(c, 1u, __ATOMIC_RELAXED, __HIP_MEMORY_SCOPE_AGENT);
            unsigned spins = 0;
            while (__hip_atomic_load(c, __ATOMIC_RELAXED, __HIP_MEMORY_SCOPE_AGENT) < 4u && ++spins < (1u << 22)) __builtin_amdgcn_s_sleep(2);
        }
        asm volatile("s_waitcnt vmcnt(0) lgkmcnt(0)" ::: "memory"); __builtin_amdgcn_s_barrier(); asm volatile("" ::: "memory");
        EPI_ROWS_BEGIN
            const unsigned long long sv = __hip_atomic_load(ss3 + row, __ATOMIC_RELAXED, __HIP_MEMORY_SCOPE_AGENT);
            const float r = rsqrtf((float)sv * (1.f / (16777216.f * DM)) + EPS);
#pragma unroll
            for (int bj = 0; bj < 2; ++bj) {
                const int col = u.pn * 256 + bj * 128 + wc * 32 + 8 * fq;
                const f32x4 g0 = *(const f32x4*)(g + col), g1 = *(const f32x4*)(g + col + 4);
                float* op = out + ((unsigned)row * (unsigned)DM + (unsigned)col);
                *(f32x4*)op = x[ai][bj][m][0] * r * g0; *(f32x4*)(op + 4) = x[ai][bj][m][1] * r * g1;
            }
        EPI_ROWS_END
    }
};
template <int MODE> __device__ __forceinline__ void mini_gemm_res(LAS unsigned char* lds, const bf16_t* A, const bf16_t* Bt, int K, const float* xin_s, float* out, bf16_t* XN, unsigned long long* ss, int tid, unsigned* cnt = nullptr, const float* gfin = nullptr) {
    const int bx = blockIdx.x, rg = bx & 7, cgp = bx >> 3, wave = tid >> 6, lane = tid & 63, lr = lane & 15, lg = lane >> 4;
    const int kw = K >> 3, k0 = wave * kw;
    const bf16_t* ap = A + (size_t)(MP + 16 * rg + lr) * K + k0 + lg * 8;
    const bf16_t* bp0 = Bt + (size_t)(32 * cgp + lr) * K + k0 + lg * 8; const bf16_t* bp1 = bp0 + (size_t)16 * K;
    f32x4 a0 = {0.f, 0.f, 0.f, 0.f}, a1 = a0;
#pragma unroll 11
    for (int ks = 0; ks < kw; ks += 32) { const bf16x8 af = *(const bf16x8*)(ap + ks);
        a0 = __builtin_amdgcn_mfma_f32_16x16x32_bf16(af, *(const bf16x8*)(bp0 + ks), a0, 0, 0, 0);
        a1 = __builtin_amdgcn_mfma_f32_16x16x32_bf16(af, *(const bf16x8*)(bp1 + ks), a1, 0, 0, 0); }
    LAS float* red = (LAS float*)lds;
    __syncthreads();
#pragma unroll
    for (int j = 0; j < 4; ++j) { red[(wave * 16 + lg * 4 + j) * 32 + lr] = a0[j]; red[(wave * 16 + lg * 4 + j) * 32 + 16 + lr] = a1[j]; }
    __syncthreads();
    const int m = tid >> 5, n = tid & 31;
    float v = 0.f;
#pragma unroll
    for (int w = 0; w < 8; ++w) v += red[(w * 16 + m) * 32 + n];
    const int row = MP + 16 * rg + m, col = 32 * cgp + n; const size_t o = (size_t)row * DM + col;
    if (MODE == 0) v += xin_s[(size_t)(row - MP) * DM + col]; else v += bf1(XN[o]);
    if (MODE != 2) XN[o] = (bf16_t)(pk2(v, 0.f) & 0xffffu);
    float sq = v * v;
#pragma unroll
    for (int s = 1; s < 32; s <<= 1) sq += __shfl_xor(sq, s);
    if (n == 0) (void)__hip_atomic_fetch_add(ss + row, (unsigned long long)(sq * 16777216.f), __ATOMIC_RELAXED, __HIP_MEMORY_SCOPE_AGENT);
    if (MODE == 2) {
        asm volatile("s_waitcnt vmcnt(0) lgkmcnt(0)" ::: "memory"); __syncthreads();
        if (tid == 0) { unsigned* c = cnt + 64 * (64 + rg); (void)__hip_atomic_fetch_add(c, 1u, __ATOMIC_RELAXED, __HIP_MEMORY_SCOPE_AGENT);
            unsigned spins = 0; while (__hip_atomic_load(c, __ATOMIC_RELAXED, __HIP_MEMORY_SCOPE_AGENT) < 32u && ++spins < (1u << 22)) __builtin_amdgcn_s_sleep(2); }
        __syncthreads();
        const unsigned long long sv = __hip_atomic_load(ss + row, __ATOMIC_RELAXED, __HIP_MEMORY_SCOPE_AGENT);
        out[o] = v * rsqrtf((float)sv * (1.f / (16777216.f * DM)) + EPS) * gfin[col];
    }
    __syncthreads();
}
template <int MODE> struct EpiRS {
    static constexpr bool PERM = true, AFTER_DRAIN = false;
    const unsigned long long* ss; bf16_t* O0; bf16_t* O1; float* out; float scale;
    __device__ __forceinline__ void operator()(const f32x4 (&acc)[2][2][4][2], const Unit& u, int wr, int wc, int fr, int fq) const {
        EPI_ROWS_BEGIN
            const float rs = rsqrtf((float)ss[row] * (1.f / (16777216.f * DM)) + EPS) * scale;
#pragma unroll
            for (int bj = 0; bj < 2; ++bj) {
                const int col = u.pn * 256 + bj * 128 + wc * 32 + 8 * fq;
                const f32x4 v0 = acc[ai][bj][m][0] * rs, v1 = acc[ai][bj][m][1] * rs;
                if (MODE == 0) store_bf16x8(O0 + (size_t)row * 512 + col, v0, v1);
                else {
                    const bool up = u.pn >= 11; const int c2 = up ? col - DFF : col;
                    store_bf16x8((up ? O1 : O0) + (size_t)row * DFF + c2, v0, v1);
                    if (!up) { float* dst = nullptr;
                        if (row < MP) { const int t = row & 4095; if (t >= 4094) dst = out + O_FCP + (size_t)((row >> 12) * 2 + t - 4094) * DFF + c2; }
                        else if (row < MT) { const int t = (row - MP) & 3; if (t >= 2) dst = out + O_FCS + (size_t)(((row - MP) >> 2) * 2 + t - 2) * DFF + c2; }
                        if (dst) { *(f32x4*)dst = v0; *(f32x4*)(dst + 4) = v1; } }
                }
            }
        EPI_ROWS_END
    }
};
struct EpiGU {
    static constexpr bool PERM = true, AFTER_DRAIN = false;
    const unsigned long long* ss; bf16_t* ACT; const float* cst; float* EDGE; float* PART; float* UPV; const float* cw; const float* cb; float* out; LAS unsigned char* xl;
    __device__ __forceinline__ void operator()(const f32x4 (&acc)[2][2][4][2], const Unit& u, int wr, int wc, int fr, int fq) const {
        const int c0 = u.pn * 128 + wc * 32 + 8 * fq;
        if (u.pm == 64) {
            const int lane = threadIdx.x & 63, i1 = (lane - 1) * 4, i2 = (lane - 2) * 4, t = fr & 3;
            f32x4 wv[2][4];
#pragma unroll
            for (int n = 0; n < 2; ++n) { wv[n][0] = *(const f32x4*)(cw + c0 + 4 * n); wv[n][1] = *(const f32x4*)(cw + DFF + c0 + 4 * n); wv[n][2] = *(const f32x4*)(cw + 2 * DFF + c0 + 4 * n); wv[n][3] = *(const f32x4*)(cb + c0 + 4 * n); }
#pragma unroll
            for (int m = 0; m < 4; ++m) {
                const int sr = wr * 64 + m * 16 + fr, b = sr >> 2;
                const float rs = rsqrtf((float)ss[(unsigned)(MP + sr)] * (1.f / (16777216.f * DM)) + EPS);
                u32x4 q;
#pragma unroll
                for (int n = 0; n < 2; ++n) {
                    const f32x4 cur = acc[0][0][m][n] * rs, upv = acc[0][1][m][n] * rs;
                    f32x4 x1, x2;
#pragma unroll
                    for (int c = 0; c < 4; ++c) { x1[c] = __int_as_float(__builtin_amdgcn_ds_bpermute(i1, __float_as_int(cur[c]))); x2[c] = __int_as_float(__builtin_amdgcn_ds_bpermute(i2, __float_as_int(cur[c]))); }
                    if (t < 1) x1 = *(const f32x4*)(cst + (unsigned)((b * 2 + 1) * DFF + c0 + 4 * n));
                    if (t < 2) x2 = *(const f32x4*)(cst + (unsigned)((b * 2 + t) * DFF + c0 + 4 * n));
                    f32x4 r;
#pragma unroll
                    for (int c = 0; c < 4; ++c) r[c] = silu_f(wv[n][3][c] + wv[n][0][c] * x2[c] + wv[n][1][c] * x1[c] + wv[n][2][c] * cur[c]) * upv[c];
                    if (n == 0) { q.x = pk2(r[0], r[1]); q.y = pk2(r[2], r[3]); } else { q.z = pk2(r[0], r[1]); q.w = pk2(r[2], r[3]); }
                    if (t >= 2) *(f32x4*)(out + O_FCS + (unsigned)(((sr >> 2) * 2 + t - 2) * DFF + c0 + 4 * n)) = cur;
                }
                *(u32x4*)(ACT + ((unsigned)(MP + sr) * (unsigned)DFF + (unsigned)c0)) = q;
            }
            return;
        }
        const int lane = threadIdx.x & 63;
        float rsv[2][4];
#pragma unroll
        for (int ai = 0; ai < 2; ++ai)
#pragma unroll
            for (int m = 0; m < 4; ++m) rsv[ai][m] = rsqrtf((float)ss[(unsigned)(u.pm * 256 + ai * 128 + wr * 64 + m * 16 + fr)] * (1.f / (16777216.f * DM)) + EPS);
        LAS float* ex = (LAS float*)xl;
#pragma unroll
        for (int ai = 0; ai < 2; ++ai) { const float rs = rsv[ai][3];
            if (fr >= 14) { LAS float* d = ex + (((wr * 4 + wc) * 2 + ai) * 2 + (fr - 14)) * 32 + 8 * fq; const f32x4 a0 = acc[ai][0][3][0] * rs, a1 = acc[ai][0][3][1] * rs;
                d[0] = a0[0]; d[1] = a0[1]; d[2] = a0[2]; d[3] = a0[3]; d[4] = a1[0]; d[5] = a1[1]; d[6] = a1[2]; d[7] = a1[3];
                if (ai == 1 && wr == 1) { float* e = EDGE + (unsigned)((u.pm * 2 + (fr - 14)) * DFF + c0); *(f32x4*)e = a0; *(f32x4*)(e + 4) = a1;
                    if ((u.pm & 15) == 15) { float* dst = out + O_FCP + (unsigned)(((u.pm >> 4) * 2 + fr - 14) * DFF + c0); *(f32x4*)dst = a0; *(f32x4*)(dst + 4) = a1; } } } }
        asm volatile("s_waitcnt lgkmcnt(0)" ::: "memory"); __builtin_amdgcn_s_barrier(); asm volatile("" ::: "memory");
        const int i1 = (fr >= 1 ? lane - 1 : lane + 15) * 4, i2 = (fr >= 2 ? lane - 2 : lane + 14) * 4;
        u32x2 stash[2][4];
#pragma unroll
        for (int n = 0; n < 2; ++n) {
            const int cn = c0 + 4 * n;
            const f32x4 w0 = *(const f32x4*)(cw + cn), w1 = *(const f32x4*)(cw + DFF + cn), w2 = *(const f32x4*)(cw + 2 * DFF + cn), bb = *(const f32x4*)(cb + cn);
#pragma unroll
            for (int ai = 0; ai < 2; ++ai) {
                const int swr = wr ^ 1, sai = (ai == 1 && wr == 1) ? 1 : 0;
                f32x4 prev = *(const LAS f32x4*)(ex + (((swr * 4 + wc) * 2 + sai) * 2 + (fr & 1)) * 32 + 8 * fq + 4 * n);
#pragma unroll
                for (int m = 0; m < 4; ++m) {
                    const int row = u.pm * 256 + ai * 128 + wr * 64 + m * 16 + fr;
                    const float rs = rsv[ai][m];
                    const f32x4 cur = acc[ai][0][m][n] * rs, upv = acc[ai][1][m][n] * rs;
                    f32x4 r;
                    const bool first = (ai == 0 && wr == 0 && m == 0);
#pragma unroll
                    for (int c = 0; c < 4; ++c) {
                        const float g1 = __int_as_float(__builtin_amdgcn_ds_bpermute(i1, __float_as_int(fr == 15 ? prev[c] : cur[c])));
                        const float g2 = __int_as_float(__builtin_amdgcn_ds_bpermute(i2, __float_as_int(fr >= 14 ? prev[c] : cur[c])));
                        if (first && fr < 2) { PART[(unsigned)((u.pm * 2 + fr) * DFF + cn + c)] = bb[c] + w2[c] * cur[c] + (fr == 1 ? w1[c] * g1 : 0.f); UPV[(unsigned)((u.pm * 2 + fr) * DFF + cn + c)] = upv[c]; }
                        r[c] = silu_f(bb[c] + w0[c] * g2 + w1[c] * g1 + w2[c] * cur[c]) * upv[c];
                    }
                    { u32x2 w; w.x = pk2(r[0], r[1]); w.y = pk2(r[2], r[3]);
                      if (n == 0) stash[ai][m] = w;
                      else if (!(first && fr < 2)) { u32x4 q; q.x = stash[ai][m].x; q.y = stash[ai][m].y; q.z = w.x; q.w = w.y; *(u32x4*)(ACT + ((unsigned)row * (unsigned)DFF + (unsigned)c0)) = q; } }
                    prev = cur;
                }
            }
        }
    }
};
__device__ __forceinline__ void ffn_fixup_local(const Args& a, int pm, int tid) {
    unsigned char* ws = a.ws;
    const float* EDGE = (const float*)(ws + WS_EDGE); const float* PART = (const float*)(ws + WS_PART); const float* UPV = (const float*)(ws + WS_UPV); bf16_t* ACT = (bf16_t*)(ws + WS_ACT);
    const float* cw = a.in[24];
    float part[11], upv[11], gm1[11], gm2[11], c0v[11], c1v[11];
#pragma unroll
    for (int j = 0; j < 11; ++j) { const int i = tid + 512 * j, fr = i >= DFF ? 1 : 0, c = i - fr * DFF; const unsigned rr = (unsigned)((pm * 2 + fr) * DFF + c);
        part[j] = PART[rr]; upv[j] = UPV[rr]; c0v[j] = cw[c]; c1v[j] = cw[DFF + c];
        gm1[j] = (pm & 15) ? EDGE[(unsigned)(((pm - 1) * 2 + 1) * DFF + c)] : 0.f; gm2[j] = (pm & 15) ? EDGE[(unsigned)(((pm - 1) * 2) * DFF + c)] : 0.f; }
#pragma unroll
    for (int j = 0; j < 11; ++j) { const int i = tid + 512 * j, fr = i >= DFF ? 1 : 0, c = i - fr * DFF;
        const float conv = part[j] + (fr == 0 ? c1v[j] * gm1[j] + c0v[j] * gm2[j] : c0v[j] * gm1[j]);
        ACT[(unsigned)((pm * 256 + fr) * DFF + c)] = (bf16_t)(pk2(silu_f(conv) * upv[j], 0.f) & 0xffffu); }
    asm volatile("s_waitcnt vmcnt(0)" ::: "memory");
    __syncthreads();
}
__device__ __forceinline__ void p0_transpose_item(const float* W, int K, int N, const float* gk, bf16_t* WT, int row_off, LAS float* scr, int item, int lane, bool il = false) {
    const int nblk = N / 32, kb = item / nblk, nb = item % nblk, k0 = 64 * kb, n0 = 32 * nb;
    { const int kq = lane >> 3, n4 = (lane & 7) * 4; f32x4 v[8]; float g[8];
#pragma unroll
      for (int i = 0; i < 8; ++i) { v[i] = *(const f32x4*)(W + (size_t)(k0 + kq + 8 * i) * N + n0 + n4); g[i] = gk ? gk[k0 + kq + 8 * i] : 1.f; }
#pragma unroll
      for (int i = 0; i < 8; ++i) { LAS float* d = scr + (kq + 8 * i) * 33 + n4; d[0] = v[i][0] * g[i]; d[1] = v[i][1] * g[i]; d[2] = v[i][2] * g[i]; d[3] = v[i][3] * g[i]; } }
    asm volatile("s_waitcnt lgkmcnt(0)" ::: "memory");
    const int c = lane & 7;
#pragma unroll
    for (int j = 0; j < 4; ++j) { const int n = (lane >> 3) + 8 * j; const LAS float* s = scr + (8 * c) * 33 + n;
        u32x4 o; o.x = pk2(s[0 * 33], s[1 * 33]); o.y = pk2(s[2 * 33], s[3 * 33]); o.z = pk2(s[4 * 33], s[5 * 33]); o.w = pk2(s[6 * 33], s[7 * 33]);
        const int drow = il ? ((n0 >> 7) << 8) + (n0 & 127) + n + row_off : row_off + n0 + n;
        *(u32x4*)(WT + (size_t)drow * K + k0 + 8 * c) = o; }
    asm volatile("s_waitcnt lgkmcnt(0)" ::: "memory");
}
__device__ __forceinline__ void rms_rows2_to_bf16(const float* x0, bf16_t* o0, const float* x1, bf16_t* o1, bool has1, int lane) {
    const f32x4* xr = (const f32x4*)x0 + lane; const f32x4* yr = (const f32x4*)x1 + lane;
    f32x4 v[4], w[4]; float s = 0.f, s2 = 0.f;
#pragma unroll
    for (int j = 0; j < 4; ++j) { v[j] = xr[64 * j]; w[j] = yr[64 * j]; }
#pragma unroll
    for (int j = 0; j < 4; ++j) { s += (v[j].x * v[j].x + v[j].y * v[j].y) + (v[j].z * v[j].z + v[j].w * v[j].w); s2 += (w[j].x * w[j].x + w[j].y * w[j].y) + (w[j].z * w[j].z + w[j].w * w[j].w); }
    const float r = rsqrtf(wave_sum(s) * (1.f / DM) + EPS), r2 = rsqrtf(wave_sum(s2) * (1.f / DM) + EPS);
    u32x2* a8 = (u32x2*)o0 + lane; u32x2* b8 = (u32x2*)o1 + lane;
#pragma unroll
    for (int j = 0; j < 4; ++j) { u32x2 p; p.x = pk2(v[j].x * r, v[j].y * r); p.y = pk2(v[j].z * r, v[j].w * r); a8[64 * j] = p;
        if (has1) { u32x2 p2; p2.x = pk2(w[j].x * r2, w[j].y * r2); p2.y = pk2(w[j].z * r2, w[j].w * r2); b8[64 * j] = p2; } }
}
constexpr int WI_IN = 16 * 112, WI_C = 16 * 16, WI_OUT = 16 * 32, WI_CO = 8 * 32, WI_G = 16 * 88, WI_D = 44 * 32;
constexpr int W_ITEMS_EARLY = WI_IN, W_ITEMS = WI_IN + 2 * WI_C + WI_OUT + WI_C + WI_CO + 2 * WI_G + WI_D;
__device__ __forceinline__ void weight_item(const Args& a, LAS float* scr, int it, int lane) {
    unsigned char* ws = a.ws; int r = it;
    if (r < WI_IN) { p0_transpose_item(a.in[11], 1024, 3584, a.in[10], (bf16_t*)(ws + WS_WIN), 0, scr, r, lane); return; } r -= WI_IN;
    if (r < WI_C) { p0_transpose_item(a.in[18], 1024, 512, a.in[16], (bf16_t*)(ws + WS_WCKV), 0, scr, r, lane); return; } r -= WI_C;
    if (r < WI_C) { p0_transpose_item(a.in[19], 1024, 512, a.in[16], (bf16_t*)(ws + WS_WCKV), 512, scr, r, lane); return; } r -= WI_C;
    if (r < WI_OUT) { const int k0 = 64 * (r / 32); const float* g = k0 < 512 ? a.in[12] : a.in[13] - 512; p0_transpose_item(a.in[14], 1024, 1024, g, (bf16_t*)(ws + WS_WOUT), 0, scr, r, lane); return; } r -= WI_OUT;
    if (r < WI_C) { p0_transpose_item(a.in[17], 1024, 512, a.in[15], (bf16_t*)(ws + WS_WCQ), 0, scr, r, lane); return; } r -= WI_C;
    if (r < WI_CO) { p0_transpose_item(a.in[20], 512, 1024, nullptr, (bf16_t*)(ws + WS_WCO), 0, scr, r, lane); return; } r -= WI_CO;
    if (r < WI_G) { p0_transpose_item(a.in[22], 1024, DFF, a.in[21], (bf16_t*)(ws + WS_WGU), 0, scr, r, lane, true); return; } r -= WI_G;
    if (r < WI_G) { p0_transpose_item(a.in[23], 1024, DFF, a.in[21], (bf16_t*)(ws + WS_WGU), 128, scr, r, lane, true); return; } r -= WI_G;
    p0_transpose_item(a.in[26], DFF, 1024, nullptr, (bf16_t*)(ws + WS_WD), 0, scr, r, lane);
}
__device__ __forceinline__ void p0_prologue(const Args& a, LAS unsigned char* lds, int wave, int lane, int G) {
    unsigned char* ws = a.ws;
    LAS float* scr = (LAS float*)(lds + wave * 16384);
    const int gw = blockIdx.x * 8 + wave, NGW = G * 8;
    for (int it = gw; it < (MK_N_LAUNCHES == 1 ? W_ITEMS_EARLY : W_ITEMS); it += NGW) weight_item(a, scr, it, lane);
    bf16_t* XN = (bf16_t*)(ws + WS_XN); bf16_t* MN = (bf16_t*)(ws + WS_MN);
    for (int m = gw; m < MT + 1024; m += 2 * NGW) {
        const int m2 = m + NGW; const bool has1 = m2 < MT + 1024; const int mb = has1 ? m2 : m;
        const float* xa = m < MP ? a.in[0] + (size_t)m * DM : (m < MT ? a.in[1] + (size_t)(m - MP) * DM : a.in[8] + (size_t)(m - MT) * DM);
        const float* xb = mb < MP ? a.in[0] + (size_t)mb * DM : (mb < MT ? a.in[1] + (size_t)(mb - MP) * DM : a.in[8] + (size_t)(mb - MT) * DM);
        bf16_t* oa = m < MT ? XN + (size_t)m * DM : MN + (size_t)(m - MT) * DM; bf16_t* ob = mb < MT ? XN + (size_t)mb * DM : MN + (size_t)(mb - MT) * DM;
        rms_rows2_to_bf16(xa, oa, xb, ob, has1, lane);
    }
    const int gt = blockIdx.x * 512 + threadIdx.x, NT = G * 512;
    float* LB = (float*)(ws + WS_LB); unsigned long long* SS1 = (unsigned long long*)(ws + WS_SS1); unsigned long long* SS2 = (unsigned long long*)(ws + WS_SS2);
    for (int i = gt; i < 512; i += NT) LB[i] = 1.f / (1.f + __expf(a.in[9][512 + i] - a.in[9][i]));
    for (int i = gt; i < MPAD; i += NT) { SS1[i] = 0ull; SS2[i] = 0ull; }
    for (int i = gt; i < MT; i += NT) ((unsigned long long*)(ws + WS_SS3))[i] = 0ull;
    for (int i = gt; i < 64 * 72; i += NT) ((unsigned*)(ws + WS_CNT))[i] = 0u;
}

__device__ __forceinline__ void hgrn_step1(const Args& a, LAS unsigned char* lds, int ch, int tid) {
    unsigned char* ws = a.ws;
    float* LF = (float*)(ws + WS_LF); const bf16_t* VT = (const bf16_t*)(ws + WS_VT); float* KV = (float*)(ws + WS_KV);
    LAS float* bsm = (LAS float*)lds;
    const int bh = ch >> 6, c = ch & 63, b = bh >> 2, h = bh & 3;
    const int row0 = b * SEQ + c * 64;
    const int k = tid & 127, seg = tid >> 7;
    float loc[16];
#pragma unroll
    for (int i = 0; i < 16; ++i) loc[i] = LF[(size_t)(row0 + seg * 16 + i) * 512 + h * 128 + k];
#pragma unroll
    for (int i = 1; i < 16; ++i) loc[i] += loc[i - 1];
    bsm[(seg * 16 + 15) * 129 + k] = loc[15];
    __syncthreads();
    float off = 0.f;
    for (int s = 0; s < seg; ++s) off += bsm[(s * 16 + 15) * 129 + k];
    __syncthreads();
#pragma unroll
    for (int i = 0; i < 16; ++i) { const float v = loc[i] + off; bsm[(seg * 16 + i) * 129 + k] = v; LF[(size_t)(row0 + seg * 16 + i) * 512 + h * 128 + k] = v; }
    __syncthreads();
    const int wave = tid >> 6, lane = tid & 63, lr = lane & 15, lg = lane >> 4;
    const bf16_t* vrow = VT + (size_t)(bh * 128 + wave * 16 + lr) * 4096 + c * 64;
    const bf16x8 A0 = *(const bf16x8*)(vrow + lg * 8), A1 = *(const bf16x8*)(vrow + 32 + lg * 8);
#pragma unroll 2
    for (int kb = 0; kb < 8; ++kb) {
        const int kk = kb * 16 + lr; const float bl = bsm[63 * 129 + kk];
        f32x4 acc = {0.f, 0.f, 0.f, 0.f};
#pragma unroll
        for (int ks = 0; ks < 2; ++ks) {
            const int s0 = ks * 32 + lg * 8;
            float bprev = s0 > 0 ? bsm[(s0 - 1) * 129 + kk] : 0.f;
            float w[8];
#pragma unroll
            for (int i = 0; i < 8; ++i) { const float bs = bsm[(s0 + i) * 129 + kk]; w[i] = (1.f - __expf(bs - bprev)) * __expf(bl - bs); bprev = bs; }
            u32x4 pw; pw.x = pk2m(w[0], w[1]); pw.y = pk2m(w[2], w[3]); pw.z = pk2m(w[4], w[5]); pw.w = pk2m(w[6], w[7]);
            acc = __builtin_amdgcn_mfma_f32_16x16x32_bf16(ks == 0 ? A0 : A1, __builtin_bit_cast(bf16x8, pw), acc, 0, 0, 0);
        }
        float* kvp = KV + ((size_t)ch * 128 + wave * 16 + lg * 4) * 128 + kk;
#pragma unroll
        for (int j = 0; j < 4; ++j) kvp[j * 128] = acc[j];
    }
    __syncthreads();
}
__device__ __forceinline__ void hgrn_scan(const Args& a, int G) {
    unsigned char* ws = a.ws;
    const float* Bc = (const float*)(ws + WS_LF); const float* KV = (const float*)(ws + WS_KV); bf16_t* SP = (bf16_t*)(ws + WS_SP);
    const int NT = G * 512;
    for (int e0 = blockIdx.x * 512 + threadIdx.x; e0 < 16 * 16384; e0 += 2 * NT) {
        const int e1 = e0 + NT; const bool has1 = e1 < 16 * 16384; const int e1c = has1 ? e1 : e0;
        const int bh0 = e0 >> 14, vk0 = e0 & 16383, bh1 = e1c >> 14, vk1 = e1c & 16383;
        const float* d0 = Bc + (size_t)((bh0 >> 2) * SEQ + 63) * 512 + (bh0 & 3) * 128 + (e0 & 127);
        const float* d1 = Bc + (size_t)((bh1 >> 2) * SEQ + 63) * 512 + (bh1 & 3) * 128 + (e1c & 127);
        float S0 = 0.f, S1 = 0.f;
        for (int c0 = 0; c0 < 64; c0 += 8) {
            float kv0[8], dl0[8], kv1[8], dl1[8];
#pragma unroll
            for (int i = 0; i < 8; ++i) { kv0[i] = KV[((size_t)(bh0 * 64 + c0 + i) << 14) + vk0]; dl0[i] = d0[(size_t)(c0 + i) * 64 * 512];
                                          kv1[i] = KV[((size_t)(bh1 * 64 + c0 + i) << 14) + vk1]; dl1[i] = d1[(size_t)(c0 + i) * 64 * 512]; }
#pragma unroll
            for (int i = 0; i < 8; ++i) { SP[((size_t)(bh0 * 64 + c0 + i) << 14) + vk0] = (bf16_t)(pk2(S0, 0.f) & 0xffffu); S0 = __expf(dl0[i]) * S0 + kv0[i];
                if (has1) SP[((size_t)(bh1 * 64 + c0 + i) << 14) + vk1] = (bf16_t)(pk2(S1, 0.f) & 0xffffu); S1 = __expf(dl1[i]) * S1 + kv1[i]; }
        }
        a.out[O_HSP + ((size_t)bh0 * 128 + (e0 & 127)) * 128 + ((e0 >> 7) & 127)] = S0;
        if (has1) a.out[O_HSP + ((size_t)bh1 * 128 + (e1 & 127)) * 128 + ((e1 >> 7) & 127)] = S1;
    }
}
template <int I> __device__ __forceinline__ void hgrn_step3(const Args& a, int ch, int lane) {
    unsigned char* ws = a.ws;
    const float* Bc = (const float*)(ws + WS_LF); const bf16_t* VT = (const bf16_t*)(ws + WS_VT); const bf16_t* SP = (const bf16_t*)(ws + WS_SP);
    const bf16_t* QH = (const bf16_t*)(ws + WS_QH); const bf16_t* GH = (const bf16_t*)(ws + WS_GH); bf16_t* MIX = (bf16_t*)(ws + WS_MIX);
    const int bh = ch >> 6, c = ch & 63, b = bh >> 2, h = bh & 3;
    const int row0 = b * SEQ + c * 64, rowI = row0 + 16 * I, hk = h * 128, lr = lane & 15, lg = lane >> 4;
    bf16x8 Qi[4], Qr[4];
#pragma unroll
    for (int ks = 0; ks < 4; ++ks) {
        const size_t o = (size_t)(rowI + lr) * 512 + hk + ks * 32 + lg * 8;
        const u32x4 qw = *(const u32x4*)(QH + o); const f32x4 b0 = *(const f32x4*)(Bc + o), b1 = *(const f32x4*)(Bc + o + 4);
        f32x4 r0 = {0.f, 0.f, 0.f, 0.f}, r1 = r0;
        if (I > 0) { const size_t orf = (size_t)(rowI - 1) * 512 + hk + ks * 32 + lg * 8; r0 = *(const f32x4*)(Bc + orf); r1 = *(const f32x4*)(Bc + orf + 4); }
        const float q[8] = {bflo(qw.x), bfhi(qw.x), bflo(qw.y), bfhi(qw.y), bflo(qw.z), bfhi(qw.z), bflo(qw.w), bfhi(qw.w)};
        const float bb[8] = {b0[0], b0[1], b0[2], b0[3], b1[0], b1[1], b1[2], b1[3]}; const float rr[8] = {r0[0], r0[1], r0[2], r0[3], r1[0], r1[1], r1[2], r1[3]};
        u32x4 wi, wr2; float x[8], y[8];
#pragma unroll
        for (int i = 0; i < 8; ++i) { x[i] = q[i] * __expf(bb[i]); y[i] = q[i] * __expf(bb[i] - rr[i]); }
        wi.x = pk2m(x[0], x[1]); wi.y = pk2m(x[2], x[3]); wi.z = pk2m(x[4], x[5]); wi.w = pk2m(x[6], x[7]);
        wr2.x = pk2m(y[0], y[1]); wr2.y = pk2m(y[2], y[3]); wr2.z = pk2m(y[4], y[5]); wr2.w = pk2m(y[6], y[7]);
        Qi[ks] = __builtin_bit_cast(bf16x8, wi); Qr[ks] = __builtin_bit_cast(bf16x8, wr2);
    }
    f32x4 oacc[8];
#pragma unroll
    for (int vb = 0; vb < 8; ++vb) { oacc[vb] = (f32x4){0.f, 0.f, 0.f, 0.f};
        const bf16_t* sp = SP + ((size_t)ch * 128 + vb * 16 + lr) * 128 + lg * 8;
#pragma unroll
        for (int ks = 0; ks < 4; ++ks) oacc[vb] = __builtin_amdgcn_mfma_f32_16x16x32_bf16(*(const bf16x8*)(sp + ks * 32), Qi[ks], oacc[vb], 0, 0, 0); }
    s16x4 Avs[I + 1][8];
#pragma unroll
    for (int J = 0; J <= I; ++J)
#pragma unroll
        for (int vb = 0; vb < 8; ++vb) Avs[J][vb] = *(const s16x4*)(VT + (size_t)(bh * 128 + vb * 16 + lr) * 4096 + c * 64 + 16 * J + lg * 4);
#pragma unroll
    for (int J = 0; J <= I; ++J) {
        f32x4 st = {0.f, 0.f, 0.f, 0.f};
        const int s = 16 * J + lr;
#pragma unroll
        for (int ks = 0; ks < 4; ++ks) {
            const size_t o = (size_t)(row0 + s) * 512 + hk + ks * 32 + lg * 8;
            const f32x4 b0 = *(const f32x4*)(Bc + o), b1 = *(const f32x4*)(Bc + o + 4);
            f32x4 p0 = {0.f, 0.f, 0.f, 0.f}, p1 = p0, r0 = p0, r1 = p0;
            if (s > 0) { p0 = *(const f32x4*)(Bc + o - 512); p1 = *(const f32x4*)(Bc + o - 512 + 4); }
            if (I > 0) { const size_t orf = (size_t)(rowI - 1) * 512 + hk + ks * 32 + lg * 8; r0 = *(const f32x4*)(Bc + orf); r1 = *(const f32x4*)(Bc + orf + 4); }
            float w[8];
#pragma unroll
            for (int i = 0; i < 4; ++i) { w[i] = (1.f - __expf(b0[i] - p0[i])) * __expf(fminf(r0[i] - b0[i], 80.f)); w[i + 4] = (1.f - __expf(b1[i] - p1[i])) * __expf(fminf(r1[i] - b1[i], 80.f)); }
            u32x4 pw; pw.x = pk2m(w[0], w[1]); pw.y = pk2m(w[2], w[3]); pw.z = pk2m(w[4], w[5]); pw.w = pk2m(w[6], w[7]);
            st = __builtin_amdgcn_mfma_f32_16x16x32_bf16(__builtin_bit_cast(bf16x8, pw), Qr[ks], st, 0, 0, 0);
        }
#pragma unroll
        for (int j = 0; j < 4; ++j) if (J > I || (J == I && lg * 4 + j > lr)) st[j] = 0.f;
        u32x2 pb; pb.x = pk2m(st[0], st[1]); pb.y = pk2m(st[2], st[3]);
        const s16x4 P = __builtin_bit_cast(s16x4, pb);
#pragma unroll
        for (int vb = 0; vb < 8; ++vb) {
            oacc[vb] = __builtin_amdgcn_mfma_f32_16x16x16bf16_1k(Avs[J][vb], P, oacc[vb], 0, 0, 0);
        }
    }
    float ssq = 0.f;
#pragma unroll
    for (int vb = 0; vb < 8; ++vb) ssq += (oacc[vb][0] * oacc[vb][0] + oacc[vb][1] * oacc[vb][1]) + (oacc[vb][2] * oacc[vb][2] + oacc[vb][3] * oacc[vb][3]);
    ssq = xg_sum(ssq);
    const float r = rsqrtf(ssq * (1.f / 128.f) + EPS);
#pragma unroll
    for (int vb = 0; vb < 8; ++vb) {
        const u32x2 gw = *(const u32x2*)(GH + (size_t)(rowI + lr) * 512 + hk + vb * 16 + lg * 4);
        u32x2 w; w.x = pk2(oacc[vb][0] * r * silu_f(bflo(gw.x)), oacc[vb][1] * r * silu_f(bfhi(gw.x))); w.y = pk2(oacc[vb][2] * r * silu_f(bflo(gw.y)), oacc[vb][3] * r * silu_f(bfhi(gw.y)));
        *(u32x2*)(MIX + (size_t)(rowI + lr) * DM + 512 + hk + vb * 16 + lg * 4) = w;
    }
}
__device__ __forceinline__ void hgrn_sample(const Args& a, LAS unsigned char* lds, int unit, int tid) {
    unsigned char* ws = a.ws;
    const float* LF = (const float*)(ws + WS_LF); const bf16_t* QH = (const bf16_t*)(ws + WS_QH); const bf16_t* VH = (const bf16_t*)(ws + WS_VH);
    const bf16_t* GH = (const bf16_t*)(ws + WS_GH); bf16_t* MIX = (bf16_t*)(ws + WS_MIX);
    LAS float* red = (LAS float*)lds;
    LAS float* tv = red + 1024;
    const int b = unit >> 2, h = unit & 3, hk = h * 128, v = tid & 127, kq = tid >> 7;
    __syncthreads();
    { const int t = tid >> 7, i = tid & 127; const size_t ro = (size_t)(MP + b * 4 + t) * 512 + hk + i;
      tv[t * 512 + i] = __expf(LF[ro]); tv[t * 512 + 128 + i] = bf1(QH[ro]); tv[t * 512 + 256 + i] = bf1(VH[ro]); tv[t * 512 + 384 + i] = bf1(GH[ro]); }
    float S[32];
    const float* s0 = a.in[4] + ((size_t)(b * 4 + h) * 128 + kq * 32) * 128 + v;
#pragma unroll
    for (int i = 0; i < 32; ++i) S[i] = s0[(size_t)i * 128];
    __syncthreads();
    for (int t = 0; t < 4; ++t) {
        const LAS float* tt = tv + t * 512;
        const float vv = tt[256 + v]; float op = 0.f;
#pragma unroll
        for (int i = 0; i < 32; ++i) { const int k = kq * 32 + i; const float f = tt[k]; S[i] = f * S[i] + (1.f - f) * vv; op += tt[128 + k] * S[i]; }
        red[kq * 128 + v] = op;
        __syncthreads();
        const float o = (red[v] + red[128 + v]) + (red[256 + v] + red[384 + v]);
        const float wsq = wave_sum(o * o);
        __syncthreads();
        if ((tid & 63) == 0) red[512 + (tid >> 6)] = wsq;
        __syncthreads();
        const float ssq = red[512] + red[513];
        if (kq == 0) { const float r = rsqrtf(ssq * (1.f / 128.f) + EPS);
            MIX[(size_t)(MP + b * 4 + t) * DM + 512 + hk + v] = (bf16_t)(pk2(o * r * silu_f(tt[384 + v]), 0.f) & 0xffffu); }
        __syncthreads();
    }
    float* so = a.out + O_HSS + ((size_t)(b * 4 + h) * 128 + kq * 32) * 128 + v;
#pragma unroll
    for (int i = 0; i < 32; ++i) so[(size_t)i * 128] = S[i];
}
__device__ __forceinline__ s16x4 tr_read(const LAS unsigned char* p) { typedef short v4i16_t __attribute__((ext_vector_type(4))); return __builtin_bit_cast(s16x4, __builtin_amdgcn_ds_read_tr16_b64_v4i16((LAS v4i16_t*)p)); }
__device__ __forceinline__ int dil_first_kb3(int p, int t0) { const int dsh = 2 * p, neg = (128 << dsh) - t0; return neg <= 0 ? 0 : (((neg + (1 << dsh) - 1) >> dsh) / 48); }
struct DilKV { bf16x8 K0[3], K1[3]; u32x4 V0[3], V1[3]; };
struct DilState { bf16x8 Q0, Q1; f32x4 o[4]; float m, l; };
__device__ __forceinline__ void dil_load(DilKV& R, const bf16_t* Kb, const bf16_t* Vb, size_t rowb, int h, int t0, int p, int kb3, int lr, int lg, int vkey, int vpart) {
    const int dsh = 2 * p, tb = t0 - (128 << dsh);
#pragma unroll
    for (int i = 0; i < 3; ++i) {
        const int kb = 3 * kb3 + i;
        int tk = tb + ((16 * kb + lr) << dsh); tk = tk < 0 ? 0 : (tk > SEQ - 1 ? SEQ - 1 : tk);
        const bf16_t* kp = Kb + (rowb + tk) * 512 + h * 64 + lg * 8;
        R.K0[i] = *(const bf16x8*)kp; R.K1[i] = *(const bf16x8*)(kp + 32);
        int tv = tb + ((16 * kb + vkey) << dsh); tv = tv < 0 ? 0 : (tv > SEQ - 1 ? SEQ - 1 : tv);
        const u32x4* vp = (const u32x4*)(Vb + (rowb + tv) * 512 + h * 64 + vpart * 16);
        R.V0[i] = vp[0]; R.V1[i] = vp[1];
    }
}
__device__ __forceinline__ void dil_qk(f32x4 (&st)[3], const DilKV& R, const DilState& S) {
#pragma unroll
    for (int i = 0; i < 3; ++i) { st[i] = (f32x4){0.f, 0.f, 0.f, 0.f};
        st[i] = __builtin_amdgcn_mfma_f32_16x16x32_bf16(R.K0[i], S.Q0, st[i], 0, 0, 0);
        st[i] = __builtin_amdgcn_mfma_f32_16x16x32_bf16(R.K1[i], S.Q1, st[i], 0, 0, 0); }
}
__device__ __forceinline__ void dil_consume(DilState& S, f32x4 (&st)[3], int jj0, int jmax, float sd, const LAS unsigned char* trp) {
    float bm = -INFINITY; const float bias0 = -sd * (float)jj0;
#pragma unroll
    for (int i = 0; i < 3; ++i)
#pragma unroll
        for (int j = 0; j < 4; ++j) { const int kk = 16 * i + j; const bool ok = (unsigned)(jj0 - kk) <= (unsigned)jmax;
            st[i][j] = ok ? st[i][j] + (bias0 + sd * (float)kk) : -INFINITY; bm = fmaxf(bm, st[i][j]); }
    bm = xg_max(bm);
    const float mnew = fmaxf(S.m, bm), corr = ex2(S.m - mnew);
    float ps = 0.f;
#pragma unroll
    for (int i = 0; i < 3; ++i)
#pragma unroll
        for (int j = 0; j < 4; ++j) { st[i][j] = ex2(st[i][j] - mnew); ps += st[i][j]; }
    ps = xg_sum(ps);
    S.l = S.l * corr + ps; S.m = mnew;
#pragma unroll
    for (int db = 0; db < 4; ++db) S.o[db] *= corr;
#pragma unroll
    for (int i = 0; i < 3; ++i) {
        u32x2 pb; pb.x = pk2m(st[i][0], st[i][1]); pb.y = pk2m(st[i][2], st[i][3]);
        const s16x4 P = __builtin_bit_cast(s16x4, pb);
#pragma unroll
        for (int db = 0; db < 4; ++db) S.o[db] = __builtin_amdgcn_mfma_f32_16x16x16bf16_1k(tr_read(trp + i * 2304 + db * 32), P, S.o[db], 0, 0, 0);
    }
}
__device__ __forceinline__ void dil_finish(DilState& S, bf16_t* MIX, size_t row, int h, int lg) {
    const float il = 1.f / S.l; float ssq = 0.f;
#pragma unroll
    for (int db = 0; db < 4; ++db) { S.o[db] *= il; ssq += (S.o[db][0] * S.o[db][0] + S.o[db][1] * S.o[db][1]) + (S.o[db][2] * S.o[db][2] + S.o[db][3] * S.o[db][3]); }
    ssq = xg_sum(ssq);
    const float rn = rsqrtf(ssq * (1.f / 64.f) + EPS);
#pragma unroll
    for (int db = 0; db < 4; ++db) { u32x2 w; w.x = pk2(S.o[db][0] * rn, S.o[db][1] * rn); w.y = pk2(S.o[db][2] * rn, S.o[db][3] * rn);
        *(u32x2*)(MIX + row * DM + h * 64 + db * 16 + lg * 4) = w; }
}
__device__ __forceinline__ void dil_attn_unit(const Args& a, LAS unsigned char* vl  , int unit, int lane) {
    unsigned char* ws = a.ws;
    const bf16_t* Qb = (const bf16_t*)(ws + WS_QB); const bf16_t* Kb = (const bf16_t*)(ws + WS_KB); const bf16_t* Vb = (const bf16_t*)(ws + WS_VB); bf16_t* MIX = (bf16_t*)(ws + WS_MIX);
    const int rp = unit & 7, blk = (unit >> 3) & 15, h = (unit >> 7) & 7, b = unit >> 10;
    const int lr = lane & 15, lg = lane >> 4, t0A = blk * 256 + rp, t0B = t0A + 8;
    const float slope = exp2f(-(float)(h + 1)) * LOG2E;
    const size_t rowb = (size_t)b * SEQ;
    DilState A, B;
    { const bf16_t* qa = Qb + (rowb + t0A + 16 * lr) * 512 + h * 64 + lg * 8; A.Q0 = *(const bf16x8*)qa; A.Q1 = *(const bf16x8*)(qa + 32);
      const bf16_t* qb = qa + 8 * 512; B.Q0 = *(const bf16x8*)qb; B.Q1 = *(const bf16x8*)(qb + 32); }
#pragma unroll
    for (int db = 0; db < 4; ++db) { A.o[db] = (f32x4){0.f, 0.f, 0.f, 0.f}; B.o[db] = A.o[db]; }
    A.m = -1e30f; A.l = 0.f; B.m = -1e30f; B.l = 0.f;
    const int vkey = lane >> 2, vpart = lane & 3, li = lane & 15;
    const LAS unsigned char* trp = vl + (lg * 4 + (li >> 2)) * 144 + (li & 3) * 8;
    const int tqA = t0A + 16 * lr, tqB = tqA + 8;
    int sg = 0, kb3 = dil_first_kb3(0, t0A);
    DilKV cur;
    dil_load(cur, Kb, Vb, rowb, h, t0A, 0, kb3, lr, lg, vkey, vpart);
#pragma unroll 1
    for (;;) {
        const int p = sg < 2 ? sg : 2, dsh = 2 * p, step = 16 >> dsh;
        f32x4 stA[3], stB[3];
        if (sg != 3) dil_qk(stA, cur, A);
        if (sg != 2) dil_qk(stB, cur, B);
#pragma unroll
        for (int i = 0; i < 3; ++i) { *(LAS u32x4*)(vl + i * 2304 + vkey * 144 + vpart * 32) = cur.V0[i]; *(LAS u32x4*)(vl + i * 2304 + vkey * 144 + vpart * 32 + 16) = cur.V1[i]; }
        int sn = sg, kn = kb3 + 1; const int nb3 = sg == 0 ? 8 : (sg == 1 ? 4 : 3);
        if (kn == nb3) { sn = sg + 1; kn = sn < 4 ? dil_first_kb3(sn < 2 ? sn : 2, sn == 3 ? t0B : t0A) : 0; }
        const bool last = sn == 4;
        if (!last) dil_load(cur, Kb, Vb, rowb, h, sn == 3 ? t0B : t0A, sn < 2 ? sn : 2, kn, lr, lg, vkey, vpart);
        const float sd = slope * (float)(1 << dsh);
        const int jbase = 128 + step * lr - 48 * kb3 - 4 * lg;
        if (sg != 3) { const int jm = tqA >> dsh; dil_consume(A, stA, jbase, jm < 128 ? jm : 128, sd, trp); }
        if (sg != 2) { const int jm = tqB >> dsh; dil_consume(B, stB, jbase + (sg < 2 ? (8 >> dsh) : 0), jm < 128 ? jm : 128, sd, trp); }
        if (last) break;
        sg = sn; kb3 = kn;
    }
    dil_finish(A, MIX, rowb + tqA, h, lg);
    dil_finish(B, MIX, rowb + tqB, h, lg);
}

template <int MODE> __device__ __forceinline__ const float* samp_row(const Args& a, int b, int t, int h, int e, bool isv) {
    if (MODE == 0) { const int p = e / 129, j = e - p * 129, idx = 2048 + t - (j << (2 * p));
        if (idx < 2048) return a.in[isv ? 3 : 2] + (((size_t)b * 2048 + idx) * 8 + h) * 64;
        return a.out + (isv ? O_WVS : O_WKS) + ((size_t)(b * 4 + idx - 2048) * 8 + h) * 64; }
    return a.in[isv ? 7 : 6] + (((size_t)b * 256 + e) * 4 + h) * 128;
}
template <int MODE, int NP> __device__ __forceinline__ void sample_attn_unit(const Args& a, LAS unsigned char* wl  , LAS float* xch  , int unit, int ul, int part, int lane) {
    constexpr int DH = MODE == 0 ? 64 : 128, NK = MODE == 0 ? 387 : 256, NH = MODE == 0 ? 8 : 4, NV = DH / 64, NKP = (NK + NP - 1) / NP;
    unsigned char* ws = a.ws;
    const int h = unit % NH, bt = unit / NH, b = bt >> 2, t = bt & 3;
    const int e0 = part * NKP, e1 = e0 + NKP < NK ? e0 + NKP : NK, nk = e1 - e0;
    LAS float* qs = (LAS float*)wl; LAS float* sc = qs + DH;
    const bf16_t* qp = (MODE == 0 ? (const bf16_t*)(ws + WS_QB) : (const bf16_t*)(ws + WS_CQ)) + (size_t)(MP + bt) * 512 + h * DH;
    for (int i = lane; i < DH; i += 64) qs[i] = bf1(qp[i]);
    const float slope = MODE == 0 ? exp2f(-(float)(h + 1)) * LOG2E : 0.f;
    float mx = -INFINITY;
    for (int el = lane; el < nk; el += 64) { const int e = e0 + el;
        const f32x4* kp = (const f32x4*)samp_row<MODE>(a, b, t, h, e, false); float dot = 0.f;
#pragma unroll
        for (int i = 0; i < DH / 4; ++i) { const f32x4 kv = kp[i]; const f32x4 qv = *(const LAS f32x4*)(qs + 4 * i); dot += (kv[0] * qv[0] + kv[1] * qv[1]) + (kv[2] * qv[2] + kv[3] * qv[3]); }
        if (MODE == 0) { const int p = e / 129, j = e - p * 129; dot -= slope * (float)(j << (2 * p)); }
        sc[el] = dot; mx = fmaxf(mx, dot);
    }
    mx = wave_max(mx);
    float sum = 0.f;
    for (int el = lane; el < nk; el += 64) { const float pe = ex2(sc[el] - mx); sc[el] = pe; sum += pe; }
    sum = wave_sum(sum);
    const int g = lane >> 4, d4 = lane & 15;
    f32x4 acc[NV];
#pragma unroll
    for (int v = 0; v < NV; ++v) acc[v] = (f32x4){0.f, 0.f, 0.f, 0.f};
    constexpr int NIT = (NKP + 3) / 4;
#pragma unroll 16
    for (int it = 0; it < NIT; ++it) { const int el = it * 4 + g; const bool ok = el < nk; const int ec = ok ? el : nk - 1;
        const float* vp = samp_row<MODE>(a, b, t, h, e0 + ec, true) + 4 * d4; const float pe = ok ? sc[ec] : 0.f;
#pragma unroll
        for (int v = 0; v < NV; ++v) acc[v] += *(const f32x4*)(vp + 64 * v) * pe; }
#pragma unroll
    for (int v = 0; v < NV; ++v)
#pragma unroll
        for (int j = 0; j < 4; ++j) { float x = acc[v][j]; x = xg_sum(x); acc[v][j] = x; }
    LAS float* xp = xch + (ul * NP + part) * (DH + 2);
    if (g == 0) {
#pragma unroll
        for (int v = 0; v < NV; ++v) *(LAS f32x4*)(xp + 64 * v + 4 * d4) = acc[v];
        if (d4 == 0) { xp[DH] = mx; xp[DH + 1] = sum; } }
    __syncthreads();
    if (part == 0) {
        const LAS float* x0 = xch + (ul * NP) * (DH + 2);
        float M = -INFINITY;
#pragma unroll
        for (int i = 0; i < NP; ++i) M = fmaxf(M, x0[i * (DH + 2) + DH]);
        float l = 0.f, o0 = 0.f, o1 = 0.f;
#pragma unroll
        for (int i = 0; i < NP; ++i) { const float f = ex2(x0[i * (DH + 2) + DH] - M); l += x0[i * (DH + 2) + DH + 1] * f; o0 += x0[i * (DH + 2) + lane] * f; if (MODE == 1) o1 += x0[i * (DH + 2) + 64 + lane] * f; }
        const float il = 1.f / l; o0 *= il; o1 *= il;
        if (MODE == 0) { const float rn = rsqrtf(wave_sum(o0 * o0) * (1.f / 64.f) + EPS);
            ((bf16_t*)(ws + WS_MIX))[(size_t)(MP + bt) * DM + h * 64 + lane] = (bf16_t)(pk2(o0 * rn, 0.f) & 0xffffu); }
        else { bf16_t* cp = (bf16_t*)(ws + WS_CO) + (size_t)(MP + bt) * 512 + h * 128; cp[lane] = (bf16_t)(pk2(o0, 0.f) & 0xffffu); cp[lane + 64] = (bf16_t)(pk2(o1, 0.f) & 0xffffu); }
    }
}

__device__ __forceinline__ void cross_unit(const Args& a, LAS unsigned char* lds, int unit, int tid) {
    unsigned char* ws = a.ws;
    const bf16_t* CQ = (const bf16_t*)(ws + WS_CQ); const bf16_t* MKB = (const bf16_t*)(ws + WS_MKB); const bf16_t* MVB = (const bf16_t*)(ws + WS_MVB); bf16_t* CO = (bf16_t*)(ws + WS_CO);
    const int qblk = unit & 15, h = (unit >> 4) & 3, b = unit >> 6;
    LAS unsigned char* ksm = lds; LAS unsigned char* vsm = lds + 256 * 272;
    __syncthreads();
    for (int i = tid; i < 4096; i += 512) { const int m = i >> 4, ck = i & 15; const size_t g = (size_t)(b * 256 + m) * 512 + h * 128 + ck * 8;
        *(LAS u32x4*)(ksm + m * 272 + ck * 16) = *(const u32x4*)(MKB + g); *(LAS u32x4*)(vsm + m * 272 + ck * 16) = *(const u32x4*)(MVB + g); }
    __syncthreads();
    const int wave = tid >> 6, lane = tid & 63, lr = lane & 15, lg = lane >> 4, li = lane & 15;
#pragma unroll 1
    for (int qq = 0; qq < 2; ++qq) {
        const size_t row = (size_t)b * SEQ + qblk * 256 + (wave * 2 + qq) * 16 + lr;
        bf16x8 Qf[4];
#pragma unroll
        for (int ks = 0; ks < 4; ++ks) Qf[ks] = *(const bf16x8*)(CQ + row * 512 + h * 128 + ks * 32 + lg * 8);
        f32x4 st[16]; float mx = -INFINITY;
#pragma unroll
        for (int kb = 0; kb < 16; ++kb) { st[kb] = (f32x4){0.f, 0.f, 0.f, 0.f};
#pragma unroll
            for (int ks = 0; ks < 4; ++ks) st[kb] = __builtin_amdgcn_mfma_f32_16x16x32_bf16(*(const LAS bf16x8*)(ksm + (kb * 16 + lr) * 272 + (ks * 32 + lg * 8) * 2), Qf[ks], st[kb], 0, 0, 0);
            mx = fmaxf(mx, fmaxf(fmaxf(st[kb][0], st[kb][1]), fmaxf(st[kb][2], st[kb][3]))); }
        mx = xg_max(mx);
        float sum = 0.f; s16x4 P[16];
#pragma unroll
        for (int kb = 0; kb < 16; ++kb) { f32x4 e;
#pragma unroll
            for (int j = 0; j < 4; ++j) { e[j] = ex2(st[kb][j] - mx); sum += e[j]; }
            u32x2 pb; pb.x = pk2m(e[0], e[1]); pb.y = pk2m(e[2], e[3]); P[kb] = __builtin_bit_cast(s16x4, pb); }
        sum = xg_sum(sum);
        const float il = 1.f / sum;
        const LAS unsigned char* trp = vsm + (lg * 4 + (li >> 2)) * 272 + (li & 3) * 8;
#pragma unroll
        for (int db = 0; db < 8; ++db) { f32x4 o = {0.f, 0.f, 0.f, 0.f};
#pragma unroll
            for (int kb = 0; kb < 16; ++kb) o = __builtin_amdgcn_mfma_f32_16x16x16bf16_1k(tr_read(trp + kb * 16 * 272 + db * 32), P[kb], o, 0, 0, 0);
            u32x2 w; w.x = pk2(o[0] * il, o[1] * il); w.y = pk2(o[2] * il, o[3] * il);
            *(u32x2*)(CO + row * 512 + h * 128 + db * 16 + lg * 4) = w; }
    }
}

__device__ __forceinline__ void unpack8(const u32x4 g, float (&x)[8]) { x[0] = bflo(g.x); x[1] = bfhi(g.x); x[2] = bflo(g.y); x[3] = bfhi(g.y); x[4] = bflo(g.z); x[5] = bfhi(g.z); x[6] = bflo(g.w); x[7] = bfhi(g.w); }
__device__ __forceinline__ void act_pass(const Args& a, int G) {
    unsigned char* ws = a.ws;
    const bf16_t* UG = (const bf16_t*)(ws + WS_UG); const bf16_t* UP = (const bf16_t*)(ws + WS_UP); bf16_t* ACT = (bf16_t*)(ws + WS_ACT);
    const float* cw = a.in[24]; const float* cb = a.in[25]; const float* st = a.in[5];
    constexpr int CH = DFF / 8, RG = 45;
    const int gt = blockIdx.x * 512 + threadIdx.x;
    const int c0 = (gt % CH) * 8, r0 = (gt / CH) * RG;
    if (r0 >= MT) return;
    const int r1 = r0 + RG < MT ? r0 + RG : MT;
    float w0[8], w1[8], w2[8], bb[8];
#pragma unroll
    for (int j = 0; j < 8; ++j) { w0[j] = cw[c0 + j]; w1[j] = cw[DFF + c0 + j]; w2[j] = cw[2 * DFF + c0 + j]; bb[j] = cb[c0 + j]; }
    float x1[8], x2[8];
    { const int t = r0 < MP ? (r0 & 4095) : ((r0 - MP) & 3);
#pragma unroll
      for (int j = 0; j < 8; ++j) { x1[j] = 0.f; x2[j] = 0.f; }
      if (t >= 1) unpack8(*(const u32x4*)(UG + (size_t)(r0 - 1) * DFF + c0), x1);
      if (t >= 2) unpack8(*(const u32x4*)(UG + (size_t)(r0 - 2) * DFF + c0), x2);
      if (r0 >= MP && t == 1) { const float* sp = st + ((size_t)((r0 - MP) >> 2) * 2 + 1) * DFF + c0;
#pragma unroll
          for (int j = 0; j < 8; ++j) x2[j] = sp[j]; } }
#pragma unroll 5
    for (int row = r0; row < r1; ++row) {
        const int t = row < MP ? (row & 4095) : ((row - MP) & 3);
        if (t == 0) {
            if (row >= MP) { const float* sp = st + (size_t)((row - MP) >> 2) * 2 * DFF + c0;
#pragma unroll
                for (int j = 0; j < 8; ++j) { x2[j] = sp[j]; x1[j] = sp[DFF + j]; } }
            else {
#pragma unroll
                for (int j = 0; j < 8; ++j) { x1[j] = 0.f; x2[j] = 0.f; } }
        }
        float x0[8], uu[8];
        unpack8(*(const u32x4*)(UG + (size_t)row * DFF + c0), x0); unpack8(*(const u32x4*)(UP + (size_t)row * DFF + c0), uu);
        float r[8];
#pragma unroll
        for (int j = 0; j < 8; ++j) { const float cv = bb[j] + w0[j] * x2[j] + w1[j] * x1[j] + w2[j] * x0[j]; r[j] = silu_f(cv) * uu[j]; x2[j] = x1[j]; x1[j] = x0[j]; }
        u32x4 w; w.x = pk2(r[0], r[1]); w.y = pk2(r[2], r[3]); w.z = pk2(r[4], r[5]); w.w = pk2(r[6], r[7]);
        *(u32x4*)(ACT + (size_t)row * DFF + c0) = w;
    }
}
__device__ __forceinline__ void final_norm(const Args& a, int G, int wave, int lane) {
    const float* g = a.in[27]; const bf16_t* XN = (const bf16_t*)(a.ws + WS_XN);
    f32x4 gg[4];
#pragma unroll
    for (int j = 0; j < 4; ++j) gg[j] = *((const f32x4*)g + 2 * lane + (j & 1) + 128 * (j >> 1));
    const int NGW = G * 8;
    for (int m = MP + blockIdx.x * 8 + wave; m < MT; m += 2 * NGW) {
        const int m2 = m + NGW; const bool has2 = m2 < MT; const int mb = has2 ? m2 : m;
        const u32x4 a0 = *((const u32x4*)(XN + (size_t)m * DM) + lane), a1 = *((const u32x4*)(XN + (size_t)m * DM) + 64 + lane);
        const u32x4 b0 = *((const u32x4*)(XN + (size_t)mb * DM) + lane), b1 = *((const u32x4*)(XN + (size_t)mb * DM) + 64 + lane);
        f32x4 v[4] = {{bflo(a0.x), bfhi(a0.x), bflo(a0.y), bfhi(a0.y)}, {bflo(a0.z), bfhi(a0.z), bflo(a0.w), bfhi(a0.w)}, {bflo(a1.x), bfhi(a1.x), bflo(a1.y), bfhi(a1.y)}, {bflo(a1.z), bfhi(a1.z), bflo(a1.w), bfhi(a1.w)}};
        f32x4 w[4] = {{bflo(b0.x), bfhi(b0.x), bflo(b0.y), bfhi(b0.y)}, {bflo(b0.z), bfhi(b0.z), bflo(b0.w), bfhi(b0.w)}, {bflo(b1.x), bfhi(b1.x), bflo(b1.y), bfhi(b1.y)}, {bflo(b1.z), bfhi(b1.z), bflo(b1.w), bfhi(b1.w)}};
        float s = 0.f, s2 = 0.f;
#pragma unroll
        for (int j = 0; j < 4; ++j) { s += (v[j].x * v[j].x + v[j].y * v[j].y) + (v[j].z * v[j].z + v[j].w * v[j].w); s2 += (w[j].x * w[j].x + w[j].y * w[j].y) + (w[j].z * w[j].z + w[j].w * w[j].w); }
        const float r = rsqrtf(wave_sum(s) * (1.f / DM) + EPS), r2 = rsqrtf(wave_sum(s2) * (1.f / DM) + EPS);
        f32x4* y = (f32x4*)(a.out + (size_t)m * DM); f32x4* y2 = (f32x4*)(a.out + (size_t)mb * DM);
#pragma unroll
        for (int j = 0; j < 4; ++j) { const int q = 2 * lane + (j & 1) + 128 * (j >> 1); y[q] = v[j] * r * gg[j]; if (has2) y2[q] = w[j] * r2 * gg[j]; }
    }
}
#define XB_TMO      128
#define XB_XCNT(j)  (256  + 64 * (j))
#define XB_XSUB(j)  (1280 + 64 * (j))
#define XB_XGEN(j)  (2304 + 64 * (j))
#define XB_TOP      3328
#define XB_TOPGEN   3392
#define XCD_BAR_WORDS 3456
#define XB_SPIN_CAP (1u << 18)

__device__ __forceinline__ unsigned xb_ld(unsigned* p)              { return __hip_atomic_load(p, __ATOMIC_RELAXED, __HIP_MEMORY_SCOPE_AGENT); }
__device__ __forceinline__ unsigned xb_add(unsigned* p, unsigned v) { return __hip_atomic_fetch_add(p, v, __ATOMIC_RELAXED, __HIP_MEMORY_SCOPE_AGENT); }
__device__ __forceinline__ unsigned xb_xcc_id() { return (unsigned)__builtin_amdgcn_s_getreg((3 << 11) | 20) & 0xFu; }
#define XB_SPIN(cond, bar) do { unsigned _sp = 0; while (cond) { __builtin_amdgcn_s_sleep(1); \
    if ((++_sp & 255u) == 0u) { if (xb_ld(&(bar)[XB_TMO])) break; if (_sp > XB_SPIN_CAP) { atomicAdd(&(bar)[XB_TMO], 1u); break; } } } } while (0)

struct XcdBarrier {
    unsigned* bar; unsigned x;
    volatile LAS unsigned* st;
};

__device__ __forceinline__ XcdBarrier xcd_barrier_post(unsigned* bar, volatile LAS unsigned* st) {
    XcdBarrier b; b.bar = bar; b.x = xb_xcc_id(); b.st = st;
    if (threadIdx.x == 0) (void)xb_add(&bar[XB_XCNT(b.x)], 1u);
    return b;
}
__device__ __forceinline__ void xcd_barrier_complete(unsigned* bar, unsigned x, unsigned& nloc, unsigned& nx) {
    const unsigned G = gridDim.x * gridDim.y * gridDim.z;
    unsigned sum, cnt, mine, sp = 0u;
    for (;;) {
        sum = 0u; cnt = 0u; mine = 0u;
#pragma unroll
        for (unsigned j = 0; j < 16; ++j) { const unsigned c = xb_ld(&bar[XB_XCNT(j)]); sum += c; cnt += (c > 0u) ? 1u : 0u; mine = (j == x) ? c : mine; }
        if (sum == G) break;
        __builtin_amdgcn_s_sleep(1);
        if ((++sp & 255u) == 0u) { if (xb_ld(&bar[XB_TMO])) break; if (sp > XB_SPIN_CAP) { atomicAdd(&bar[XB_TMO], 1u); break; } }
    }
    nloc = mine > 0u ? mine : 1u; nx = cnt > 0u ? cnt : 1u;
}

__device__ __forceinline__ void xcd_barrier(const XcdBarrier& b) {
    asm volatile("s_waitcnt vmcnt(0)" ::: "memory");
    __syncthreads();
    if (threadIdx.x == 0) {
        unsigned* bar = b.bar;
        __builtin_amdgcn_s_waitcnt(0);
        unsigned nloc = b.st[0], nx = b.st[1];
        if (nloc == 0u) { xcd_barrier_complete(bar, b.x, nloc, nx); b.st[0] = nloc; b.st[1] = nx; }
        const unsigned old = xb_add(&bar[XB_XSUB(b.x)], 1u);
        const unsigned gen = old / nloc;
        if (old + 1u == (gen + 1u) * nloc) {
            __builtin_amdgcn_fence(__ATOMIC_RELEASE, "agent");
            asm volatile("s_waitcnt vmcnt(0)" ::: "memory");
            const unsigned og = xb_add(&bar[XB_TOP], 1u);
            const unsigned tg = og / nx;
            if (og + 1u == (tg + 1u) * nx) xb_add(&bar[XB_TOPGEN], 1u);
            else XB_SPIN(xb_ld(&bar[XB_TOPGEN]) == tg, bar);
            __builtin_amdgcn_fence(__ATOMIC_ACQUIRE, "agent");
            xb_add(&bar[XB_XGEN(b.x)], 1u);
            asm volatile("s_waitcnt vmcnt(0)" ::: "memory");
        } else {
            XB_SPIN(xb_ld(&bar[XB_XGEN(b.x)]) == gen, bar);
            __builtin_amdgcn_fence(__ATOMIC_ACQUIRE, "agent");
            asm volatile("s_waitcnt vmcnt(0)" ::: "memory");
        }
    }
    __syncthreads();
}

constexpr int NPH = 13;
__global__ void __launch_bounds__(512, 2) fwd_mega(Args args) {
    extern __shared__ __attribute__((aligned(16))) unsigned char lds_raw[];
    LAS unsigned char* lds = (LAS unsigned char*)lds_raw;
    cg::grid_group grid = cg::this_grid();
    const int tid = threadIdx.x, lane = tid & 63, wave = __builtin_amdgcn_readfirstlane(tid >> 6), G = gridDim.x, bx = blockIdx.x;
    unsigned char* ws = args.ws;
    const int lo = args.ph_lo, hi = args.ph_hi;
#define IN(k) (lo <= (k) && (k) < hi)
    volatile LAS unsigned* barst = (volatile LAS unsigned*)(lds + LDS_BARST);
    if (tid < 2) barst[tid] = 0u;
    __syncthreads();
    XcdBarrier xbar; xbar.bar = (unsigned*)(ws + WS_BAR); xbar.x = 0; xbar.st = barst;
    if (lo < 0) grid.sync();
    if (hi - lo > 1) xbar = xcd_barrier_post((unsigned*)(ws + WS_BAR), barst);
#define SEAM(k) do { if (IN(k) && IN((k) + 1)) xcd_barrier(xbar); } while (0)
    bf16_t* XN = (bf16_t*)(ws + WS_XN);
    if (IN(0)) { REPS(0) p0_prologue(args, lds, wave, lane, G); }
    SEAM(0);
    if (IN(1)) REPS(1) {
        { pg8::Gemm g{XN, (const bf16_t*)(ws + WS_WIN), MPAD, 3584, 1024}; pg8::StaticOrder S; S.init(MPAD, 3584, G, bx);
          EpiIn E{(bf16_t*)(ws + WS_QB), (bf16_t*)(ws + WS_KB), (bf16_t*)(ws + WS_VB), (bf16_t*)(ws + WS_QH), (bf16_t*)(ws + WS_VH), (bf16_t*)(ws + WS_GH), (bf16_t*)(ws + WS_VT),
                  (float*)(ws + WS_LF), (const float*)(ws + WS_LB), args.out};
          pg8::gemm_phase<EpiIn, pg8::StaticOrder, true, true>(lds, g, S, E); }
        if (MK_N_LAUNCHES == 1 && bx >= 142) {
            __syncthreads();
            LAS float* scr = (LAS float*)(lds + wave * 16384);
            for (int it = W_ITEMS_EARLY + (bx - 142) * 8 + wave; it < W_ITEMS; it += (G - 142) * 8) weight_item(args, scr, it, lane);
            __syncthreads();
        }
    }
    SEAM(1);
    if (IN(2)) {
        for (int ch = bx; ch < 1024; ch += G) hgrn_step1(args, lds, ch, tid);
        __syncthreads();
        LAS unsigned char* wl = lds + wave * 8192;
        {
            const int x = bx & 7, lw = (bx >> 3) * 8 + wave;
#pragma unroll 1
            REPS(2) for (int kk = 0; kk < 3; ++kk) { if (kk < 2) dil_attn_unit(args, wl, ((((kk * 2 + (lw >> 7)) * 8 + x) << 7) | (lw & 127)), lane);
                else sample_attn_unit<0, 2>(args, wl, (LAS float*)(lds + 65536), bx * 4 + (wave & 3), wave & 3, wave >> 2, lane); }
        }
    }
    SEAM(2);
    if (IN(3)) { REPS(3) hgrn_scan(args, G); }
    SEAM(3);
    if (IN(4)) REPS(4) {
#pragma unroll 1
        for (int u = bx * 8 + wave; u < 4096; u += G * 8) { const int I = u < 2048 ? 3 - (u & 3) : (u & 3), ch = u >> 2;
            if (I == 0) hgrn_step3<0>(args, ch, lane); else if (I == 1) hgrn_step3<1>(args, ch, lane); else if (I == 2) hgrn_step3<2>(args, ch, lane); else hgrn_step3<3>(args, ch, lane); }
        __syncthreads();
        for (int u = G - 1 - bx; u < 128; u += G) hgrn_sample(args, lds, u, tid);
    }
    SEAM(4);
    if (IN(5)) {
        pg8::Gemm g{(const bf16_t*)(ws + WS_MIX), (const bf16_t*)(ws + WS_WOUT), MP, 1024, 1024}; pg8::StaticOrder S; S.init(MP, 1024, G, bx);
        EpiRes<0> E{args.in[0], args.out, XN, (unsigned long long*)(ws + WS_SS1)};
        pg8::gemm_phase<EpiRes<0>, pg8::StaticOrder, true, true>(lds, g, S, E);
        mini_gemm_res<0>(lds, (const bf16_t*)(ws + WS_MIX), (const bf16_t*)(ws + WS_WOUT), 1024, args.in[1], args.out, XN, (unsigned long long*)(ws + WS_SS1), tid);
    }
    SEAM(5);
    if (IN(6)) REPS(6) {
        pg8::Gemm g{XN, (const bf16_t*)(ws + WS_WCQ), MPAD, 512, 1024}; pg8::StaticOrder S; S.init(MPAD, 512, G, bx);
        EpiRS<0> E{(const unsigned long long*)(ws + WS_SS1), (bf16_t*)(ws + WS_CQ), nullptr, args.out, CQSCALE};
        pg8::gemm_phase<EpiRS<0>, pg8::StaticOrder, true, true>(lds, g, S, E);
        { pg8::Gemm g{(const bf16_t*)(ws + WS_MN), (const bf16_t*)(ws + WS_WCKV), 1024, 1024, 1024}; pg8::StaticOrder S; S.init(1024, 1024, G, G - 1 - bx);
          EpiMem E{(bf16_t*)(ws + WS_MKB), (bf16_t*)(ws + WS_MVB), args.out};
          pg8::gemm_phase<EpiMem, pg8::StaticOrder, true, true>(lds, g, S, E); }
    }
    SEAM(6);
    if (IN(7)) {
        REPS(7) for (int u = bx; u < 256; u += G) cross_unit(args, lds, u, tid);
        __syncthreads();
        LAS unsigned char* wl = lds + wave * 4096;
        sample_attn_unit<1, 4>(args, wl, (LAS float*)(lds + 65536), bx * 2 + (wave >> 2), wave >> 2, wave & 3, lane);
    }
    SEAM(7);
    if (IN(8)) {
        pg8::Gemm g{(const bf16_t*)(ws + WS_CO), (const bf16_t*)(ws + WS_WCO), MP, 1024, 512}; pg8::StaticOrder S; S.init(MP, 1024, G, bx);
        EpiRes<1> E{nullptr, args.out, XN, (unsigned long long*)(ws + WS_SS2)};
        pg8::gemm_phase<EpiRes<1>, pg8::StaticOrder, true, true>(lds, g, S, E);
        mini_gemm_res<1>(lds, (const bf16_t*)(ws + WS_CO), (const bf16_t*)(ws + WS_WCO), 512, nullptr, args.out, XN, (unsigned long long*)(ws + WS_SS2), tid);
    }
    SEAM(8);
    if (IN(9)) REPS(9) {
        pg8::Gemm g{XN, (const bf16_t*)(ws + WS_WGU), MPAD, 2 * DFF, 1024}; pg8::StaticOrder S; S.init(MPAD, 2 * DFF, G, bx);
        EpiGU E{(const unsigned long long*)(ws + WS_SS2), (bf16_t*)(ws + WS_ACT), args.in[5], (float*)(ws + WS_EDGE), (float*)(ws + WS_PART), (float*)(ws + WS_UPV),
                args.in[24], args.in[25], args.out, lds + 131072};
        pg8::gemm_phase<EpiGU, pg8::StaticOrder, true, true>(lds, g, S, E);
    }
    SEAM(9);
    if (IN(11)) {
        { const int wg = (bx & 7) * 32 + (bx >> 3), pm0 = (wg >> 5) * 8 + (wg & 7);
          ffn_fixup_local(args, pm0, tid); }
        pg8::Gemm g{(const bf16_t*)(ws + WS_ACT), (const bf16_t*)(ws + WS_WD), MP, 1024, DFF}; pg8::StaticOrder S; S.init(MP, 1024, G, bx);
        EpiFinal E{XN, (unsigned long long*)(ws + WS_SS3), (unsigned*)(ws + WS_CNT), args.in[27], args.out};
        pg8::gemm_phase<EpiFinal, pg8::StaticOrder, true, true>(lds, g, S, E);
        mini_gemm_res<2>(lds, (const bf16_t*)(ws + WS_ACT), (const bf16_t*)(ws + WS_WD), DFF, nullptr, args.out, XN, (unsigned long long*)(ws + WS_SS3), tid, (unsigned*)(ws + WS_CNT), args.in[27]);
    }
#undef IN
#undef SEAM
}

extern "C" void kernel_launch(void* const* d_in, const int* in_sizes, int n_in, void* d_out, int out_size, void* d_ws, size_t ws_size, hipStream_t stream) {
    static int grid = 0;
    if (grid == 0) {
        int dev = 0, cus = 0, per_cu = 0;
        (void)hipGetDevice(&dev); (void)hipDeviceGetAttribute(&cus, hipDeviceAttributeMultiprocessorCount, dev);
        if (hipFuncSetAttribute((const void*)fwd_mega, hipFuncAttributeMaxDynamicSharedMemorySize, LDS_BYTES) != hipSuccess) fprintf(stderr, "hipFuncSetAttribute failed\n");
        (void)hipOccupancyMaxActiveBlocksPerMultiprocessor(&per_cu, (const void*)fwd_mega, 512, LDS_BYTES);
        (void)hipGetLastError();
        grid = 256;
        if (cus < 256) fprintf(stderr, "kernel_launch: device reports %d CUs, this kernel needs 256\n", cus);
        if (n_in != 28 || ws_size < 384 * MiB) { fprintf(stderr, "kernel_launch: unexpected inputs (n_in %d, ws %zu)\n", n_in, ws_size); }
    }
    Args a{};
    for (int i = 0; i < 28; ++i) a.in[i] = (const float*)d_in[i];
    a.out = (float*)d_out; a.ws = (unsigned char*)d_ws;
#if MK_N_LAUNCHES == 1
    a.ph_lo = 0; a.ph_hi = NPH;
    (void)hipMemsetAsync((unsigned char*)d_ws + WS_BAR, 0, 3456 * 4, stream);
    void* kargs[] = {&a};
    hipError_t e = hipLaunchCooperativeKernel((const void*)fwd_mega, dim3(grid), dim3(512), kargs, LDS_BYTES, stream);
    if (e != hipSuccess) fprintf(stderr, "cooperative launch failed: %s (grid %d)\n", hipGetErrorString(e), grid);
#else
    for (int p = 0; p < NPH; ++p) { a.ph_lo = p; a.ph_hi = p + 1; hipLaunchKernelGGL(fwd_mega, dim3(grid), dim3(512), LDS_BYTES, stream, a); }
#endif
}
```

```cpp
#include <hip/hip_runtime.h>
#include <hip/hip_cooperative_groups.h>
#include <cstdio>
#include <cstdint>
namespace cg = cooperative_groups;
#ifndef MK_N_LAUNCHES
#define MK_N_LAUNCHES 1
#endif
#ifndef REP_MASK
#define REP_MASK 0
#endif
#define REPS(k) for (int rep_ = 0; rep_ < 1 + ((REP_MASK >> (k)) & 1); ++rep_)
namespace pg8 {
#define PG8_LAS __attribute__((address_space(3)))
typedef unsigned short bf16_t;
typedef short bf16x8 __attribute__((ext_vector_type(8)));
typedef float f32x4 __attribute__((ext_vector_type(4)));
typedef unsigned u32x4 __attribute__((ext_vector_type(4)));
constexpr int BM = 256, BK = 64, HALF = 128, HTB = HALF * BK * 2  , STAGE_BYTES = 8 * HTB, NXCD = 8, WGM = 8;

__host__ __device__ __forceinline__ int lds_byte(int r, int c) { const int st = (r >> 4) * 2 + (c >> 5), rr = r & 15, cc = c & 31, ob = rr * 64 + cc * 2; return st * 1024 + (ob ^ (((ob >> 9) & 1) << 5)); }
__host__ __device__ __forceinline__ void stage_rc(int b, int& R, int& C) { const int st = b / 1024, sb = b % 1024, swz = sb ^ (((sb >> 9) & 1) << 5); R = (st >> 1) * 16 + swz / 64; C = (st & 1) * 32 + (swz % 64) / 2; }
__host__ __device__ __forceinline__ int perm32(int rho) { const int n = rho >> 4, i = rho & 15; return 8 * (i >> 2) + 4 * n + (i & 3); }

struct Unit { int pm, pn; };
struct Gemm { const bf16_t* A; const bf16_t* Bt; int M, N, K; };

struct StaticOrder {
    int nM, nN, nwg, G, c;
    __host__ __device__ void init(int M, int N, int G_, int c_) { nM = M / BM; nN = N / BM; nwg = nM * nN; G = G_; c = c_; }
    __host__ __device__ bool next(int i, Unit& u) const {
        const long L = (long)i * G + c; if (L >= nwg) return false;
        int wgid = (int)L; { const int q = nwg / NXCD, r = nwg % NXCD, xcd = wgid % NXCD, off = wgid / NXCD; wgid = (xcd < r ? xcd * (q + 1) : r * (q + 1) + (xcd - r) * q) + off; }
        const int nig = WGM * nN, gid = wgid / nig, fm = gid * WGM, gsz = (nM - fm) < WGM ? (nM - fm) : WGM;
        u.pm = fm + ((wgid % nig) % gsz); u.pn = (wgid % nig) / gsz; return true;
    }
    __device__ __forceinline__ void a_ready(const Unit&) const {}
    __device__ __forceinline__ void done(const Unit&) const {}
};


template <class Epi, class Sched, bool ALIGN_EPI = false, bool SP2 = false>
__device__ __forceinline__ void gemm_phase(PG8_LAS unsigned char* lds, const Gemm g, const Sched& S, const Epi& E) {
    const int tid = threadIdx.x, wid = __builtin_amdgcn_readfirstlane(tid >> 6), lane = tid & 63, wr = wid >> 2, wc = wid & 3, fr = lane & 15, fq = lane >> 4;
    const int K = g.K, nt = K / BK;
    unsigned voffA[2], voffB[2];
#pragma unroll
    for (int i = 0; i < 2; ++i) { int R, C; stage_rc(tid * 16 + i * 8192, R, C); const int Rb = Epi::PERM ? ((R & ~31) + perm32(R & 31)) : R;
        voffA[i] = (unsigned)(R * K + C) * 2u; voffB[i] = (unsigned)(Rb * K + C) * 2u; }
    const size_t kstep = (size_t)(BK * 2);
    const size_t hstep = (size_t)HALF * K * 2;
    const size_t tstep = 2 * hstep;
    const unsigned ldsw = (unsigned)wid * 1024u;
    const int aoff = lds_byte(wr * 64 + fr, fq * 8), boff = lds_byte(wc * 32 + fr, fq * 8);
#define PG8_SA(b, h) (((b) * 2 + (h)) * HTB)
#define PG8_SB(b, h) ((4 + (b) * 2 + (h)) * HTB)
#define PG8_STAGE(bufoff, gbase, voff) do { _Pragma("unroll") for (int _i = 0; _i < 2; ++_i) \
        __builtin_amdgcn_global_load_lds((const unsigned*)((const char*)(gbase) + (voff)[_i]), (PG8_LAS unsigned*)(lds + (bufoff) + ldsw + _i * 8192), 16, 0, 0); } while (0)
#define PG8_LDA(dst, b, h) do { _Pragma("unroll") for (int m = 0; m < 4; ++m) _Pragma("unroll") for (int k = 0; k < 2; ++k) dst[m][k] = *(const PG8_LAS bf16x8*)(lds + PG8_SA(b, h) + aoff + m * 2048 + k * 1024); } while (0)
#define PG8_LDB(dst, b, h) do { _Pragma("unroll") for (int n = 0; n < 2; ++n) _Pragma("unroll") for (int k = 0; k < 2; ++k) dst[n][k] = *(const PG8_LAS bf16x8*)(lds + PG8_SB(b, h) + boff + n * 2048 + k * 1024); } while (0)
#define PG8_MMA(ai, bj, At, Bt) do { __builtin_amdgcn_s_setprio(1); _Pragma("unroll") for (int m = 0; m < 4; ++m) _Pragma("unroll") for (int n = 0; n < 2; ++n) _Pragma("unroll") for (int k = 0; k < 2; ++k) \
        acc[ai][bj][m][n] = __builtin_amdgcn_mfma_f32_16x16x32_bf16(Bt[n][k], At[m][k], acc[ai][bj][m][n], 0, 0, 0); __builtin_amdgcn_s_setprio(0); } while (0)
#define PG8_WAIT_V(n) asm volatile("s_waitcnt vmcnt(" #n ")" ::: "memory")
#define PG8_WAIT_L(n) asm volatile("s_waitcnt lgkmcnt(" #n ")" ::: "memory")
#define PG8_BAR __builtin_amdgcn_s_barrier()
#define PG8_SCHED __builtin_amdgcn_sched_barrier(0)
    Unit cur, nxt; int ui = 0;
    if (!S.next(0, cur)) return;
    f32x4 acc[2][2][4][2];
#pragma unroll
    for (int a = 0; a < 2; ++a)
#pragma unroll
        for (int b = 0; b < 2; ++b)
#pragma unroll
            for (int m = 0; m < 4; ++m)
#pragma unroll
                for (int n = 0; n < 2; ++n) acc[a][b][m][n] = (f32x4){0.f, 0.f, 0.f, 0.f};
    bf16x8 At[4][2], B0[2][2], B1[2][2];
    const char* cA = (const char*)g.A + (size_t)cur.pm * tstep; const char* cB = (const char*)g.Bt + (size_t)cur.pn * tstep;
    S.a_ready(cur);
    if constexpr (SP2) {
        PG8_STAGE(PG8_SB(0, 0), cB, voffB); PG8_STAGE(PG8_SB(0, 1), cB + hstep, voffB); PG8_STAGE(PG8_SA(0, 0), cA, voffA); PG8_STAGE(PG8_SA(0, 1), cA + hstep, voffA);
        if (wr == 1) PG8_BAR;
        PG8_WAIT_V(2); PG8_BAR;
        PG8_STAGE(PG8_SB(1, 0), cB + kstep, voffB); PG8_STAGE(PG8_SA(1, 0), cA + kstep, voffA); PG8_STAGE(PG8_SB(1, 1), cB + hstep + kstep, voffB);
        PG8_WAIT_V(6); PG8_BAR;
    } else {
        PG8_STAGE(PG8_SB(0, 0), cB, voffB); PG8_STAGE(PG8_SA(0, 0), cA, voffA); PG8_STAGE(PG8_SB(0, 1), cB + hstep, voffB); PG8_STAGE(PG8_SA(0, 1), cA + hstep, voffA);
        if (wr == 1) PG8_BAR;
        PG8_WAIT_V(4); PG8_BAR;
        PG8_STAGE(PG8_SB(1, 0), cB + kstep, voffB); PG8_STAGE(PG8_SA(1, 0), cA + kstep, voffA); PG8_STAGE(PG8_SB(1, 1), cB + hstep + kstep, voffB);
        PG8_WAIT_V(6); PG8_BAR;
    }
    for (;;) {
        const bool has_next = S.next(ui + 1, nxt);
        const char* nA = has_next ? (const char*)g.A + (size_t)nxt.pm * tstep : cA; const char* nB = has_next ? (const char*)g.Bt + (size_t)nxt.pn * tstep : cB;
        for (int t = 0; t < nt; t += 2) {
            const bool last = (t == nt - 2);
            const char* a1 = cA + (size_t)(t + 1) * kstep;
            const char* a2 = last ? nA : cA + (size_t)(t + 2) * kstep; const char* b2 = last ? nB : cB + (size_t)(t + 2) * kstep;
            const char* a3 = a2 + kstep; const char* b3 = b2 + kstep;
            if (last && has_next) S.a_ready(nxt);
            if constexpr (SP2) {
            PG8_LDB(B0, 0, 0); PG8_LDB(B1, 0, 1); PG8_SCHED; PG8_LDA(At, 0, 0); PG8_STAGE(PG8_SA(1, 1), a1 + hstep, voffA);
            PG8_WAIT_V(8); PG8_WAIT_L(0); PG8_BAR; PG8_MMA(0, 0, At, B0); PG8_MMA(0, 1, At, B1); PG8_BAR; PG8_SCHED;
            PG8_LDA(At, 0, 1); PG8_STAGE(PG8_SB(0, 0), b2, voffB); PG8_STAGE(PG8_SB(0, 1), b2 + hstep, voffB); PG8_STAGE(PG8_SA(0, 0), a2, voffA);
            PG8_WAIT_V(8); PG8_WAIT_L(0); PG8_BAR; PG8_MMA(1, 0, At, B0); PG8_MMA(1, 1, At, B1); PG8_BAR; PG8_SCHED;
            PG8_LDB(B0, 1, 0); PG8_LDB(B1, 1, 1); PG8_SCHED; PG8_LDA(At, 1, 0); PG8_STAGE(PG8_SA(0, 1), a2 + hstep, voffA);
            PG8_WAIT_V(8); PG8_WAIT_L(0); PG8_BAR; PG8_MMA(0, 0, At, B0); PG8_MMA(0, 1, At, B1); PG8_BAR; PG8_SCHED;
            PG8_LDA(At, 1, 1); PG8_STAGE(PG8_SB(1, 0), b3, voffB); PG8_STAGE(PG8_SB(1, 1), b3 + hstep, voffB); PG8_STAGE(PG8_SA(1, 0), a3, voffA);
            PG8_WAIT_V(8); PG8_WAIT_L(0); PG8_BAR; PG8_MMA(1, 0, At, B0); PG8_MMA(1, 1, At, B1); PG8_BAR; PG8_SCHED;
            } else {
            PG8_LDB(B0, 0, 0); PG8_SCHED; PG8_LDA(At, 0, 0); PG8_STAGE(PG8_SA(1, 1), a1 + hstep, voffA);
            PG8_WAIT_L(8); PG8_BAR; PG8_WAIT_L(0); PG8_MMA(0, 0, At, B0); PG8_BAR; PG8_SCHED;
            PG8_LDB(B1, 0, 1); PG8_STAGE(PG8_SB(0, 0), b2, voffB);
            PG8_BAR; PG8_WAIT_L(0); PG8_MMA(0, 1, At, B1); PG8_BAR;
            PG8_LDA(At, 0, 1); PG8_STAGE(PG8_SA(0, 0), a2, voffA);
            PG8_BAR; PG8_WAIT_L(0); PG8_MMA(1, 0, At, B0); PG8_BAR; PG8_SCHED;
            PG8_STAGE(PG8_SB(0, 1), b2 + hstep, voffB);
            PG8_WAIT_V(6); PG8_BAR; PG8_MMA(1, 1, At, B1); PG8_BAR;
            PG8_LDB(B0, 1, 0); PG8_SCHED; PG8_LDA(At, 1, 0); PG8_STAGE(PG8_SA(0, 1), a2 + hstep, voffA);
            PG8_WAIT_L(8); PG8_BAR; PG8_WAIT_L(0); PG8_MMA(0, 0, At, B0); PG8_BAR; PG8_SCHED;
            PG8_LDB(B1, 1, 1); PG8_STAGE(PG8_SB(1, 0), b3, voffB);
            PG8_BAR; PG8_WAIT_L(0); PG8_MMA(0, 1, At, B1); PG8_BAR;
            PG8_LDA(At, 1, 1); PG8_STAGE(PG8_SA(1, 0), a3, voffA);
            PG8_BAR; PG8_WAIT_L(0); PG8_MMA(1, 0, At, B0); PG8_BAR; PG8_SCHED;
            PG8_STAGE(PG8_SB(1, 1), b3 + hstep, voffB);
            PG8_WAIT_V(6); PG8_BAR; PG8_MMA(1, 1, At, B1); PG8_BAR;
            }
        }
        if constexpr (ALIGN_EPI) { if (wr == 0) PG8_BAR; }
        if constexpr (!Epi::AFTER_DRAIN) { E(acc, cur, wr, wc, fr, fq); S.done(cur); }
        if (!has_next) break;
#pragma unroll
        for (int a = 0; a < 2; ++a)
#pragma unroll
            for (int b = 0; b < 2; ++b)
#pragma unroll
                for (int m = 0; m < 4; ++m)
#pragma unroll
                    for (int n = 0; n < 2; ++n) acc[a][b][m][n] = (f32x4){0.f, 0.f, 0.f, 0.f};
        cur = nxt; cA = nA; cB = nB; ++ui;
        if constexpr (ALIGN_EPI) { if (wr == 1) PG8_BAR; }
    }
    PG8_WAIT_V(0);
    if constexpr (!ALIGN_EPI) { if (wr == 0) PG8_BAR; }
    PG8_BAR;
    if constexpr (Epi::AFTER_DRAIN) { E.fused(acc, cur, wr, wc, fr, fq, lds, wid, lane); S.done(cur); }
#undef PG8_SA
#undef PG8_SB
#undef PG8_STAGE
#undef PG8_LDA
#undef PG8_LDB
#undef PG8_MMA
#undef PG8_WAIT_V
#undef PG8_WAIT_L
#undef PG8_BAR
#undef PG8_SCHED
}
}
using pg8::bf16_t; using pg8::bf16x8; using pg8::f32x4; using pg8::u32x4; using pg8::Unit;
typedef short s16x4 __attribute__((ext_vector_type(4)));
typedef unsigned u32x2 __attribute__((ext_vector_type(2)));
#define LAS __attribute__((address_space(3)))
constexpr int MP = 16384, MSAMP = 128, MT = MP + MSAMP, MPAD = 16640, DM = 1024, SEQ = 4096, DFF = 2816;
constexpr float EPS = 1e-6f, LOG2E = 1.4426950408889634f;
constexpr float QSCALE = 0.125f * LOG2E;
constexpr float CQSCALE = 0.08838834764831845f * LOG2E;
constexpr float HQSCALE = 0.08838834764831845f;
constexpr size_t O_Y = 0, O_WKP = 16908288, O_WVP = 21102592, O_HSP = 25296896, O_FCP = 25559040, O_MKP = 25581568, O_MVP = 26105856,
                 O_WKS = 26630144, O_WVS = 26695680, O_HSS = 26761216, O_FCS = 28858368;
constexpr size_t MiB = 1u << 20;
constexpr size_t WS_WIN = 0, WS_WOUT = 7 * MiB, WS_WCQ = 9 * MiB, WS_WCKV = 10 * MiB, WS_WCO = 12 * MiB, WS_WGU = 13 * MiB, WS_WD = 24 * MiB,
                 WS_LB = 30 * MiB, WS_SS1 = WS_LB + 4096, WS_SS2 = WS_SS1 + 256 * 1024, WS_XN = 32 * MiB, WS_CQ = 65 * MiB, WS_CO = 82 * MiB,
                 WS_MKB = 99 * MiB, WS_MVB = 100 * MiB, WS_MN = 101 * MiB,
                 WS_QB = 104 * MiB, WS_KB = 121 * MiB, WS_VB = 138 * MiB, WS_QH = 155 * MiB, WS_VH = 172 * MiB, WS_GH = 189 * MiB, WS_LF = 206 * MiB,
                 WS_VT = 239 * MiB, WS_KV = 255 * MiB, WS_SP = 319 * MiB, WS_MIX = 351 * MiB,
                 WS_UG = 104 * MiB, WS_UP = 194 * MiB, WS_ACT = 284 * MiB;
constexpr size_t WS_SS3 = 30 * MiB + 600 * 1024, WS_CNT = 30 * MiB + 800 * 1024, WS_BAR = 31 * MiB, WS_EDGE = 375 * MiB, WS_PART = 377 * MiB, WS_UPV = 379 * MiB, WS_UGS = 381 * MiB, WS_UPS = 382 * MiB;
constexpr int LDS_BYTES = 147456, LDS_BARST = 147456 - 64;

struct Args { const float* in[28]; float* out; unsigned char* ws; int ph_lo, ph_hi; };

typedef float f32x2_t __attribute__((ext_vector_type(2))); typedef __bf16 bf16x2_t __attribute__((ext_vector_type(2)));
__device__ __forceinline__ unsigned pk2(float lo, float hi) { unsigned r; asm volatile("v_cvt_pk_bf16_f32 %0, %1, %2" : "=v"(r) : "v"(lo), "v"(hi)); return r; }
__device__ __forceinline__ unsigned pk2m(float lo, float hi) { const f32x2_t v = {lo, hi}; const bf16x2_t b = __builtin_convertvector(v, bf16x2_t); return __builtin_bit_cast(unsigned, b); }
__device__ __forceinline__ float bflo(unsigned w) { return __uint_as_float(w << 16); }
__device__ __forceinline__ float bfhi(unsigned w) { return __uint_as_float(w & 0xffff0000u); }
__device__ __forceinline__ float bf1(bf16_t h) { return __uint_as_float((unsigned)h << 16); }
__device__ __forceinline__ void store_bf16x8(bf16_t* p, f32x4 a, f32x4 b) { u32x4 w; w.x = pk2(a[0], a[1]); w.y = pk2(a[2], a[3]); w.z = pk2(b[0], b[1]); w.w = pk2(b[2], b[3]); *(u32x4*)p = w; }
__device__ __forceinline__ float wave_sum(float v) {
#pragma unroll
    for (int o = 1; o < 64; o <<= 1) v += __shfl_xor(v, o);
    return v;
}
__device__ __forceinline__ float wave_max(float v) {
#pragma unroll
    for (int o = 1; o < 64; o <<= 1) v = fmaxf(v, __shfl_xor(v, o));
    return v;
}
__device__ __forceinline__ float xg_max(float x) {
    auto s = __builtin_amdgcn_permlane16_swap(__float_as_uint(x), __float_as_uint(x), false, false); x = fmaxf(__uint_as_float(s[0]), __uint_as_float(s[1]));
    auto u = __builtin_amdgcn_permlane32_swap(__float_as_uint(x), __float_as_uint(x), false, false); return fmaxf(__uint_as_float(u[0]), __uint_as_float(u[1]));
}
__device__ __forceinline__ float xg_sum(float x) {
    auto s = __builtin_amdgcn_permlane16_swap(__float_as_uint(x), __float_as_uint(x), false, false); x = __uint_as_float(s[0]) + __uint_as_float(s[1]);
    auto u = __builtin_amdgcn_permlane32_swap(__float_as_uint(x), __float_as_uint(x), false, false); return __uint_as_float(u[0]) + __uint_as_float(u[1]);
}
__device__ __forceinline__ float silu_f(float x) { return x * __builtin_amdgcn_rcpf(1.f + __expf(-x)); }
__device__ __forceinline__ float ex2(float x) { return __builtin_amdgcn_exp2f(x); }

#define EPI_ROWS_BEGIN  _Pragma("unroll") for (int ai = 0; ai < 2; ++ai) _Pragma("unroll") for (int m = 0; m < 4; ++m) { const int row = u.pm * 256 + ai * 128 + wr * 64 + m * 16 + fr;
#define EPI_ROWS_END }

struct EpiIn {
    static constexpr bool PERM = true, AFTER_DRAIN = false;
    bf16_t *Qb, *Kb, *Vb, *QH, *VH, *GH, *VT; float* LF; const float* LB; float* out;
    __device__ __forceinline__ void operator()(const f32x4 (&acc)[2][2][4][2], const Unit& u, int wr, int wc, int fr, int fq) const {
        const int grp = u.pn >> 1;
        EPI_ROWS_BEGIN
            if (row >= MT) continue;
#pragma unroll
            for (int bj = 0; bj < 2; ++bj) {
                const int cc = (u.pn & 1) * 256 + bj * 128 + wc * 32 + 8 * fq;
                f32x4 v0 = acc[ai][bj][m][0], v1 = acc[ai][bj][m][1];
                const size_t o = (size_t)row * 512 + cc;
                if (grp == 0) { store_bf16x8(Qb + o, v0 * QSCALE, v1 * QSCALE); }
                else if (grp == 1 || grp == 2) {
                    store_bf16x8((grp == 1 ? Kb : Vb) + o, v0, v1);
                    float* dst = nullptr;
                    if (row >= MP) dst = out + (grp == 1 ? O_WKS : O_WVS) + (size_t)(row - MP) * 512 + cc;
                    else { const int t = row & 4095, b = row >> 12; if (t >= 2048) dst = out + (grp == 1 ? O_WKP : O_WVP) + (size_t)(b * 2048 + t - 2048) * 512 + cc; }
                    if (dst) { *(f32x4*)dst = v0; *(f32x4*)(dst + 4) = v1; }
                } else if (grp == 3) {
#pragma unroll
                    for (int j = 0; j < 4; ++j) { v0[j] = silu_f(v0[j]) * HQSCALE; v1[j] = silu_f(v1[j]) * HQSCALE; }
                    store_bf16x8(QH + o, v0, v1);
                } else if (grp == 4) {
                    const f32x4 l0 = *(const f32x4*)(LB + cc), l1 = *(const f32x4*)(LB + cc + 4);
#pragma unroll
                    for (int j = 0; j < 4; ++j) { v0[j] = __logf(l0[j] + (1.f - l0[j]) * __builtin_amdgcn_rcpf(1.f + __expf(-v0[j]))); v1[j] = __logf(l1[j] + (1.f - l1[j]) * __builtin_amdgcn_rcpf(1.f + __expf(-v1[j]))); }
                    *(f32x4*)(LF + o) = v0; *(f32x4*)(LF + o + 4) = v1;
                } else if (grp == 5) {
                    store_bf16x8(VH + o, v0, v1);
                    if (row < MP) { const int t = row & 4095, b = row >> 12; bf16_t* vt = VT + (size_t)(b * 512 + cc) * 4096 + t;
#pragma unroll
                        for (int j = 0; j < 4; ++j) { vt[(size_t)j * 4096] = (bf16_t)(pk2(v0[j], 0.f) & 0xffffu); vt[(size_t)(j + 4) * 4096] = (bf16_t)(pk2(v1[j], 0.f) & 0xffffu); } }
                } else { store_bf16x8(GH + o, v0, v1); }
            }
        EPI_ROWS_END
    }
};

struct EpiMem {
    static constexpr bool PERM = true, AFTER_DRAIN = false;
    bf16_t *MKB, *MVB; float* out;
    __device__ __forceinline__ void operator()(const f32x4 (&acc)[2][2][4][2], const Unit& u, int wr, int wc, int fr, int fq) const {
        const bool isv = u.pn >= 2;
        EPI_ROWS_BEGIN
#pragma unroll
            for (int bj = 0; bj < 2; ++bj) {
                const int cc = (u.pn & 1) * 256 + bj * 128 + wc * 32 + 8 * fq;
                const f32x4 v0 = acc[ai][bj][m][0], v1 = acc[ai][bj][m][1];
                const size_t o = (size_t)row * 512 + cc;
                store_bf16x8((isv ? MVB : MKB) + o, v0, v1);
                float* dst = out + (isv ? O_MVP : O_MKP) + o; *(f32x4*)dst = v0; *(f32x4*)(dst + 4) = v1;
            }
        EPI_ROWS_END
    }
};

template <int MODE> struct EpiRes {
    static constexpr bool PERM = true, AFTER_DRAIN = false;
    const float* xin; float* out; bf16_t* XN; unsigned long long* ss;
    __device__ __forceinline__ void operator()(const f32x4 (&acc)[2][2][4][2], const Unit& u, int wr, int wc, int fr, int fq) const {
        EPI_ROWS_BEGIN
            float sq = 0.f;
#pragma unroll
            for (int bj = 0; bj < 2; ++bj) {
                const int col = u.pn * 256 + bj * 128 + wc * 32 + 8 * fq;
                f32x4 v0 = acc[ai][bj][m][0], v1 = acc[ai][bj][m][1];
                const size_t o = (size_t)row * DM + col;
                if (MODE == 0) { v0 += *(const f32x4*)(xin + o); v1 += *(const f32x4*)(xin + o + 4); }
                else { const u32x4 w = *(const u32x4*)(XN + o); v0 += (f32x4){bflo(w.x), bfhi(w.x), bflo(w.y), bfhi(w.y)}; v1 += (f32x4){bflo(w.z), bfhi(w.z), bflo(w.w), bfhi(w.w)}; }
                if (MODE == 2) { store_bf16x8(XN + o, v0, v1); }
                else { store_bf16x8(XN + o, v0, v1);
                    sq += (v0[0] * v0[0] + v0[1] * v0[1]) + (v0[2] * v0[2] + v0[3] * v0[3]) + (v1[0] * v1[0] + v1[1] * v1[1]) + (v1[2] * v1[2] + v1[3] * v1[3]); }
            }
            if (MODE != 2) { sq = xg_sum(sq); if (fq == 0) atomicAdd(ss + row, (unsigned long long)(sq * 16777216.f)); }
        EPI_ROWS_END
    }
};
struct EpiFinal {
    static constexpr bool PERM = true, AFTER_DRAIN = false;
    const bf16_t* XN; unsigned long long* ss3; unsigned* cnt; const float* g; float* out;
    __device__ __forceinline__ void operator()(const f32x4 (&acc_)[2][2][4][2], const Unit& u, int wr, int wc, int fr, int fq) const {
        f32x4 (&x)[2][2][4][2] = const_cast<f32x4 (&)[2][2][4][2]>(acc_);
        EPI_ROWS_BEGIN
            float sq = 0.f;
#pragma unroll
            for (int bj = 0; bj < 2; ++bj) {
                const int col = u.pn * 256 + bj * 128 + wc * 32 + 8 * fq;
                const u32x4 w = *(const u32x4*)(XN + ((unsigned)row * (unsigned)DM + (unsigned)col));
                f32x4 v0 = x[ai][bj][m][0] + (f32x4){bflo(w.x), bfhi(w.x), bflo(w.y), bfhi(w.y)}, v1 = x[ai][bj][m][1] + (f32x4){bflo(w.z), bfhi(w.z), bflo(w.w), bfhi(w.w)};
                x[ai][bj][m][0] = v0; x[ai][bj][m][1] = v1;
                sq += (v0[0] * v0[0] + v0[1] * v0[1]) + (v0[2] * v0[2] + v0[3] * v0[3]) + (v1[0] * v1[0] + v1[1] * v1[1]) + (v1[2] * v1[2] + v1[3] * v1[3]);
            }
            sq = xg_sum(sq);
            if (fq == 0) (void)__hip_atomic_fetch_add(ss3 + row, (unsigned long long)(sq * 16777216.f), __ATOMIC_RELAXED, __HIP_MEMORY_SCOPE_AGENT);
        EPI_ROWS_END
        asm volatile("s_waitcnt vmcnt(0) lgkmcnt(0)" ::: "memory"); __builtin_amdgcn_s_barrier(); asm volatile("" ::: "memory");
        if (threadIdx.x == 0) {
            unsigned* c = cnt + 64 * u.pm;
            (void)__hip_atomic_fetch_add(c, 1u, __ATOMIC_RELAXED, __HIP_MEMORY_SCOPE_AGENT);
            unsigned spins = 0;
            while (__hip_atomic_load(c, __ATOMIC_RELAXED, __HIP_MEMORY_SCOPE_AGENT) < 4u && ++spins < (1u << 22)) __builtin_amdgcn_s_sleep(2);
        }
        asm volatile("s_waitcnt vmcnt(0) lgkmcnt(0)" ::: "memory"); __builtin_amdgcn_s_barrier(); asm volatile("" ::: "memory");
        EPI_ROWS_BEGIN
            const unsigned long long sv = __hip_atomic_load(ss3 + row, __ATOMIC_RELAXED, __HIP_MEMORY_SCOPE_AGENT);
            const float r = rsqrtf((float)sv * (1.f / (16777216.f * DM)) + EPS);
#pragma unroll
            for (int bj = 0; bj < 2; ++bj) {
                const int col = u.pn * 256 + bj * 128 + wc * 32 + 8 * fq;
                const f32x4 g0 = *(const f32x4*)(g + col), g1 = *(const f32x4*)(g + col + 4);
                float* op = out + ((unsigned)row * (unsigned)DM + (unsigned)col);
                *(f32x4*)op = x[ai][bj][m][0] * r * g0; *(f32x4*)(op + 4) = x[ai][bj][m][1] * r * g1;
            }
        EPI_ROWS_END
    }
};
template <int MODE> __device__ __forceinline__ void mini_gemm_res(LAS unsigned char* lds, const bf16_t* A, const bf16_t* Bt, int K, const float* xin_s, float* out, bf16_t* XN, unsigned long long* ss, int tid, unsigned* cnt = nullptr, const float* gfin = nullptr) {
    const int bx = blockIdx.x, rg = bx & 7, cgp = bx >> 3, wave = tid >> 6, lane = tid & 63, lr = lane & 15, lg = lane >> 4;
    const int kw = K >> 3, k0 = wave * kw;
    const bf16_t* ap = A + (size_t)(MP + 16 * rg + lr) * K + k0 + lg * 8;
    const bf16_t* bp0 = Bt + (size_t)(32 * cgp + lr) * K + k0 + lg * 8; const bf16_t* bp1 = bp0 + (size_t)16 * K;
    f32x4 a0 = {0.f, 0.f, 0.f, 0.f}, a1 = a0;
#pragma unroll 11
    for (int ks = 0; ks < kw; ks += 32) { const bf16x8 af = *(const bf16x8*)(ap + ks);
        a0 = __builtin_amdgcn_mfma_f32_16x16x32_bf16(af, *(const bf16x8*)(bp0 + ks), a0, 0, 0, 0);
        a1 = __builtin_amdgcn_mfma_f32_16x16x32_bf16(af, *(const bf16x8*)(bp1 + ks), a1, 0, 0, 0); }
    LAS float* red = (LAS float*)lds;
    __syncthreads();
#pragma unroll
    for (int j = 0; j < 4; ++j) { red[(wave * 16 + lg * 4 + j) * 32 + lr] = a0[j]; red[(wave * 16 + lg * 4 + j) * 32 + 16 + lr] = a1[j]; }
    __syncthreads();
    const int m = tid >> 5, n = tid & 31;
    float v = 0.f;
#pragma unroll
    for (int w = 0; w < 8; ++w) v += red[(w * 16 + m) * 32 + n];
    const int row = MP + 16 * rg + m, col = 32 * cgp + n; const size_t o = (size_t)row * DM + col;
    if (MODE == 0) v += xin_s[(size_t)(row - MP) * DM + col]; else v += bf1(XN[o]);
    if (MODE != 2) XN[o] = (bf16_t)(pk2(v, 0.f) & 0xffffu);
    float sq = v * v;
#pragma unroll
    for (int s = 1; s < 32; s <<= 1) sq += __shfl_xor(sq, s);
    if (n == 0) (void)__hip_atomic_fetch_add(ss + row, (unsigned long long)(sq * 16777216.f), __ATOMIC_RELAXED, __HIP_MEMORY_SCOPE_AGENT);
    if (MODE == 2) {
        asm volatile("s_waitcnt vmcnt(0) lgkmcnt(0)" ::: "memory"); __syncthreads();
        if (tid == 0) { unsigned* c = cnt + 64 * (64 + rg); (void)__hip_atomic_fetch_add(c, 1u, __ATOMIC_RELAXED, __HIP_MEMORY_SCOPE_AGENT);
            unsigned spins = 0; while (__hip_atomic_load(c, __ATOMIC_RELAXED, __HIP_MEMORY_SCOPE_AGENT) < 32u && ++spins < (1u << 22)) __builtin_amdgcn_s_sleep(2); }
        __syncthreads();
        const unsigned long long sv = __hip_atomic_load(ss + row, __ATOMIC_RELAXED, __HIP_MEMORY_SCOPE_AGENT);
        out[o] = v * rsqrtf((float)sv * (1.f / (16777216.f * DM)) + EPS) * gfin[col];
    }
    __syncthreads();
}
template <int MODE> struct EpiRS {
    static constexpr bool PERM = true, AFTER_DRAIN = false;
    const unsigned long long* ss; bf16_t* O0; bf16_t* O1; float* out; float scale;
    __device__ __forceinline__ void operator()(const f32x4 (&acc)[2][2][4][2], const Unit& u, int wr, int wc, int fr, int fq) const {
        EPI_ROWS_BEGIN
            const float rs = rsqrtf((float)ss[row] * (1.f / (16777216.f * DM)) + EPS) * scale;
#pragma unroll
            for (int bj = 0; bj < 2; ++bj) {
                const int col = u.pn * 256 + bj * 128 + wc * 32 + 8 * fq;
                const f32x4 v0 = acc[ai][bj][m][0] * rs, v1 = acc[ai][bj][m][1] * rs;
                if (MODE == 0) store_bf16x8(O0 + (size_t)row * 512 + col, v0, v1);
                else {
                    const bool up = u.pn >= 11; const int c2 = up ? col - DFF : col;
                    store_bf16x8((up ? O1 : O0) + (size_t)row * DFF + c2, v0, v1);
                    if (!up) { float* dst = nullptr;
                        if (row < MP) { const int t = row & 4095; if (t >= 4094) dst = out + O_FCP + (size_t)((row >> 12) * 2 + t - 4094) * DFF + c2; }
                        else if (row < MT) { const int t = (row - MP) & 3; if (t >= 2) dst = out + O_FCS + (size_t)(((row - MP) >> 2) * 2 + t - 2) * DFF + c2; }
                        if (dst) { *(f32x4*)dst = v0; *(f32x4*)(dst + 4) = v1; } }
                }
            }
        EPI_ROWS_END
    }
};
struct EpiGU {
    static constexpr bool PERM = true, AFTER_DRAIN = false;
    const unsigned long long* ss; bf16_t* ACT; const float* cst; float* EDGE; float* PART; float* UPV; const float* cw; const float* cb; float* out; LAS unsigned char* xl;
    __device__ __forceinline__ void operator()(const f32x4 (&acc)[2][2][4][2], const Unit& u, int wr, int wc, int fr, int fq) const {
        const int c0 = u.pn * 128 + wc * 32 + 8 * fq;
        if (u.pm == 64) {
            const int lane = threadIdx.x & 63, i1 = (lane - 1) * 4, i2 = (lane - 2) * 4, t = fr & 3;
            f32x4 wv[2][4];
#pragma unroll
            for (int n = 0; n < 2; ++n) { wv[n][0] = *(const f32x4*)(cw + c0 + 4 * n); wv[n][1] = *(const f32x4*)(cw + DFF + c0 + 4 * n); wv[n][2] = *(const f32x4*)(cw + 2 * DFF + c0 + 4 * n); wv[n][3] = *(const f32x4*)(cb + c0 + 4 * n); }
#pragma unroll
            for (int m = 0; m < 4; ++m) {
                const int sr = wr * 64 + m * 16 + fr, b = sr >> 2;
                const float rs = rsqrtf((float)ss[(unsigned)(MP + sr)] * (1.f / (16777216.f * DM)) + EPS);
                u32x4 q;
#pragma unroll
                for (int n = 0; n < 2; ++n) {
                    const f32x4 cur = acc[0][0][m][n] * rs, upv = acc[0][1][m][n] * rs;
                    f32x4 x1, x2;
#pragma unroll
                    for (int c = 0; c < 4; ++c) { x1[c] = __int_as_float(__builtin_amdgcn_ds_bpermute(i1, __float_as_int(cur[c]))); x2[c] = __int_as_float(__builtin_amdgcn_ds_bpermute(i2, __float_as_int(cur[c]))); }
                    if (t < 1) x1 = *(const f32x4*)(cst + (unsigned)((b * 2 + 1) * DFF + c0 + 4 * n));
                    if (t < 2) x2 = *(const f32x4*)(cst + (unsigned)((b * 2 + t) * DFF + c0 + 4 * n));
                    f32x4 r;
#pragma unroll
                    for (int c = 0; c < 4; ++c) r[c] = silu_f(wv[n][3][c] + wv[n][0][c] * x2[c] + wv[n][1][c] * x1[c] + wv[n][2][c] * cur[c]) * upv[c];
                    if (n == 0) { q.x = pk2(r[0], r[1]); q.y = pk2(r[2], r[3]); } else { q.z = pk2(r[0], r[1]); q.w = pk2(r[2], r[3]); }
                    if (t >= 2) *(f32x4*)(out + O_FCS + (unsigned)(((sr >> 2) * 2 + t - 2) * DFF + c0 + 4 * n)) = cur;
                }
                *(u32x4*)(ACT + ((unsigned)(MP + sr) * (unsigned)DFF + (unsigned)c0)) = q;
            }
            return;
        }
        const int lane = threadIdx.x & 63;
        float rsv[2][4];
#pragma unroll
        for (int ai = 0; ai < 2; ++ai)
#pragma unroll
            for (int m = 0; m < 4; ++m) rsv[ai][m] = rsqrtf((float)ss[(unsigned)(u.pm * 256 + ai * 128 + wr * 64 + m * 16 + fr)] * (1.f / (16777216.f * DM)) + EPS);
        LAS float* ex = (LAS float*)xl;
#pragma unroll
        for (int ai = 0; ai < 2; ++ai) { const float rs = rsv[ai][3];
            if (fr >= 14) { LAS float* d = ex + (((wr * 4 + wc) * 2 + ai) * 2 + (fr - 14)) * 32 + 8 * fq; const f32x4 a0 = acc[ai][0][3][0] * rs, a1 = acc[ai][0][3][1] * rs;
                d[0] = a0[0]; d[1] = a0[1]; d[2] = a0[2]; d[3] = a0[3]; d[4] = a1[0]; d[5] = a1[1]; d[6] = a1[2]; d[7] = a1[3];
                if (ai == 1 && wr == 1) { float* e = EDGE + (unsigned)((u.pm * 2 + (fr - 14)) * DFF + c0); *(f32x4*)e = a0; *(f32x4*)(e + 4) = a1;
                    if ((u.pm & 15) == 15) { float* dst = out + O_FCP + (unsigned)(((u.pm >> 4) * 2 + fr - 14) * DFF + c0); *(f32x4*)dst = a0; *(f32x4*)(dst + 4) = a1; } } } }
        asm volatile("s_waitcnt lgkmcnt(0)" ::: "memory"); __builtin_amdgcn_s_barrier(); asm volatile("" ::: "memory");
        const int i1 = (fr >= 1 ? lane - 1 : lane + 15) * 4, i2 = (fr >= 2 ? lane - 2 : lane + 14) * 4;
        u32x2 stash[2][4];
#pragma unroll
        for (int n = 0; n < 2; ++n) {
            const int cn = c0 + 4 * n;
            const f32x4 w0 = *(const f32x4*)(cw + cn), w1 = *(const f32x4*)(cw + DFF + cn), w2 = *(const f32x4*)(cw + 2 * DFF + cn), bb = *(const f32x4*)(cb + cn);
#pragma unroll
            for (int ai = 0; ai < 2; ++ai) {
                const int swr = wr ^ 1, sai = (ai == 1 && wr == 1) ? 1 : 0;
                f32x4 prev = *(const LAS f32x4*)(ex + (((swr * 4 + wc) * 2 + sai) * 2 + (fr & 1)) * 32 + 8 * fq + 4 * n);
#pragma unroll
                for (int m = 0; m < 4; ++m) {
                    const int row = u.pm * 256 + ai * 128 + wr * 64 + m * 16 + fr;
                    const float rs = rsv[ai][m];
                    const f32x4 cur = acc[ai][0][m][n] * rs, upv = acc[ai][1][m][n] * rs;
                    f32x4 r;
                    const bool first = (ai == 0 && wr == 0 && m == 0);
#pragma unroll
                    for (int c = 0; c < 4; ++c) {
                        const float g1 = __int_as_float(__builtin_amdgcn_ds_bpermute(i1, __float_as_int(fr == 15 ? prev[c] : cur[c])));
                        const float g2 = __int_as_float(__builtin_amdgcn_ds_bpermute(i2, __float_as_int(fr >= 14 ? prev[c] : cur[c])));
                        if (first && fr < 2) { PART[(unsigned)((u.pm * 2 + fr) * DFF + cn + c)] = bb[c] + w2[c] * cur[c] + (fr == 1 ? w1[c] * g1 : 0.f); UPV[(unsigned)((u.pm * 2 + fr) * DFF + cn + c)] = upv[c]; }
                        r[c] = silu_f(bb[c] + w0[c] * g2 + w1[c] * g1 + w2[c] * cur[c]) * upv[c];
                    }
                    { u32x2 w; w.x = pk2(r[0], r[1]); w.y = pk2(r[2], r[3]);
                      if (n == 0) stash[ai][m] = w;
                      else if (!(first && fr < 2)) { u32x4 q; q.x = stash[ai][m].x; q.y = stash[ai][m].y; q.z = w.x; q.w = w.y; *(u32x4*)(ACT + ((unsigned)row * (unsigned)DFF + (unsigned)c0)) = q; } }
                    prev = cur;
                }
            }
        }
    }
};
__device__ __forceinline__ void ffn_fixup_local(const Args& a, int pm, int tid) {
    unsigned char* ws = a.ws;
    const float* EDGE = (const float*)(ws + WS_EDGE); const float* PART = (const float*)(ws + WS_PART); const float* UPV = (const float*)(ws + WS_UPV); bf16_t* ACT = (bf16_t*)(ws + WS_ACT);
    const float* cw = a.in[24];
    float part[11], upv[11], gm1[11], gm2[11], c0v[11], c1v[11];
#pragma unroll
    for (int j = 0; j < 11; ++j) { const int i = tid + 512 * j, fr = i >= DFF ? 1 : 0, c = i - fr * DFF; const unsigned rr = (unsigned)((pm * 2 + fr) * DFF + c);
        part[j] = PART[rr]; upv[j] = UPV[rr]; c0v[j] = cw[c]; c1v[j] = cw[DFF + c];
        gm1[j] = (pm & 15) ? EDGE[(unsigned)(((pm - 1) * 2 + 1) * DFF + c)] : 0.f; gm2[j] = (pm & 15) ? EDGE[(unsigned)(((pm - 1) * 2) * DFF + c)] : 0.f; }
#pragma unroll
    for (int j = 0; j < 11; ++j) { const int i = tid + 512 * j, fr = i >= DFF ? 1 : 0, c = i - fr * DFF;
        const float conv = part[j] + (fr == 0 ? c1v[j] * gm1[j] + c0v[j] * gm2[j] : c0v[j] * gm1[j]);
        ACT[(unsigned)((pm * 256 + fr) * DFF + c)] = (bf16_t)(pk2(silu_f(conv) * upv[j], 0.f) & 0xffffu); }
    asm volatile("s_waitcnt vmcnt(0)" ::: "memory");
    __syncthreads();
}
__device__ __forceinline__ void p0_transpose_item(const float* W, int K, int N, const float* gk, bf16_t* WT, int row_off, LAS float* scr, int item, int lane, bool il = false) {
    const int nblk = N / 32, kb = item / nblk, nb = item % nblk, k0 = 64 * kb, n0 = 32 * nb;
    { const int kq = lane >> 3, n4 = (lane & 7) * 4; f32x4 v[8]; float g[8];
#pragma unroll
      for (int i = 0; i < 8; ++i) { v[i] = *(const f32x4*)(W + (size_t)(k0 + kq + 8 * i) * N + n0 + n4); g[i] = gk ? gk[k0 + kq + 8 * i] : 1.f; }
#pragma unroll
      for (int i = 0; i < 8; ++i) { LAS float* d = scr + (kq + 8 * i) * 33 + n4; d[0] = v[i][0] * g[i]; d[1] = v[i][1] * g[i]; d[2] = v[i][2] * g[i]; d[3] = v[i][3] * g[i]; } }
    asm volatile("s_waitcnt lgkmcnt(0)" ::: "memory");
    const int c = lane & 7;
#pragma unroll
    for (int j = 0; j < 4; ++j) { const int n = (lane >> 3) + 8 * j; const LAS float* s = scr + (8 * c) * 33 + n;
        u32x4 o; o.x = pk2(s[0 * 33], s[1 * 33]); o.y = pk2(s[2 * 33], s[3 * 33]); o.z = pk2(s[4 * 33], s[5 * 33]); o.w = pk2(s[6 * 33], s[7 * 33]);
        const int drow = il ? ((n0 >> 7) << 8) + (n0 & 127) + n + row_off : row_off + n0 + n;
        *(u32x4*)(WT + (size_t)drow * K + k0 + 8 * c) = o; }
    asm volatile("s_waitcnt lgkmcnt(0)" ::: "memory");
}
__device__ __forceinline__ void rms_rows2_to_bf16(const float* x0, bf16_t* o0, const float* x1, bf16_t* o1, bool has1, int lane) {
    const f32x4* xr = (const f32x4*)x0 + lane; const f32x4* yr = (const f32x4*)x1 + lane;
    f32x4 v[4], w[4]; float s = 0.f, s2 = 0.f;
#pragma unroll
    for (int j = 0; j < 4; ++j) { v[j] = xr[64 * j]; w[j] = yr[64 * j]; }
#pragma unroll
    for (int j = 0; j < 4; ++j) { s += (v[j].x * v[j].x + v[j].y * v[j].y) + (v[j].z * v[j].z + v[j].w * v[j].w); s2 += (w[j].x * w[j].x + w[j].y * w[j].y) + (w[j].z * w[j].z + w[j].w * w[j].w); }
    const float r = rsqrtf(wave_sum(s) * (1.f / DM) + EPS), r2 = rsqrtf(wave_sum(s2) * (1.f / DM) + EPS);
    u32x2* a8 = (u32x2*)o0 + lane; u32x2* b8 = (u32x2*)o1 + lane;
#pragma unroll
    for (int j = 0; j < 4; ++j) { u32x2 p; p.x = pk2(v[j].x * r, v[j].y * r); p.y = pk2(v[j].z * r, v[j].w * r); a8[64 * j] = p;
        if (has1) { u32x2 p2; p2.x = pk2(w[j].x * r2, w[j].y * r2); p2.y = pk2(w[j].z * r2, w[j].w * r2); b8[64 * j] = p2; } }
}
constexpr int WI_IN = 16 * 112, WI_C = 16 * 16, WI_OUT = 16 * 32, WI_CO = 8 * 32, WI_G = 16 * 88, WI_D = 44 * 32;
constexpr int W_ITEMS_EARLY = WI_IN, W_ITEMS = WI_IN + 2 * WI_C + WI_OUT + WI_C + WI_CO + 2 * WI_G + WI_D;
__device__ __forceinline__ void weight_item(const Args& a, LAS float* scr, int it, int lane) {
    unsigned char* ws = a.ws; int r = it;
    if (r < WI_IN) { p0_transpose_item(a.in[11], 1024, 3584, a.in[10], (bf16_t*)(ws + WS_WIN), 0, scr, r, lane); return; } r -= WI_IN;
    if (r < WI_C) { p0_transpose_item(a.in[18], 1024, 512, a.in[16], (bf16_t*)(ws + WS_WCKV), 0, scr, r, lane); return; } r -= WI_C;
    if (r < WI_C) { p0_transpose_item(a.in[19], 1024, 512, a.in[16], (bf16_t*)(ws + WS_WCKV), 512, scr, r, lane); return; } r -= WI_C;
    if (r < WI_OUT) { const int k0 = 64 * (r / 32); const float* g = k0 < 512 ? a.in[12] : a.in[13] - 512; p0_transpose_item(a.in[14], 1024, 1024, g, (bf16_t*)(ws + WS_WOUT), 0, scr, r, lane); return; } r -= WI_OUT;
    if (r < WI_C) { p0_transpose_item(a.in[17], 1024, 512, a.in[15], (bf16_t*)(ws + WS_WCQ), 0, scr, r, lane); return; } r -= WI_C;
    if (r < WI_CO) { p0_transpose_item(a.in[20], 512, 1024, nullptr, (bf16_t*)(ws + WS_WCO), 0, scr, r, lane); return; } r -= WI_CO;
    if (r < WI_G) { p0_transpose_item(a.in[22], 1024, DFF, a.in[21], (bf16_t*)(ws + WS_WGU), 0, scr, r, lane, true); return; } r -= WI_G;
    if (r < WI_G) { p0_transpose_item(a.in[23], 1024, DFF, a.in[21], (bf16_t*)(ws + WS_WGU), 128, scr, r, lane, true); return; } r -= WI_G;
    p0_transpose_item(a.in[26], DFF, 1024, nullptr, (bf16_t*)(ws + WS_WD), 0, scr, r, lane);
}
__device__ __forceinline__ void p0_prologue(const Args& a, LAS unsigned char* lds, int wave, int lane, int G) {
    unsigned char* ws = a.ws;
    LAS float* scr = (LAS float*)(lds + wave * 16384);
    const int gw = blockIdx.x * 8 + wave, NGW = G * 8;
    for (int it = gw; it < (MK_N_LAUNCHES == 1 ? W_ITEMS_EARLY : W_ITEMS); it += NGW) weight_item(a, scr, it, lane);
    bf16_t* XN = (bf16_t*)(ws + WS_XN); bf16_t* MN = (bf16_t*)(ws + WS_MN);
    for (int m = gw; m < MT + 1024; m += 2 * NGW) {
        const int m2 = m + NGW; const bool has1 = m2 < MT + 1024; const int mb = has1 ? m2 : m;
        const float* xa = m < MP ? a.in[0] + (size_t)m * DM : (m < MT ? a.in[1] + (size_t)(m - MP) * DM : a.in[8] + (size_t)(m - MT) * DM);
        const float* xb = mb < MP ? a.in[0] + (size_t)mb * DM : (mb < MT ? a.in[1] + (size_t)(mb - MP) * DM : a.in[8] + (size_t)(mb - MT) * DM);
        bf16_t* oa = m < MT ? XN + (size_t)m * DM : MN + (size_t)(m - MT) * DM; bf16_t* ob = mb < MT ? XN + (size_t)mb * DM : MN + (size_t)(mb - MT) * DM;
        rms_rows2_to_bf16(xa, oa, xb, ob, has1, lane);
    }
    const int gt = blockIdx.x * 512 + threadIdx.x, NT = G * 512;
    float* LB = (float*)(ws + WS_LB); unsigned long long* SS1 = (unsigned long long*)(ws + WS_SS1); unsigned long long* SS2 = (unsigned long long*)(ws + WS_SS2);
    for (int i = gt; i < 512; i += NT) LB[i] = 1.f / (1.f + __expf(a.in[9][512 + i] - a.in[9][i]));
    for (int i = gt; i < MPAD; i += NT) { SS1[i] = 0ull; SS2[i] = 0ull; }
    for (int i = gt; i < MT; i += NT) ((unsigned long long*)(ws + WS_SS3))[i] = 0ull;
    for (int i = gt; i < 64 * 72; i += NT) ((unsigned*)(ws + WS_CNT))[i] = 0u;
}

__device__ __forceinline__ void hgrn_step1(const Args& a, LAS unsigned char* lds, int ch, int tid) {
    unsigned char* ws = a.ws;
    float* LF = (float*)(ws + WS_LF); const bf16_t* VT = (const bf16_t*)(ws + WS_VT); float* KV = (float*)(ws + WS_KV);
    LAS float* bsm = (LAS float*)lds;
    const int bh = ch >> 6, c = ch & 63, b = bh >> 2, h = bh & 3;
    const int row0 = b * SEQ + c * 64;
    const int k = tid & 127, seg = tid >> 7;
    float loc[16];
#pragma unroll
    for (int i = 0; i < 16; ++i) loc[i] = LF[(size_t)(row0 + seg * 16 + i) * 512 + h * 128 + k];
#pragma unroll
    for (int i = 1; i < 16; ++i) loc[i] += loc[i - 1];
    bsm[(seg * 16 + 15) * 129 + k] = loc[15];
    __syncthreads();
    float off = 0.f;
    for (int s = 0; s < seg; ++s) off += bsm[(s * 16 + 15) * 129 + k];
    __syncthreads();
#pragma unroll
    for (int i = 0; i < 16; ++i) { const float v = loc[i] + off; bsm[(seg * 16 + i) * 129 + k] = v; LF[(size_t)(row0 + seg * 16 + i) * 512 + h * 128 + k] = v; }
    __syncthreads();
    const int wave = tid >> 6, lane = tid & 63, lr = lane & 15, lg = lane >> 4;
    const bf16_t* vrow = VT + (size_t)(bh * 128 + wave * 16 + lr) * 4096 + c * 64;
    const bf16x8 A0 = *(const bf16x8*)(vrow + lg * 8), A1 = *(const bf16x8*)(vrow + 32 + lg * 8);
#pragma unroll 2
    for (int kb = 0; kb < 8; ++kb) {
        const int kk = kb * 16 + lr; const float bl = bsm[63 * 129 + kk];
        f32x4 acc = {0.f, 0.f, 0.f, 0.f};
#pragma unroll
        for (int ks = 0; ks < 2; ++ks) {
            const int s0 = ks * 32 + lg * 8;
            float bprev = s0 > 0 ? bsm[(s0 - 1) * 129 + kk] : 0.f;
            float w[8];
#pragma unroll
            for (int i = 0; i < 8; ++i) { const float bs = bsm[(s0 + i) * 129 + kk]; w[i] = (1.f - __expf(bs - bprev)) * __expf(bl - bs); bprev = bs; }
            u32x4 pw; pw.x = pk2m(w[0], w[1]); pw.y = pk2m(w[2], w[3]); pw.z = pk2m(w[4], w[5]); pw.w = pk2m(w[6], w[7]);
            acc = __builtin_amdgcn_mfma_f32_16x16x32_bf16(ks == 0 ? A0 : A1, __builtin_bit_cast(bf16x8, pw), acc, 0, 0, 0);
        }
        float* kvp = KV + ((size_t)ch * 128 + wave * 16 + lg * 4) * 128 + kk;
#pragma unroll
        for (int j = 0; j < 4; ++j) kvp[j * 128] = acc[j];
    }
    __syncthreads();
}
__device__ __forceinline__ void hgrn_scan(const Args& a, int G) {
    unsigned char* ws = a.ws;
    const float* Bc = (const float*)(ws + WS_LF); const float* KV = (const float*)(ws + WS_KV); bf16_t* SP = (bf16_t*)(ws + WS_SP);
    const int NT = G * 512;
    for (int e0 = blockIdx.x * 512 + threadIdx.x; e0 < 16 * 16384; e0 += 2 * NT) {
        const int e1 = e0 + NT; const bool has1 = e1 < 16 * 16384; const int e1c = has1 ? e1 : e0;
        const int bh0 = e0 >> 14, vk0 = e0 & 16383, bh1 = e1c >> 14, vk1 = e1c & 16383;
        const float* d0 = Bc + (size_t)((bh0 >> 2) * SEQ + 63) * 512 + (bh0 & 3) * 128 + (e0 & 127);
        const float* d1 = Bc + (size_t)((bh1 >> 2) * SEQ + 63) * 512 + (bh1 & 3) * 128 + (e1c & 127);
        float S0 = 0.f, S1 = 0.f;
        for (int c0 = 0; c0 < 64; c0 += 16) {
            float kv0[16], dl0[16], kv1[16], dl1[16];
#pragma unroll
            for (int i = 0; i < 16; ++i) { kv0[i] = KV[((size_t)(bh0 * 64 + c0 + i) << 14) + vk0]; dl0[i] = d0[(size_t)(c0 + i) * 64 * 512];
                                          kv1[i] = KV[((size_t)(bh1 * 64 + c0 + i) << 14) + vk1]; dl1[i] = d1[(size_t)(c0 + i) * 64 * 512]; }
#pragma unroll
            for (int i = 0; i < 16; ++i) { SP[((size_t)(bh0 * 64 + c0 + i) << 14) + vk0] = (bf16_t)(pk2(S0, 0.f) & 0xffffu); S0 = __expf(dl0[i]) * S0 + kv0[i];
                if (has1) SP[((size_t)(bh1 * 64 + c0 + i) << 14) + vk1] = (bf16_t)(pk2(S1, 0.f) & 0xffffu); S1 = __expf(dl1[i]) * S1 + kv1[i]; }
        }
        a.out[O_HSP + ((size_t)bh0 * 128 + (e0 & 127)) * 128 + ((e0 >> 7) & 127)] = S0;
        if (has1) a.out[O_HSP + ((size_t)bh1 * 128 + (e1 & 127)) * 128 + ((e1 >> 7) & 127)] = S1;
    }
}
template <int I> __device__ __forceinline__ void hgrn_step3(const Args& a, int ch, int lane) {
    unsigned char* ws = a.ws;
    const float* Bc = (const float*)(ws + WS_LF); const bf16_t* VT = (const bf16_t*)(ws + WS_VT); const bf16_t* SP = (const bf16_t*)(ws + WS_SP);
    const bf16_t* QH = (const bf16_t*)(ws + WS_QH); const bf16_t* GH = (const bf16_t*)(ws + WS_GH); bf16_t* MIX = (bf16_t*)(ws + WS_MIX);
    const int bh = ch >> 6, c = ch & 63, b = bh >> 2, h = bh & 3;
    const int row0 = b * SEQ + c * 64, rowI = row0 + 16 * I, hk = h * 128, lr = lane & 15, lg = lane >> 4;
    bf16x8 Qi[4], Qr[4];
#pragma unroll
    for (int ks = 0; ks < 4; ++ks) {
        const size_t o = (size_t)(rowI + lr) * 512 + hk + ks * 32 + lg * 8;
        const u32x4 qw = *(const u32x4*)(QH + o); const f32x4 b0 = *(const f32x4*)(Bc + o), b1 = *(const f32x4*)(Bc + o + 4);
        f32x4 r0 = {0.f, 0.f, 0.f, 0.f}, r1 = r0;
        if (I > 0) { const size_t orf = (size_t)(rowI - 1) * 512 + hk + ks * 32 + lg * 8; r0 = *(const f32x4*)(Bc + orf); r1 = *(const f32x4*)(Bc + orf + 4); }
        const float q[8] = {bflo(qw.x), bfhi(qw.x), bflo(qw.y), bfhi(qw.y), bflo(qw.z), bfhi(qw.z), bflo(qw.w), bfhi(qw.w)};
        const float bb[8] = {b0[0], b0[1], b0[2], b0[3], b1[0], b1[1], b1[2], b1[3]}; const float rr[8] = {r0[0], r0[1], r0[2], r0[3], r1[0], r1[1], r1[2], r1[3]};
        u32x4 wi, wr2; float x[8], y[8];
#pragma unroll
        for (int i = 0; i < 8; ++i) { x[i] = q[i] * __expf(bb[i]); y[i] = q[i] * __expf(bb[i] - rr[i]); }
        wi.x = pk2m(x[0], x[1]); wi.y = pk2m(x[2], x[3]); wi.z = pk2m(x[4], x[5]); wi.w = pk2m(x[6], x[7]);
        wr2.x = pk2m(y[0], y[1]); wr2.y = pk2m(y[2], y[3]); wr2.z = pk2m(y[4], y[5]); wr2.w = pk2m(y[6], y[7]);
        Qi[ks] = __builtin_bit_cast(bf16x8, wi); Qr[ks] = __builtin_bit_cast(bf16x8, wr2);
    }
    f32x4 oacc[8];
#pragma unroll
    for (int vb = 0; vb < 8; ++vb) { oacc[vb] = (f32x4){0.f, 0.f, 0.f, 0.f};
        const bf16_t* sp = SP + ((size_t)ch * 128 + vb * 16 + lr) * 128 + lg * 8;
#pragma unroll
        for (int ks = 0; ks < 4; ++ks) oacc[vb] = __builtin_amdgcn_mfma_f32_16x16x32_bf16(*(const bf16x8*)(sp + ks * 32), Qi[ks], oacc[vb], 0, 0, 0); }
    s16x4 Avs[I + 1][8];
#pragma unroll
    for (int J = 0; J <= I; ++J)
#pragma unroll
        for (int vb = 0; vb < 8; ++vb) Avs[J][vb] = *(const s16x4*)(VT + (size_t)(bh * 128 + vb * 16 + lr) * 4096 + c * 64 + 16 * J + lg * 4);
#pragma unroll
    for (int J = 0; J <= I; ++J) {
        f32x4 st = {0.f, 0.f, 0.f, 0.f};
        const int s = 16 * J + lr;
#pragma unroll
        for (int ks = 0; ks < 4; ++ks) {
            const size_t o = (size_t)(row0 + s) * 512 + hk + ks * 32 + lg * 8;
            const f32x4 b0 = *(const f32x4*)(Bc + o), b1 = *(const f32x4*)(Bc + o + 4);
            f32x4 p0 = {0.f, 0.f, 0.f, 0.f}, p1 = p0, r0 = p0, r1 = p0;
            if (s > 0) { p0 = *(const f32x4*)(Bc + o - 512); p1 = *(const f32x4*)(Bc + o - 512 + 4); }
            if (I > 0) { const size_t orf = (size_t)(rowI - 1) * 512 + hk + ks * 32 + lg * 8; r0 = *(const f32x4*)(Bc + orf); r1 = *(const f32x4*)(Bc + orf + 4); }
            float w[8];
#pragma unroll
            for (int i = 0; i < 4; ++i) { w[i] = (1.f - __expf(b0[i] - p0[i])) * __expf(fminf(r0[i] - b0[i], 80.f)); w[i + 4] = (1.f - __expf(b1[i] - p1[i])) * __expf(fminf(r1[i] - b1[i], 80.f)); }
            u32x4 pw; pw.x = pk2m(w[0], w[1]); pw.y = pk2m(w[2], w[3]); pw.z = pk2m(w[4], w[5]); pw.w = pk2m(w[6], w[7]);
            st = __builtin_amdgcn_mfma_f32_16x16x32_bf16(__builtin_bit_cast(bf16x8, pw), Qr[ks], st, 0, 0, 0);
        }
#pragma unroll
        for (int j = 0; j < 4; ++j) if (J > I || (J == I && lg * 4 + j > lr)) st[j] = 0.f;
        u32x2 pb; pb.x = pk2m(st[0], st[1]); pb.y = pk2m(st[2], st[3]);
        const s16x4 P = __builtin_bit_cast(s16x4, pb);
#pragma unroll
        for (int vb = 0; vb < 8; ++vb) {
            oacc[vb] = __builtin_amdgcn_mfma_f32_16x16x16bf16_1k(Avs[J][vb], P, oacc[vb], 0, 0, 0);
        }
    }
    float ssq = 0.f;
#pragma unroll
    for (int vb = 0; vb < 8; ++vb) ssq += (oacc[vb][0] * oacc[vb][0] + oacc[vb][1] * oacc[vb][1]) + (oacc[vb][2] * oacc[vb][2] + oacc[vb][3] * oacc[vb][3]);
    ssq = xg_sum(ssq);
    const float r = rsqrtf(ssq * (1.f / 128.f) + EPS);
#pragma unroll
    for (int vb = 0; vb < 8; ++vb) {
        const u32x2 gw = *(const u32x2*)(GH + (size_t)(rowI + lr) * 512 + hk + vb * 16 + lg * 4);
        u32x2 w; w.x = pk2(oacc[vb][0] * r * silu_f(bflo(gw.x)), oacc[vb][1] * r * silu_f(bfhi(gw.x))); w.y = pk2(oacc[vb][2] * r * silu_f(bflo(gw.y)), oacc[vb][3] * r * silu_f(bfhi(gw.y)));
        *(u32x2*)(MIX + (size_t)(rowI + lr) * DM + 512 + hk + vb * 16 + lg * 4) = w;
    }
}
__device__ __forceinline__ void hgrn_sample(const Args& a, LAS unsigned char* lds, int unit, int tid) {
    unsigned char* ws = a.ws;
    const float* LF = (const float*)(ws + WS_LF); const bf16_t* QH = (const bf16_t*)(ws + WS_QH); const bf16_t* VH = (const bf16_t*)(ws + WS_VH);
    const bf16_t* GH = (const bf16_t*)(ws + WS_GH); bf16_t* MIX = (bf16_t*)(ws + WS_MIX);
    LAS float* red = (LAS float*)lds;
    LAS float* tv = red + 1024;
    const int b = unit >> 2, h = unit & 3, hk = h * 128, v = tid & 127, kq = tid >> 7;
    __syncthreads();
    { const int t = tid >> 7, i = tid & 127; const size_t ro = (size_t)(MP + b * 4 + t) * 512 + hk + i;
      tv[t * 512 + i] = __expf(LF[ro]); tv[t * 512 + 128 + i] = bf1(QH[ro]); tv[t * 512 + 256 + i] = bf1(VH[ro]); tv[t * 512 + 384 + i] = bf1(GH[ro]); }
    float S[32];
    const float* s0 = a.in[4] + ((size_t)(b * 4 + h) * 128 + kq * 32) * 128 + v;
#pragma unroll
    for (int i = 0; i < 32; ++i) S[i] = s0[(size_t)i * 128];
    __syncthreads();
    for (int t = 0; t < 4; ++t) {
        const LAS float* tt = tv + t * 512;
        const float vv = tt[256 + v]; float op = 0.f;
#pragma unroll
        for (int i = 0; i < 32; ++i) { const int k = kq * 32 + i; const float f = tt[k]; S[i] = f * S[i] + (1.f - f) * vv; op += tt[128 + k] * S[i]; }
        red[kq * 128 + v] = op;
        __syncthreads();
        const float o = (red[v] + red[128 + v]) + (red[256 + v] + red[384 + v]);
        const float wsq = wave_sum(o * o);
        __syncthreads();
        if ((tid & 63) == 0) red[512 + (tid >> 6)] = wsq;
        __syncthreads();
        const float ssq = red[512] + red[513];
        if (kq == 0) { const float r = rsqrtf(ssq * (1.f / 128.f) + EPS);
            MIX[(size_t)(MP + b * 4 + t) * DM + 512 + hk + v] = (bf16_t)(pk2(o * r * silu_f(tt[384 + v]), 0.f) & 0xffffu); }
        __syncthreads();
    }
    float* so = a.out + O_HSS + ((size_t)(b * 4 + h) * 128 + kq * 32) * 128 + v;
#pragma unroll
    for (int i = 0; i < 32; ++i) so[(size_t)i * 128] = S[i];
}
__device__ __forceinline__ s16x4 tr_read(const LAS unsigned char* p) { typedef short v4i16_t __attribute__((ext_vector_type(4))); return __builtin_bit_cast(s16x4, __builtin_amdgcn_ds_read_tr16_b64_v4i16((LAS v4i16_t*)p)); }
__device__ __forceinline__ int dil_first_kb3(int p, int t0) { const int dsh = 2 * p, neg = (128 << dsh) - t0; return neg <= 0 ? 0 : (((neg + (1 << dsh) - 1) >> dsh) / 48); }
struct DilKV { bf16x8 K0[3], K1[3]; u32x4 V0[3], V1[3]; };
struct DilState { bf16x8 Q0, Q1; f32x4 o[4]; float m, l; };
__device__ __forceinline__ void dil_load(DilKV& R, const bf16_t* Kb, const bf16_t* Vb, size_t rowb, int h, int t0, int p, int kb3, int lr, int lg, int vkey, int vpart) {
    const int dsh = 2 * p, tb = t0 - (128 << dsh);
#pragma unroll
    for (int i = 0; i < 3; ++i) {
        const int kb = 3 * kb3 + i;
        int tk = tb + ((16 * kb + lr) << dsh); tk = tk < 0 ? 0 : (tk > SEQ - 1 ? SEQ - 1 : tk);
        const bf16_t* kp = Kb + (rowb + tk) * 512 + h * 64 + lg * 8;
        R.K0[i] = *(const bf16x8*)kp; R.K1[i] = *(const bf16x8*)(kp + 32);
        int tv = tb + ((16 * kb + vkey) << dsh); tv = tv < 0 ? 0 : (tv > SEQ - 1 ? SEQ - 1 : tv);
        const u32x4* vp = (const u32x4*)(Vb + (rowb + tv) * 512 + h * 64 + vpart * 16);
        R.V0[i] = vp[0]; R.V1[i] = vp[1];
    }
}
__device__ __forceinline__ void dil_qk(f32x4 (&st)[3], const DilKV& R, const DilState& S) {
#pragma unroll
    for (int i = 0; i < 3; ++i) { st[i] = (f32x4){0.f, 0.f, 0.f, 0.f};
        st[i] = __builtin_amdgcn_mfma_f32_16x16x32_bf16(R.K0[i], S.Q0, st[i], 0, 0, 0);
        st[i] = __builtin_amdgcn_mfma_f32_16x16x32_bf16(R.K1[i], S.Q1, st[i], 0, 0, 0); }
}
__device__ __forceinline__ void dil_consume(DilState& S, f32x4 (&st)[3], int jj0, int jmax, float sd, const LAS unsigned char* trp) {
    float bm = -INFINITY; const float bias0 = -sd * (float)jj0;
#pragma unroll
    for (int i = 0; i < 3; ++i)
#pragma unroll
        for (int j = 0; j < 4; ++j) { const int kk = 16 * i + j; const bool ok = (unsigned)(jj0 - kk) <= (unsigned)jmax;
            st[i][j] = ok ? st[i][j] + (bias0 + sd * (float)kk) : -INFINITY; bm = fmaxf(bm, st[i][j]); }
    bm = xg_max(bm);
    const float mnew = fmaxf(S.m, bm), corr = ex2(S.m - mnew);
    float ps = 0.f;
#pragma unroll
    for (int i = 0; i < 3; ++i)
#pragma unroll
        for (int j = 0; j < 4; ++j) { st[i][j] = ex2(st[i][j] - mnew); ps += st[i][j]; }
    ps = xg_sum(ps);
    S.l = S.l * corr + ps; S.m = mnew;
#pragma unroll
    for (int db = 0; db < 4; ++db) S.o[db] *= corr;
#pragma unroll
    for (int i = 0; i < 3; ++i) {
        u32x2 pb; pb.x = pk2m(st[i][0], st[i][1]); pb.y = pk2m(st[i][2], st[i][3]);
        const s16x4 P = __builtin_bit_cast(s16x4, pb);
#pragma unroll
        for (int db = 0; db < 4; ++db) S.o[db] = __builtin_amdgcn_mfma_f32_16x16x16bf16_1k(tr_read(trp + i * 2304 + db * 32), P, S.o[db], 0, 0, 0);
    }
}
__device__ __forceinline__ void dil_finish(DilState& S, bf16_t* MIX, size_t row, int h, int lg) {
    const float il = 1.f / S.l; float ssq = 0.f;
#pragma unroll
    for (int db = 0; db < 4; ++db) { S.o[db] *= il; ssq += (S.o[db][0] * S.o[db][0] + S.o[db][1] * S.o[db][1]) + (S.o[db][2] * S.o[db][2] + S.o[db][3] * S.o[db][3]); }
    ssq = xg_sum(ssq);
    const float rn = rsqrtf(ssq * (1.f / 64.f) + EPS);
#pragma unroll
    for (int db = 0; db < 4; ++db) { u32x2 w; w.x = pk2(S.o[db][0] * rn, S.o[db][1] * rn); w.y = pk2(S.o[db][2] * rn, S.o[db][3] * rn);
        *(u32x2*)(MIX + row * DM + h * 64 + db * 16 + lg * 4) = w; }
}
__device__ __forceinline__ void dil_attn_unit(const Args& a, LAS unsigned char* vl  , int unit, int lane) {
    unsigned char* ws = a.ws;
    const bf16_t* Qb = (const bf16_t*)(ws + WS_QB); const bf16_t* Kb = (const bf16_t*)(ws + WS_KB); const bf16_t* Vb = (const bf16_t*)(ws + WS_VB); bf16_t* MIX = (bf16_t*)(ws + WS_MIX);
    const int rp = unit & 7, blk = (unit >> 3) & 15, h = (unit >> 7) & 7, b = unit >> 10;
    const int lr = lane & 15, lg = lane >> 4, t0A = blk * 256 + rp, t0B = t0A + 8;
    const float slope = exp2f(-(float)(h + 1)) * LOG2E;
    const size_t rowb = (size_t)b * SEQ;
    DilState A, B;
    { const bf16_t* qa = Qb + (rowb + t0A + 16 * lr) * 512 + h * 64 + lg * 8; A.Q0 = *(const bf16x8*)qa; A.Q1 = *(const bf16x8*)(qa + 32);
      const bf16_t* qb = qa + 8 * 512; B.Q0 = *(const bf16x8*)qb; B.Q1 = *(const bf16x8*)(qb + 32); }
#pragma unroll
    for (int db = 0; db < 4; ++db) { A.o[db] = (f32x4){0.f, 0.f, 0.f, 0.f}; B.o[db] = A.o[db]; }
    A.m = -1e30f; A.l = 0.f; B.m = -1e30f; B.l = 0.f;
    const int vkey = lane >> 2, vpart = lane & 3, li = lane & 15;
    const LAS unsigned char* trp = vl + (lg * 4 + (li >> 2)) * 144 + (li & 3) * 8;
    const int tqA = t0A + 16 * lr, tqB = tqA + 8;
    int sg = 0, kb3 = dil_first_kb3(0, t0A);
    DilKV cur;
    dil_load(cur, Kb, Vb, rowb, h, t0A, 0, kb3, lr, lg, vkey, vpart);
#pragma unroll 1
    for (;;) {
        const int p = sg < 2 ? sg : 2, dsh = 2 * p, step = 16 >> dsh;
        f32x4 stA[3], stB[3];
        if (sg != 3) dil_qk(stA, cur, A);
        if (sg != 2) dil_qk(stB, cur, B);
#pragma unroll
        for (int i = 0; i < 3; ++i) { *(LAS u32x4*)(vl + i * 2304 + vkey * 144 + vpart * 32) = cur.V0[i]; *(LAS u32x4*)(vl + i * 2304 + vkey * 144 + vpart * 32 + 16) = cur.V1[i]; }
        int sn = sg, kn = kb3 + 1; const int nb3 = sg == 0 ? 8 : (sg == 1 ? 4 : 3);
        if (kn == nb3) { sn = sg + 1; kn = sn < 4 ? dil_first_kb3(sn < 2 ? sn : 2, sn == 3 ? t0B : t0A) : 0; }
        const bool last = sn == 4;
        if (!last) dil_load(cur, Kb, Vb, rowb, h, sn == 3 ? t0B : t0A, sn < 2 ? sn : 2, kn, lr, lg, vkey, vpart);
        const float sd = slope * (float)(1 << dsh);
        const int jbase = 128 + step * lr - 48 * kb3 - 4 * lg;
        if (sg != 3) { const int jm = tqA >> dsh; dil_consume(A, stA, jbase, jm < 128 ? jm : 128, sd, trp); }
        if (sg != 2) { const int jm = tqB >> dsh; dil_consume(B, stB, jbase + (sg < 2 ? (8 >> dsh) : 0), jm < 128 ? jm : 128, sd, trp); }
        if (last) break;
        sg = sn; kb3 = kn;
    }
    dil_finish(A, MIX, rowb + tqA, h, lg);
    dil_finish(B, MIX, rowb + tqB, h, lg);
}

template <int MODE> __device__ __forceinline__ const float* samp_row(const Args& a, int b, int t, int h, int e, bool isv) {
    if (MODE == 0) { const int p = e / 129, j = e - p * 129, idx = 2048 + t - (j << (2 * p));
        if (idx < 2048) return a.in[isv ? 3 : 2] + (((size_t)b * 2048 + idx) * 8 + h) * 64;
        return a.out + (isv ? O_WVS : O_WKS) + ((size_t)(b * 4 + idx - 2048) * 8 + h) * 64; }
    return a.in[isv ? 7 : 6] + (((size_t)b * 256 + e) * 4 + h) * 128;
}
template <int MODE, int NP> __device__ __forceinline__ void sample_attn_unit(const Args& a, LAS unsigned char* wl  , LAS float* xch  , int unit, int ul, int part, int lane) {
    constexpr int DH = MODE == 0 ? 64 : 128, NK = MODE == 0 ? 387 : 256, NH = MODE == 0 ? 8 : 4, NV = DH / 64, NKP = (NK + NP - 1) / NP;
    unsigned char* ws = a.ws;
    const int h = unit % NH, bt = unit / NH, b = bt >> 2, t = bt & 3;
    const int e0 = part * NKP, e1 = e0 + NKP < NK ? e0 + NKP : NK, nk = e1 - e0;
    LAS float* qs = (LAS float*)wl; LAS float* sc = qs + DH;
    const bf16_t* qp = (MODE == 0 ? (const bf16_t*)(ws + WS_QB) : (const bf16_t*)(ws + WS_CQ)) + (size_t)(MP + bt) * 512 + h * DH;
    for (int i = lane; i < DH; i += 64) qs[i] = bf1(qp[i]);
    const float slope = MODE == 0 ? exp2f(-(float)(h + 1)) * LOG2E : 0.f;
    float mx = -INFINITY;
    for (int el = lane; el < nk; el += 64) { const int e = e0 + el;
        const f32x4* kp = (const f32x4*)samp_row<MODE>(a, b, t, h, e, false); float dot = 0.f;
#pragma unroll
        for (int i = 0; i < DH / 4; ++i) { const f32x4 kv = kp[i]; const f32x4 qv = *(const LAS f32x4*)(qs + 4 * i); dot += (kv[0] * qv[0] + kv[1] * qv[1]) + (kv[2] * qv[2] + kv[3] * qv[3]); }
        if (MODE == 0) { const int p = e / 129, j = e - p * 129; dot -= slope * (float)(j << (2 * p)); }
        sc[el] = dot; mx = fmaxf(mx, dot);
    }
    mx = wave_max(mx);
    float sum = 0.f;
    for (int el = lane; el < nk; el += 64) { const float pe = ex2(sc[el] - mx); sc[el] = pe; sum += pe; }
    sum = wave_sum(sum);
    const int g = lane >> 4, d4 = lane & 15;
    f32x4 acc[NV];
#pragma unroll
    for (int v = 0; v < NV; ++v) acc[v] = (f32x4){0.f, 0.f, 0.f, 0.f};
    constexpr int NIT = (NKP + 3) / 4;
#pragma unroll 16
    for (int it = 0; it < NIT; ++it) { const int el = it * 4 + g; const bool ok = el < nk; const int ec = ok ? el : nk - 1;
        const float* vp = samp_row<MODE>(a, b, t, h, e0 + ec, true) + 4 * d4; const float pe = ok ? sc[ec] : 0.f;
#pragma unroll
        for (int v = 0; v < NV; ++v) acc[v] += *(const f32x4*)(vp + 64 * v) * pe; }
#pragma unroll
    for (int v = 0; v < NV; ++v)
#pragma unroll
        for (int j = 0; j < 4; ++j) { float x = acc[v][j]; x = xg_sum(x); acc[v][j] = x; }
    LAS float* xp = xch + (ul * NP + part) * (DH + 2);
    if (g == 0) {
#pragma unroll
        for (int v = 0; v < NV; ++v) *(LAS f32x4*)(xp + 64 * v + 4 * d4) = acc[v];
        if (d4 == 0) { xp[DH] = mx; xp[DH + 1] = sum; } }
    __syncthreads();
    if (part == 0) {
        const LAS float* x0 = xch + (ul * NP) * (DH + 2);
        float M = -INFINITY;
#pragma unroll
        for (int i = 0; i < NP; ++i) M = fmaxf(M, x0[i * (DH + 2) + DH]);
        float l = 0.f, o0 = 0.f, o1 = 0.f;
#pragma unroll
        for (int i = 0; i < NP; ++i) { const float f = ex2(x0[i * (DH + 2) + DH] - M); l += x0[i * (DH + 2) + DH + 1] * f; o0 += x0[i * (DH + 2) + lane] * f; if (MODE == 1) o1 += x0[i * (DH + 2) + 64 + lane] * f; }
        const float il = 1.f / l; o0 *= il; o1 *= il;
        if (MODE == 0) { const float rn = rsqrtf(wave_sum(o0 * o0) * (1.f / 64.f) + EPS);
            ((bf16_t*)(ws + WS_MIX))[(size_t)(MP + bt) * DM + h * 64 + lane] = (bf16_t)(pk2(o0 * rn, 0.f) & 0xffffu); }
        else { bf16_t* cp = (bf16_t*)(ws + WS_CO) + (size_t)(MP + bt) * 512 + h * 128; cp[lane] = (bf16_t)(pk2(o0, 0.f) & 0xffffu); cp[lane + 64] = (bf16_t)(pk2(o1, 0.f) & 0xffffu); }
    }
}

__device__ __forceinline__ void cross_unit(const Args& a, LAS unsigned char* lds, int unit, int tid) {
    unsigned char* ws = a.ws;
    const bf16_t* CQ = (const bf16_t*)(ws + WS_CQ); const bf16_t* MKB = (const bf16_t*)(ws + WS_MKB); const bf16_t* MVB = (const bf16_t*)(ws + WS_MVB); bf16_t* CO = (bf16_t*)(ws + WS_CO);
    const int qblk = unit & 15, h = (unit >> 4) & 3, b = unit >> 6;
    LAS unsigned char* ksm = lds; LAS unsigned char* vsm = lds + 256 * 272;
    __syncthreads();
    for (int i = tid; i < 4096; i += 512) { const int m = i >> 4, ck = i & 15; const size_t g = (size_t)(b * 256 + m) * 512 + h * 128 + ck * 8;
        *(LAS u32x4*)(ksm + m * 272 + ck * 16) = *(const u32x4*)(MKB + g); *(LAS u32x4*)(vsm + m * 272 + ck * 16) = *(const u32x4*)(MVB + g); }
    __syncthreads();
    const int wave = tid >> 6, lane = tid & 63, lr = lane & 15, lg = lane >> 4, li = lane & 15;
#pragma unroll 1
    for (int qq = 0; qq < 2; ++qq) {
        const size_t row = (size_t)b * SEQ + qblk * 256 + (wave * 2 + qq) * 16 + lr;
        bf16x8 Qf[4];
#pragma unroll
        for (int ks = 0; ks < 4; ++ks) Qf[ks] = *(const bf16x8*)(CQ + row * 512 + h * 128 + ks * 32 + lg * 8);
        f32x4 st[16]; float mx = -INFINITY;
#pragma unroll
        for (int kb = 0; kb < 16; ++kb) { st[kb] = (f32x4){0.f, 0.f, 0.f, 0.f};
#pragma unroll
            for (int ks = 0; ks < 4; ++ks) st[kb] = __builtin_amdgcn_mfma_f32_16x16x32_bf16(*(const LAS bf16x8*)(ksm + (kb * 16 + lr) * 272 + (ks * 32 + lg * 8) * 2), Qf[ks], st[kb], 0, 0, 0);
            mx = fmaxf(mx, fmaxf(fmaxf(st[kb][0], st[kb][1]), fmaxf(st[kb][2], st[kb][3]))); }
        mx = xg_max(mx);
        float sum = 0.f; s16x4 P[16];
#pragma unroll
        for (int kb = 0; kb < 16; ++kb) { f32x4 e;
#pragma unroll
            for (int j = 0; j < 4; ++j) { e[j] = ex2(st[kb][j] - mx); sum += e[j]; }
            u32x2 pb; pb.x = pk2m(e[0], e[1]); pb.y = pk2m(e[2], e[3]); P[kb] = __builtin_bit_cast(s16x4, pb); }
        sum = xg_sum(sum);
        const float il = 1.f / sum;
        const LAS unsigned char* trp = vsm + (lg * 4 + (li >> 2)) * 272 + (li & 3) * 8;
#pragma unroll
        for (int db = 0; db < 8; ++db) { f32x4 o = {0.f, 0.f, 0.f, 0.f};
#pragma unroll
            for (int kb = 0; kb < 16; ++kb) o = __builtin_amdgcn_mfma_f32_16x16x16bf16_1k(tr_read(trp + kb * 16 * 272 + db * 32), P[kb], o, 0, 0, 0);
            u32x2 w; w.x = pk2(o[0] * il, o[1] * il); w.y = pk2(o[2] * il, o[3] * il);
            *(u32x2*)(CO + row * 512 + h * 128 + db * 16 + lg * 4) = w; }
    }
}

__device__ __forceinline__ void unpack8(const u32x4 g, float (&x)[8]) { x[0] = bflo(g.x); x[1] = bfhi(g.x); x[2] = bflo(g.y); x[3] = bfhi(g.y); x[4] = bflo(g.z); x[5] = bfhi(g.z); x[6] = bflo(g.w); x[7] = bfhi(g.w); }
__device__ __forceinline__ void act_pass(const Args& a, int G) {
    unsigned char* ws = a.ws;
    const bf16_t* UG = (const bf16_t*)(ws + WS_UG); const bf16_t* UP = (const bf16_t*)(ws + WS_UP); bf16_t* ACT = (bf16_t*)(ws + WS_ACT);
    const float* cw = a.in[24]; const float* cb = a.in[25]; const float* st = a.in[5];
    constexpr int CH = DFF / 8, RG = 45;
    const int gt = blockIdx.x * 512 + threadIdx.x;
    const int c0 = (gt % CH) * 8, r0 = (gt / CH) * RG;
    if (r0 >= MT) return;
    const int r1 = r0 + RG < MT ? r0 + RG : MT;
    float w0[8], w1[8], w2[8], bb[8];
#pragma unroll
    for (int j = 0; j < 8; ++j) { w0[j] = cw[c0 + j]; w1[j] = cw[DFF + c0 + j]; w2[j] = cw[2 * DFF + c0 + j]; bb[j] = cb[c0 + j]; }
    float x1[8], x2[8];
    { const int t = r0 < MP ? (r0 & 4095) : ((r0 - MP) & 3);
#pragma unroll
      for (int j = 0; j < 8; ++j) { x1[j] = 0.f; x2[j] = 0.f; }
      if (t >= 1) unpack8(*(const u32x4*)(UG + (size_t)(r0 - 1) * DFF + c0), x1);
      if (t >= 2) unpack8(*(const u32x4*)(UG + (size_t)(r0 - 2) * DFF + c0), x2);
      if (r0 >= MP && t == 1) { const float* sp = st + ((size_t)((r0 - MP) >> 2) * 2 + 1) * DFF + c0;
#pragma unroll
          for (int j = 0; j < 8; ++j) x2[j] = sp[j]; } }
#pragma unroll 5
    for (int row = r0; row < r1; ++row) {
        const int t = row < MP ? (row & 4095) : ((row - MP) & 3);
        if (t == 0) {
            if (row >= MP) { const float* sp = st + (size_t)((row - MP) >> 2) * 2 * DFF + c0;
#pragma unroll
                for (int j = 0; j < 8; ++j) { x2[j] = sp[j]; x1[j] = sp[DFF + j]; } }
            else {
#pragma unroll
                for (int j = 0; j < 8; ++j) { x1[j] = 0.f; x2[j] = 0.f; } }
        }
        float x0[8], uu[8];
        unpack8(*(const u32x4*)(UG + (size_t)row * DFF + c0), x0); unpack8(*(const u32x4*)(UP + (size_t)row * DFF + c0), uu);
        float r[8];
#pragma unroll
        for (int j = 0; j < 8; ++j) { const float cv = bb[j] + w0[j] * x2[j] + w1[j] * x1[j] + w2[j] * x0[j]; r[j] = silu_f(cv) * uu[j]; x2[j] = x1[j]; x1[j] = x0[j]; }
        u32x4 w; w.x = pk2(r[0], r[1]); w.y = pk2(r[2], r[3]); w.z = pk2(r[4], r[5]); w.w = pk2(r[6], r[7]);
        *(u32x4*)(ACT + (size_t)row * DFF + c0) = w;
    }
}
__device__ __forceinline__ void final_norm(const Args& a, int G, int wave, int lane) {
    const float* g = a.in[27]; const bf16_t* XN = (const bf16_t*)(a.ws + WS_XN);
    f32x4 gg[4];
#pragma unroll
    for (int j = 0; j < 4; ++j) gg[j] = *((const f32x4*)g + 2 * lane + (j & 1) + 128 * (j >> 1));
    const int NGW = G * 8;
    for (int m = MP + blockIdx.x * 8 + wave; m < MT; m += 2 * NGW) {
        const int m2 = m + NGW; const bool has2 = m2 < MT; const int mb = has2 ? m2 : m;
        const u32x4 a0 = *((const u32x4*)(XN + (size_t)m * DM) + lane), a1 = *((const u32x4*)(XN + (size_t)m * DM) + 64 + lane);
        const u32x4 b0 = *((const u32x4*)(XN + (size_t)mb * DM) + lane), b1 = *((const u32x4*)(XN + (size_t)mb * DM) + 64 + lane);
        f32x4 v[4] = {{bflo(a0.x), bfhi(a0.x), bflo(a0.y), bfhi(a0.y)}, {bflo(a0.z), bfhi(a0.z), bflo(a0.w), bfhi(a0.w)}, {bflo(a1.x), bfhi(a1.x), bflo(a1.y), bfhi(a1.y)}, {bflo(a1.z), bfhi(a1.z), bflo(a1.w), bfhi(a1.w)}};
        f32x4 w[4] = {{bflo(b0.x), bfhi(b0.x), bflo(b0.y), bfhi(b0.y)}, {bflo(b0.z), bfhi(b0.z), bflo(b0.w), bfhi(b0.w)}, {bflo(b1.x), bfhi(b1.x), bflo(b1.y), bfhi(b1.y)}, {bflo(b1.z), bfhi(b1.z), bflo(b1.w), bfhi(b1.w)}};
        float s = 0.f, s2 = 0.f;
#pragma unroll
        for (int j = 0; j < 4; ++j) { s += (v[j].x * v[j].x + v[j].y * v[j].y) + (v[j].z * v[j].z + v[j].w * v[j].w); s2 += (w[j].x * w[j].x + w[j].y * w[j].y) + (w[j].z * w[j].z + w[j].w * w[j].w); }
        const float r = rsqrtf(wave_sum(s) * (1.f / DM) + EPS), r2 = rsqrtf(wave_sum(s2) * (1.f / DM) + EPS);
        f32x4* y = (f32x4*)(a.out + (size_t)m * DM); f32x4* y2 = (f32x4*)(a.out + (size_t)mb * DM);
#pragma unroll
        for (int j = 0; j < 4; ++j) { const int q = 2 * lane + (j & 1) + 128 * (j >> 1); y[q] = v[j] * r * gg[j]; if (has2) y2[q] = w[j] * r2 * gg[j]; }
    }
}
#define XB_TMO      128
#define XB_XCNT(j)  (256  + 64 * (j))
#define XB_XSUB(j)  (1280 + 64 * (j))
#define XB_XGEN(j)  (2304 + 64 * (j))
#define XB_TOP      3328
#define XB_TOPGEN   3392
#define XCD_BAR_WORDS 3456
#define XB_SPIN_CAP (1u << 18)

__device__ __forceinline__ unsigned xb_ld(unsigned* p)              { return __hip_atomic_load(p, __ATOMIC_RELAXED, __HIP_MEMORY_SCOPE_AGENT); }
__device__ __forceinline__ unsigned xb_add(unsigned* p, unsigned v) { return __hip_atomic_fetch_add(p, v, __ATOMIC_RELAXED, __HIP_MEMORY_SCOPE_AGENT); }
__device__ __forceinline__ unsigned xb_xcc_id() { return (unsigned)__builtin_amdgcn_s_getreg((3 << 11) | 20) & 0xFu; }
#define XB_SPIN(cond, bar) do { unsigned _sp = 0; while (cond) { __builtin_amdgcn_s_sleep(1); \
    if ((++_sp & 255u) == 0u) { if (xb_ld(&(bar)[XB_TMO])) break; if (_sp > XB_SPIN_CAP) { atomicAdd(&(bar)[XB_TMO], 1u); break; } } } } while (0)

struct XcdBarrier {
    unsigned* bar; unsigned x;
    volatile LAS unsigned* st;
};

__device__ __forceinline__ XcdBarrier xcd_barrier_post(unsigned* bar, volatile LAS unsigned* st) {
    XcdBarrier b; b.bar = bar; b.x = xb_xcc_id(); b.st = st;
    if (threadIdx.x == 0) (void)xb_add(&bar[XB_XCNT(b.x)], 1u);
    return b;
}
__device__ __forceinline__ void xcd_barrier_complete(unsigned* bar, unsigned x, unsigned& nloc, unsigned& nx) {
    const unsigned G = gridDim.x * gridDim.y * gridDim.z;
    unsigned sum, cnt, mine, sp = 0u;
    for (;;) {
        sum = 0u; cnt = 0u; mine = 0u;
#pragma unroll
        for (unsigned j = 0; j < 16; ++j) { const unsigned c = xb_ld(&bar[XB_XCNT(j)]); sum += c; cnt += (c > 0u) ? 1u : 0u; mine = (j == x) ? c : mine; }
        if (sum == G) break;
        __builtin_amdgcn_s_sleep(1);
        if ((++sp & 255u) == 0u) { if (xb_ld(&bar[XB_TMO])) break; if (sp > XB_SPIN_CAP) { atomicAdd(&bar[XB_TMO], 1u); break; } }
    }
    nloc = mine > 0u ? mine : 1u; nx = cnt > 0u ? cnt : 1u;
}

__device__ __forceinline__ void xcd_barrier(const XcdBarrier& b) {
    asm volatile("s_waitcnt vmcnt(0)" ::: "memory");
    __syncthreads();
    if (threadIdx.x == 0) {
        unsigned* bar = b.bar;
        __builtin_amdgcn_s_waitcnt(0);
        unsigned nloc = b.st[0], nx = b.st[1];
        if (nloc == 0u) { xcd_barrier_complete(bar, b.x, nloc, nx); b.st[0] = nloc; b.st[1] = nx; }
        const unsigned old = xb_add(&bar[XB_XSUB(b.x)], 1u);
        const unsigned gen = old / nloc;
        if (old + 1u == (gen + 1u) * nloc) {
            __builtin_amdgcn_fence(__ATOMIC_RELEASE, "agent");
            asm volatile("s_waitcnt vmcnt(0)" ::: "memory");
            const unsigned og = xb_add(&bar[XB_TOP], 1u);
            const unsigned tg = og / nx;
            if (og + 1u == (tg + 1u) * nx) xb_add(&bar[XB_TOPGEN], 1u);
            else XB_SPIN(xb_ld(&bar[XB_TOPGEN]) == tg, bar);
            __builtin_amdgcn_fence(__ATOMIC_ACQUIRE, "agent");
            xb_add(&bar[XB_XGEN(b.x)], 1u);
            asm volatile("s_waitcnt vmcnt(0)" ::: "memory");
        } else {
            XB_SPIN(xb_ld(&bar[XB_XGEN(b.x)]) == gen, bar);
            __builtin_amdgcn_fence(__ATOMIC_ACQUIRE, "agent");
            asm volatile("s_waitcnt vmcnt(0)" ::: "memory");
        }
    }
    __syncthreads();
}

constexpr int NPH = 13;
__global__ void __launch_bounds__(512, 2) fwd_mega(Args args) {
    extern __shared__ __attribute__((aligned(16))) unsigned char lds_raw[];
    LAS unsigned char* lds = (LAS unsigned char*)lds_raw;
    cg::grid_group grid = cg::this_grid();
    const int tid = threadIdx.x, lane = tid & 63, wave = __builtin_amdgcn_readfirstlane(tid >> 6), G = gridDim.x, bx = blockIdx.x;
    unsigned char* ws = args.ws;
    const int lo = args.ph_lo, hi = args.ph_hi;
#define IN(k) (lo <= (k) && (k) < hi)
    volatile LAS unsigned* barst = (volatile LAS unsigned*)(lds + LDS_BARST);
    if (tid < 2) barst[tid] = 0u;
    __syncthreads();
    XcdBarrier xbar; xbar.bar = (unsigned*)(ws + WS_BAR); xbar.x = 0; xbar.st = barst;
    if (lo < 0) grid.sync();
    if (hi - lo > 1) xbar = xcd_barrier_post((unsigned*)(ws + WS_BAR), barst);
#define SEAM(k) do { if (IN(k) && IN((k) + 1)) xcd_barrier(xbar); } while (0)
    bf16_t* XN = (bf16_t*)(ws + WS_XN);
    if (IN(0)) { REPS(0) p0_prologue(args, lds, wave, lane, G); }
    SEAM(0);
    if (IN(1)) REPS(1) {
        { pg8::Gemm g{XN, (const bf16_t*)(ws + WS_WIN), MPAD, 3584, 1024}; pg8::StaticOrder S; S.init(MPAD, 3584, G, bx);
          EpiIn E{(bf16_t*)(ws + WS_QB), (bf16_t*)(ws + WS_KB), (bf16_t*)(ws + WS_VB), (bf16_t*)(ws + WS_QH), (bf16_t*)(ws + WS_VH), (bf16_t*)(ws + WS_GH), (bf16_t*)(ws + WS_VT),
                  (float*)(ws + WS_LF), (const float*)(ws + WS_LB), args.out};
          pg8::gemm_phase<EpiIn, pg8::StaticOrder, true, true>(lds, g, S, E); }
        if (MK_N_LAUNCHES == 1 && bx >= 142) {
            __syncthreads();
            LAS float* scr = (LAS float*)(lds + wave * 16384);
            for (int it = W_ITEMS_EARLY + (bx - 142) * 8 + wave; it < W_ITEMS; it += (G - 142) * 8) weight_item(args, scr, it, lane);
            __syncthreads();
        }
    }
    SEAM(1);
    if (IN(2)) {
        for (int ch = bx; ch < 1024; ch += G) hgrn_step1(args, lds, ch, tid);
        __syncthreads();
        LAS unsigned char* wl = lds + wave * 8192;
        {
            const int x = bx & 7, lw = (bx >> 3) * 8 + wave;
#pragma unroll 1
            REPS(2) for (int kk = 0; kk < 3; ++kk) { if (kk < 2) dil_attn_unit(args, wl, ((((kk * 2 + (lw >> 7)) * 8 + x) << 7) | (lw & 127)), lane);
                else sample_attn_unit<0, 2>(args, wl, (LAS float*)(lds + 65536), bx * 4 + (wave & 3), wave & 3, wave >> 2, lane); }
        }
    }
    SEAM(2);
    if (IN(3)) { REPS(3) hgrn_scan(args, G); }
    SEAM(3);
    if (IN(4)) REPS(4) {
#pragma unroll 1
        for (int u = bx * 8 + wave; u < 4096; u += G * 8) { const int I = u < 2048 ? 3 - (u & 3) : (u & 3), ch = u >> 2;
            if (I == 0) hgrn_step3<0>(args, ch, lane); else if (I == 1) hgrn_step3<1>(args, ch, lane); else if (I == 2) hgrn_step3<2>(args, ch, lane); else hgrn_step3<3>(args, ch, lane); }
        __syncthreads();
        for (int u = G - 1 - bx; u < 128; u += G) hgrn_sample(args, lds, u, tid);
    }
    SEAM(4);
    if (IN(5)) {
        pg8::Gemm g{(const bf16_t*)(ws + WS_MIX), (const bf16_t*)(ws + WS_WOUT), MP, 1024, 1024}; pg8::StaticOrder S; S.init(MP, 1024, G, bx);
        EpiRes<0> E{args.in[0], args.out, XN, (unsigned long long*)(ws + WS_SS1)};
        pg8::gemm_phase<EpiRes<0>, pg8::StaticOrder, true, true>(lds, g, S, E);
        mini_gemm_res<0>(lds, (const bf16_t*)(ws + WS_MIX), (const bf16_t*)(ws + WS_WOUT), 1024, args.in[1], args.out, XN, (unsigned long long*)(ws + WS_SS1), tid);
    }
    SEAM(5);
    if (IN(6)) REPS(6) {
        pg8::Gemm g{XN, (const bf16_t*)(ws + WS_WCQ), MPAD, 512, 1024}; pg8::StaticOrder S; S.init(MPAD, 512, G, bx);
        EpiRS<0> E{(const unsigned long long*)(ws + WS_SS1), (bf16_t*)(ws + WS_CQ), nullptr, args.out, CQSCALE};
        pg8::gemm_phase<EpiRS<0>, pg8::StaticOrder, true, true>(lds, g, S, E);
        { pg8::Gemm g{(const bf16_t*)(ws + WS_MN), (const bf16_t*)(ws + WS_WCKV), 1024, 1024, 1024}; pg8::StaticOrder S; S.init(1024, 1024, G, G - 1 - bx);
          EpiMem E{(bf16_t*)(ws + WS_MKB), (bf16_t*)(ws + WS_MVB), args.out};
          pg8::gemm_phase<EpiMem, pg8::StaticOrder, true, true>(lds, g, S, E); }
    }
    SEAM(6);
    if (IN(7)) {
        REPS(7) for (int u = bx; u < 256; u += G) cross_unit(args, lds, u, tid);
        __syncthreads();
        LAS unsigned char* wl = lds + wave * 4096;
        sample_attn_unit<1, 4>(args, wl, (LAS float*)(lds + 65536), bx * 2 + (wave >> 2), wave >> 2, wave & 3, lane);
    }
    SEAM(7);
    if (IN(8)) {
        pg8::Gemm g{(const bf16_t*)(ws + WS_CO), (const bf16_t*)(ws + WS_WCO), MP, 1024, 512}; pg8::StaticOrder S; S.init(MP, 1024, G, bx);
        EpiRes<1> E{nullptr, args.out, XN, (unsigned long long*)(ws + WS_SS2)};
        pg8::gemm_phase<EpiRes<1>, pg8::StaticOrder, true, true>(lds, g, S, E);
        mini_gemm_res<1>(lds, (const bf16_t*)(ws + WS_CO), (const bf16_t*)(ws + WS_WCO), 512, nullptr, args.out, XN, (unsigned long long*)(ws + WS_SS2), tid);
    }
    SEAM(8);
    if (IN(9)) REPS(9) {
        pg8::Gemm g{XN, (const bf16_t*)(ws + WS_WGU), MPAD, 2 * DFF, 1024}; pg8::StaticOrder S; S.init(MPAD, 2 * DFF, G, bx);
        EpiGU E{(const unsigned long long*)(ws + WS_SS2), (bf16_t*)(ws + WS_ACT), args.in[5], (float*)(ws + WS_EDGE), (float*)(ws + WS_PART), (float*)(ws + WS_UPV),
                args.in[24], args.in[25], args.out, lds + 131072};
        pg8::gemm_phase<EpiGU, pg8::StaticOrder, true, true>(lds, g, S, E);
    }
    SEAM(9);
    if (IN(11)) {
        { const int wg = (bx & 7) * 32 + (bx >> 3), pm0 = (wg >> 5) * 8 + (wg & 7);
          ffn_fixup_local(args, pm0, tid); }
        pg8::Gemm g{(const bf16_t*)(ws + WS_ACT), (const bf16_t*)(ws + WS_WD), MP, 1024, DFF}; pg8::StaticOrder S; S.init(MP, 1024, G, bx);
        EpiFinal E{XN, (unsigned long long*)(ws + WS_SS3), (unsigned*)(ws + WS_CNT), args.in[27], args.out};
        pg8::gemm_phase<EpiFinal, pg8::StaticOrder, true, true>(lds, g, S, E);
        mini_gemm_res<2>(lds, (const bf16_t*)(ws + WS_ACT), (const bf16_t*)(ws + WS_WD), DFF, nullptr, args.out, XN, (unsigned long long*)(ws + WS_SS3), tid, (unsigned*)(ws + WS_CNT), args.in[27]);
    }
#undef IN
#undef SEAM
}

extern "C" void kernel_launch(void* const* d_in, const int* in_sizes, int n_in, void* d_out, int out_size, void* d_ws, size_t ws_size, hipStream_t stream) {
    static int grid = 0;
    if (grid == 0) {
        int dev = 0, cus = 0, per_cu = 0;
        (void)hipGetDevice(&dev); (void)hipDeviceGetAttribute(&cus, hipDeviceAttributeMultiprocessorCount, dev);
        if (hipFuncSetAttribute((const void*)fwd_mega, hipFuncAttributeMaxDynamicSharedMemorySize, LDS_BYTES) != hipSuccess) fprintf(stderr, "hipFuncSetAttribute failed\n");
        (void)hipOccupancyMaxActiveBlocksPerMultiprocessor(&per_cu, (const void*)fwd_mega, 512, LDS_BYTES);
        (void)hipGetLastError();
        grid = 256;
        if (cus < 256) fprintf(stderr, "kernel_launch: device reports %d CUs, this kernel needs 256\n", cus);
        if (n_in != 28 || ws_size < 384 * MiB) { fprintf(stderr, "kernel_launch: unexpected inputs (n_in %d, ws %zu)\n", n_in, ws_size); }
    }
    Args a{};
    for (int i = 0; i < 28; ++i) a.in[i] = (const float*)d_in[i];
    a.out = (float*)d_out; a.ws = (unsigned char*)d_ws;
#if MK_N_LAUNCHES == 1
    a.ph_lo = 0; a.ph_hi = NPH;
    (void)hipMemsetAsync((unsigned char*)d_ws + WS_BAR, 0, 3456 * 4, stream);
    void* kargs[] = {&a};
    hipError_t e = hipLaunchCooperativeKernel((const void*)fwd_mega, dim3(grid), dim3(512), kargs, LDS_BYTES, stream);
    if (e != hipSuccess) fprintf(stderr, "cooperative launch failed: %s (grid %d)\n", hipGetErrorString(e), grid);
#else
    for (int p = 0; p < NPH; ++p) { a.ph_lo = p; a.ph_hi = p + 1; hipLaunchKernelGGL(fwd_mega, dim3(grid), dim3(512), LDS_BYTES, stream, a); }
#endif
}
```
